# Optimizing an MI355X kernel written in HIP

```python
import math
import jax, jax.numpy as jnp
from jax import lax
import numpy as np


D_MODEL = 1024
BATCH = 2
SEQ = 16384
DEPTH = 2

N_MIXERS = 2
N_GLA_LAYERS = (DEPTH + 1) // 2
N_DIFF_LAYERS = DEPTH // 2
RMS_EPS = 1e-6

GLA_HEADS = 4
GLA_DK = D_MODEL // 2 // GLA_HEADS
GLA_DV = D_MODEL // GLA_HEADS
GLA_GATE_RANK = 16
GLA_TAU = 16.0
GLA_CHUNK = 64
GLA_QK = GLA_HEADS * GLA_DK
GLA_V = GLA_HEADS * GLA_DV
GLA_IN = 2 * GLA_QK + 2 * GLA_V + GLA_GATE_RANK

DIFF_HEADS = D_MODEL // 128
DIFF_DH = 64
DIFF_DV = 2 * DIFF_DH
DIFF_QK = 2 * DIFF_HEADS * DIFF_DH
DIFF_VW = DIFF_HEADS * DIFF_DV
DIFF_IN = 2 * DIFF_QK + DIFF_VW
ROPE_DIMS = DIFF_DH // 4
ROPE_THETA = 500000.0
Q_BLOCK = 128

PEER_HEADS = 8
PEER_NKEYS = 128
PEER_N_EXPERTS = PEER_NKEYS * PEER_NKEYS
PEER_DKEY = 128
PEER_TOPK = 16
PEER_TOKEN_BLOCK = 128

kernel_name = "hybrid_gla_diffattn_peer"


def rmsnorm(x, g):
    xf = x.astype(jnp.float32)
    y = xf * lax.rsqrt(jnp.mean(xf * xf, axis=-1, keepdims=True) + RMS_EPS)
    return (y * g.astype(jnp.float32)).astype(x.dtype)


def gla_mixer(h, w_in, w_gate_up, b_gate, g_norm, w_out):
    B, S, _ = h.shape
    nC = S // GLA_CHUNK
    proj = h @ w_in
    q, k, v, r, glr = jnp.split(
        proj, [GLA_QK, 2 * GLA_QK, 2 * GLA_QK + GLA_V, 2 * GLA_QK + 2 * GLA_V], axis=-1)
    glog = jax.nn.log_sigmoid((glr @ w_gate_up + b_gate).astype(jnp.float32)) / GLA_TAU

    def heads(t, d):
        return t.reshape(B, nC, GLA_CHUNK, GLA_HEADS, d).transpose(0, 3, 1, 2, 4)

    q = heads(q, GLA_DK) * (GLA_DK ** -0.5)
    k = heads(k, GLA_DK)
    v = heads(v, GLA_DV)
    cum = jnp.cumsum(heads(glog, GLA_DK), axis=3)
    last = cum[:, :, :, -1:, :]
    mid = cum[:, :, :, GLA_CHUNK // 2 - 1:GLA_CHUNK // 2, :]

    a = jnp.einsum('bhncd,bhnjd->bhncj', q * jnp.exp(cum - mid), k * jnp.exp(mid - cum))
    causal = jnp.tril(jnp.ones((GLA_CHUNK, GLA_CHUNK), dtype=bool))
    a = jnp.where(causal, a, 0.0)
    o_intra = jnp.einsum('bhncj,bhnjv->bhncv', a, v)

    kv = jnp.einsum('bhncd,bhncv->nbhdv', k * jnp.exp(last - cum), v)
    chunk_decay = jnp.exp(last[:, :, :, 0, :]).transpose(2, 0, 1, 3)

    def step(state, inp):
        dec, kv_c = inp
        return dec[..., None] * state + kv_c, state

    init = jnp.zeros((B, GLA_HEADS, GLA_DK, GLA_DV), kv.dtype)
    _, states = lax.scan(step, init, (chunk_decay, kv))
    o_inter = jnp.einsum('bhncd,nbhdv->bhncv', q * jnp.exp(cum), states)

    o = (o_intra + o_inter).transpose(0, 2, 3, 1, 4).reshape(B, S, GLA_HEADS, GLA_DV)
    o = rmsnorm(o, g_norm).reshape(B, S, GLA_V) * jax.nn.silu(r.astype(jnp.float32))
    return o.astype(h.dtype) @ w_out


def rope_partial(t, cos, sin):
    half = ROPE_DIMS // 2
    x1, x2, rest = t[..., :half], t[..., half:ROPE_DIMS], t[..., ROPE_DIMS:]
    return jnp.concatenate([x1 * cos - x2 * sin, x2 * cos + x1 * sin, rest], axis=-1).astype(t.dtype)


def diff_mixer(h, positions, w_in, lq1, lk1, lq2, lk2, g_norm, w_out, lambda_init):
    B, S, _ = h.shape
    nQ = S // Q_BLOCK
    proj = h @ w_in
    q, k, v = jnp.split(proj, [DIFF_QK, 2 * DIFF_QK], axis=-1)
    q = q.reshape(B, S, 2 * DIFF_HEADS, DIFF_DH)
    k = k.reshape(B, S, 2 * DIFF_HEADS, DIFF_DH)
    v = v.reshape(B, S, DIFF_HEADS, DIFF_DV)

    inv_freq = ROPE_THETA ** (-jnp.arange(0, ROPE_DIMS, 2, dtype=jnp.float32) / ROPE_DIMS)
    ang = positions.astype(jnp.float32)[..., None] * inv_freq
    cos, sin = jnp.cos(ang)[:, :, None, :], jnp.sin(ang)[:, :, None, :]
    q = rope_partial(q, cos, sin) * (DIFF_DH ** -0.5)
    k = rope_partial(k, cos, sin)
    q = q.reshape(B, S, DIFF_HEADS, 2, DIFF_DH)
    k = k.reshape(B, S, DIFF_HEADS, 2, DIFF_DH)

    lam = (jnp.exp(jnp.sum(lq1.astype(jnp.float32) * lk1.astype(jnp.float32)))
           - jnp.exp(jnp.sum(lq2.astype(jnp.float32) * lk2.astype(jnp.float32)))
           + lambda_init)

    qb = q.reshape(B, nQ, Q_BLOCK, DIFF_HEADS, 2, DIFF_DH).transpose(1, 0, 2, 3, 4, 5)
    key_idx = jnp.arange(S)

    def block(args):
        q_blk, i = args
        s = jnp.einsum('bqhmd,bkhmd->bhmqk', q_blk, k).astype(jnp.float32)
        q_idx = i * Q_BLOCK + jnp.arange(Q_BLOCK)
        mask = key_idx[None, :] <= q_idx[:, None]
        p = jax.nn.softmax(jnp.where(mask, s, -jnp.inf), axis=-1)
        attn = p[:, :, 0] - lam * p[:, :, 1]
        return jnp.einsum('bhqk,bkhv->bqhv', attn.astype(v.dtype), v)

    o = lax.map(block, (qb, jnp.arange(nQ)))
    o = o.transpose(1, 0, 2, 3, 4).reshape(B, S, DIFF_HEADS, DIFF_DV)
    o = rmsnorm(o, g_norm) * (1.0 - lambda_init)
    return o.reshape(B, S, DIFF_VW) @ w_out


def peer(h, w_query, sub_keys, expert_u, expert_v):
    B, S, D = h.shape
    tokens = h.reshape(-1, PEER_TOKEN_BLOCK, D)

    def block(x_blk):
        T = x_blk.shape[0]
        qry = (x_blk @ w_query).reshape(T, PEER_HEADS, 2, PEER_DKEY)
        scores = jnp.einsum('thpd,hpnd->thpn', qry, sub_keys).astype(jnp.float32)
        top_s, top_i = lax.top_k(scores, PEER_TOPK)
        cand_s = top_s[:, :, 0, :, None] + top_s[:, :, 1, None, :]
        cand_i = top_i[:, :, 0, :, None] * PEER_NKEYS + top_i[:, :, 1, None, :]
        cand_s = cand_s.reshape(T, PEER_HEADS, PEER_TOPK * PEER_TOPK)
        cand_i = cand_i.reshape(T, PEER_HEADS, PEER_TOPK * PEER_TOPK)
        best_s, best_pos = lax.top_k(cand_s, PEER_TOPK)
        idx = jnp.take_along_axis(cand_i, best_pos, axis=-1)
        gate = jax.nn.softmax(best_s, axis=-1)
        u = expert_u[idx]
        act = jax.nn.gelu(jnp.einsum('thkd,td->thk', u, x_blk), approximate=False)
        vsel = expert_v[idx]
        return jnp.einsum('thk,thkd->td', (gate * act).astype(vsel.dtype), vsel)

    return lax.map(block, tokens).reshape(B, S, D)


def setup_inputs(seed: int = 0) -> dict:
    key = jax.random.key(seed)
    ks = jax.random.split(key, 24)
    f32 = jnp.float32
    D = D_MODEL

    def nrm(k, shape, scale):
        return jax.random.normal(k, shape, f32) * scale

    x = jax.random.normal(ks[0], (BATCH, SEQ, D), f32)
    positions = jnp.broadcast_to(jnp.arange(SEQ, dtype=jnp.int32)[None, :], (BATCH, SEQ))
    return {
        "x": x,
        "positions": positions,
        "norm_mix": 1.0 + nrm(ks[1], (DEPTH, D), 0.02),
        "norm_ffn": 1.0 + nrm(ks[2], (DEPTH, D), 0.02),
        "norm_final": 1.0 + nrm(ks[3], (D,), 0.02),
        "gla_w_in": nrm(ks[4], (N_GLA_LAYERS, D, GLA_IN), D ** -0.5),
        "gla_w_gate_up": nrm(ks[5], (N_GLA_LAYERS, GLA_GATE_RANK, GLA_QK), GLA_GATE_RANK ** -0.5),
        "gla_b_gate": nrm(ks[6], (N_GLA_LAYERS, GLA_QK), 0.1),
        "gla_norm": 1.0 + nrm(ks[7], (N_GLA_LAYERS, GLA_HEADS, GLA_DV), 0.02),
        "gla_w_out": nrm(ks[8], (N_GLA_LAYERS, GLA_V, D), GLA_V ** -0.5),
        "diff_w_in": nrm(ks[9], (N_DIFF_LAYERS, D, DIFF_IN), D ** -0.5),
        "diff_lambda_q1": nrm(ks[10], (N_DIFF_LAYERS, DIFF_DH), 0.1),
        "diff_lambda_k1": nrm(ks[11], (N_DIFF_LAYERS, DIFF_DH), 0.1),
        "diff_lambda_q2": nrm(ks[12], (N_DIFF_LAYERS, DIFF_DH), 0.1),
        "diff_lambda_k2": nrm(ks[13], (N_DIFF_LAYERS, DIFF_DH), 0.1),
        "diff_norm": 1.0 + nrm(ks[14], (N_DIFF_LAYERS, DIFF_HEADS, DIFF_DV), 0.02),
        "diff_w_out": nrm(ks[15], (N_DIFF_LAYERS, DIFF_VW, D), DIFF_VW ** -0.5),
        "peer_w_query": nrm(ks[16], (DEPTH, D, PEER_HEADS * 2 * PEER_DKEY), D ** -0.5),
        "peer_sub_keys": nrm(ks[17], (DEPTH, PEER_HEADS, 2, PEER_NKEYS, PEER_DKEY), PEER_DKEY ** -0.5),
        "peer_u": nrm(ks[18], (DEPTH, PEER_N_EXPERTS, D), D ** -0.5),
        "peer_v": nrm(ks[19], (DEPTH, PEER_N_EXPERTS, D), PEER_HEADS ** -0.5),
    }


def reference(x, positions, norm_mix, norm_ffn, norm_final,
              gla_w_in, gla_w_gate_up, gla_b_gate, gla_norm, gla_w_out,
              diff_w_in, diff_lambda_q1, diff_lambda_k1, diff_lambda_q2, diff_lambda_k2,
              diff_norm, diff_w_out,
              peer_w_query, peer_sub_keys, peer_u, peer_v):
    h = x
    for i in range(DEPTH):
        hn = rmsnorm(h, norm_mix[i])
        j = i // N_MIXERS
        if i % N_MIXERS == 0:
            mix = gla_mixer(hn, gla_w_in[j], gla_w_gate_up[j], gla_b_gate[j],
                            gla_norm[j], gla_w_out[j])
        else:
            lambda_init = 0.8 - 0.6 * math.exp(-0.3 * i)
            mix = diff_mixer(hn, positions, diff_w_in[j], diff_lambda_q1[j], diff_lambda_k1[j],
                             diff_lambda_q2[j], diff_lambda_k2[j], diff_norm[j], diff_w_out[j],
                             lambda_init)
        h = h + mix.astype(h.dtype)
        ff = peer(rmsnorm(h, norm_ffn[i]), peer_w_query[i], peer_sub_keys[i], peer_u[i], peer_v[i])
        h = h + ff.astype(h.dtype)
    return rmsnorm(h, norm_final)
```

```cpp
#include <hip/hip_runtime.h>
#include <stdint.h>

#define DI __device__ __forceinline__
typedef unsigned short u16;
typedef __attribute__((ext_vector_type(8))) short bf16x8;
typedef __attribute__((ext_vector_type(16))) float f32x16;
typedef __attribute__((ext_vector_type(2))) __bf16 bf2_t;
typedef __attribute__((ext_vector_type(4))) unsigned u32x4;
typedef __attribute__((ext_vector_type(2))) unsigned u32x2;
typedef __attribute__((ext_vector_type(4))) float f32x4;
#define MFMA32(a, b, c) __builtin_amdgcn_mfma_f32_32x32x16_bf16((a), (b), (c), 0, 0, 0)

constexpr int T_TOK = 32768, SEQ = 16384, DM = 1024;
constexpr int GLA_NPAD = 3200;
constexpr int NTHR = 256;

constexpr size_t MB = 1024ull * 1024ull;
constexpr size_t WS_BAR    = 0;
constexpr size_t WS_ROPE   = 64 * 1024;
constexpr size_t WS_WGIN   = WS_ROPE + 2 * MB;
constexpr size_t WS_WGOUT  = WS_WGIN + (size_t)GLA_NPAD * 1024 * 2;
constexpr size_t WS_WDIN   = WS_WGOUT + 2 * MB;
constexpr size_t WS_WDOUT  = WS_WDIN + 6 * MB;
constexpr size_t WS_WPQ    = WS_WDOUT + 2 * MB;
constexpr size_t WS_SK     = WS_WPQ + 8 * MB;
constexpr size_t WS_GLR    = WS_SK + 1 * MB;
constexpr size_t WS_DEC    = WS_GLR + 2 * MB;
constexpr size_t WS_TAB    = WS_DEC + 1 * MB;
constexpr size_t WS_HN     = WS_TAB + 64 * MB;
constexpr size_t WS_PROJ   = WS_HN + 64 * MB;
constexpr size_t WS_KV     = WS_PROJ + 192 * MB;
constexpr size_t WS_END    = WS_KV + 128 * MB;
static_assert(WS_END <= 512 * MB, "workspace overflow");
constexpr size_t WS_VT     = WS_PROJ + 128 * MB;
constexpr size_t WS_IDX    = WS_KV;
constexpr size_t WS_GATE   = WS_KV + 16 * MB;

struct Params {
    const float* x; const int* pos; const float* norm_mix; const float* norm_ffn; const float* norm_final;
    const float* gla_w_in; const float* gla_wgu; const float* gla_bg; const float* gla_norm; const float* gla_w_out;
    const float* diff_w_in; const float* lq1; const float* lk1; const float* lq2; const float* lk2;
    const float* diff_norm; const float* diff_w_out;
    const float* peer_wq; const float* peer_sk; const float* peer_u; const float* peer_v;
    float* out; char* ws;
};

DI unsigned pk2(float a, float b) { bf2_t v = {(__bf16)a, (__bf16)b}; return __builtin_bit_cast(unsigned, v); }
DI u16 f2bf(float a) { return (u16)(pk2(a, 0.f) & 0xffffu); }
DI float bflo(unsigned w) { return __uint_as_float(w << 16); }
DI float bfhi(unsigned w) { return __uint_as_float(w & 0xffff0000u); }
DI float bf2f(u16 h) { return __uint_as_float(((unsigned)h) << 16); }
DI int crow(int i, int half) { return (i & 3) + 8 * (i >> 2) + 4 * half; }
DI float wave_sum(float v) { for (int o = 32; o > 0; o >>= 1) v += __shfl_xor(v, o); return v; }
DI f32x16 zero16() { f32x16 z; for (int i = 0; i < 16; ++i) z[i] = 0.f; return z; }
DI bf16x8 lds_frag(const char* p) { return *(const bf16x8*)p; }
DI bf16x8 lds_frag2(const char* p0, const char* p1) {
    u32x2 a = *(const u32x2*)p0, b = *(const u32x2*)p1; u32x4 r = {a.x, a.y, b.x, b.y}; return __builtin_bit_cast(bf16x8, r);
}
DI bf16x8 pack8(const f32x16& x, int s) {
    u32x4 r = {pk2(x[8 * s], x[8 * s + 1]), pk2(x[8 * s + 2], x[8 * s + 3]), pk2(x[8 * s + 4], x[8 * s + 5]), pk2(x[8 * s + 6], x[8 * s + 7])};
    return __builtin_bit_cast(bf16x8, r);
}
DI void rmsnorm_row_bf16(const float* __restrict__ src, const float* __restrict__ g, u16* __restrict__ dst, int lane) {
    const f32x4* xr = (const f32x4*)src;
    f32x4 a0 = xr[lane * 2], a1 = xr[lane * 2 + 1], b0 = xr[128 + lane * 2], b1 = xr[128 + lane * 2 + 1];
    float ss = a0.x * a0.x + a0.y * a0.y + a0.z * a0.z + a0.w * a0.w + a1.x * a1.x + a1.y * a1.y + a1.z * a1.z + a1.w * a1.w
             + b0.x * b0.x + b0.y * b0.y + b0.z * b0.z + b0.w * b0.w + b1.x * b1.x + b1.y * b1.y + b1.z * b1.z + b1.w * b1.w;
    ss = wave_sum(ss);
    const float r = rsqrtf(ss * (1.f / 1024.f) + 1e-6f);
    const f32x4* gr = (const f32x4*)g;
    f32x4 g0 = gr[lane * 2], g1 = gr[lane * 2 + 1], g2 = gr[128 + lane * 2], g3 = gr[128 + lane * 2 + 1];
    u32x4 o0 = u32x4{pk2(a0.x * r * g0.x, a0.y * r * g0.y), pk2(a0.z * r * g0.z, a0.w * r * g0.w), pk2(a1.x * r * g1.x, a1.y * r * g1.y), pk2(a1.z * r * g1.z, a1.w * r * g1.w)};
    u32x4 o1 = u32x4{pk2(b0.x * r * g2.x, b0.y * r * g2.y), pk2(b0.z * r * g2.z, b0.w * r * g2.w), pk2(b1.x * r * g3.x, b1.y * r * g3.y), pk2(b1.z * r * g3.z, b1.w * r * g3.w)};
    ((u32x4*)dst)[lane] = o0;
    ((u32x4*)dst)[64 + lane] = o1;
}

DI void tconv_item(const float* __restrict__ src, u16* __restrict__ dst, int K, int N, int item, int lane) {
    const int kgroups = K >> 3;
    const int ng = item / kgroups, kg = item - ng * kgroups;
    const int n = ng * 64 + lane, k0 = kg * 8;
    float v[8];
#pragma unroll
    for (int i = 0; i < 8; ++i) v[i] = (n < N) ? src[(size_t)(k0 + i) * N + n] : 0.f;
    u32x4 o = u32x4{pk2(v[0], v[1]), pk2(v[2], v[3]), pk2(v[4], v[5]), pk2(v[6], v[7])};
    *(u32x4*)(dst + (size_t)n * K + k0) = o;
}

DI void conv8(const float* __restrict__ src, u16* __restrict__ dst, size_t i8) {
    const f32x4* s = (const f32x4*)(src + i8 * 8);
    f32x4 a = s[0], b = s[1];
    *(u32x4*)(dst + i8 * 8) = u32x4{pk2(a.x, a.y), pk2(a.z, a.w), pk2(b.x, b.y), pk2(b.z, b.w)};
}

DI void phase_prep(const Params& p, int bid, int nb) {
    const int wave = threadIdx.x >> 6, lane = threadIdx.x & 63;
    const int gw = bid * 4 + wave, nw = nb * 4;
    char* ws = p.ws;
    for (int t = gw; t < T_TOK; t += nw) rmsnorm_row_bf16(p.x + (size_t)t * DM, p.norm_mix, (u16*)(ws + WS_HN) + (size_t)t * DM, lane);
    {
        const int n0 = (GLA_NPAD / 64) * 128, n1 = n0 + 16 * 128, n2 = n1 + 48 * 128, n3 = n2 + 16 * 128, n4 = n3 + 32 * 128, n5 = n4 + 32 * 128;
        for (int it = gw; it < n5; it += nw) {
            if (it < n0)      tconv_item(p.gla_w_in, (u16*)(ws + WS_WGIN), 1024, 3088, it, lane);
            else if (it < n1) tconv_item(p.gla_w_out, (u16*)(ws + WS_WGOUT), 1024, 1024, it - n0, lane);
            else if (it < n2) tconv_item(p.diff_w_in, (u16*)(ws + WS_WDIN), 1024, 3072, it - n1, lane);
            else if (it < n3) tconv_item(p.diff_w_out, (u16*)(ws + WS_WDOUT), 1024, 1024, it - n2, lane);
            else if (it < n4) tconv_item(p.peer_wq, (u16*)(ws + WS_WPQ), 1024, 2048, it - n3, lane);
            else              tconv_item(p.peer_wq + (size_t)1024 * 2048, (u16*)(ws + WS_WPQ) + (size_t)2048 * 1024, 1024, 2048, it - n4, lane);
        }
    }
    for (int i = gw * 64 + lane; i < 65536; i += nw * 64) conv8(p.peer_sk, (u16*)(ws + WS_SK), (size_t)i);
    for (int i = gw * 64 + lane; i < T_TOK * 8; i += nw * 64) {
        const int t = i >> 3, f = i & 7;
        const float inv = exp2f(-(float)f * (18.931568569324174f / 8.f));
        const float ang = (float)p.pos[t] * inv;
        float sn, cs; sincosf(ang, &sn, &cs);
        ((float2*)(ws + WS_ROPE))[i] = make_float2(cs, sn);
    }
}

DI void phase_tabconv(const Params& p, int layer, int bid, int nb) {
    const size_t n8 = (size_t)16384 * 1024 / 8;
    const float* su = p.peer_u + (size_t)layer * 16384 * 1024;
    const float* sv = p.peer_v + (size_t)layer * 16384 * 1024;
    u16* du = (u16*)(p.ws + WS_TAB); u16* dv = du + (size_t)16384 * 1024;
    for (size_t i = (size_t)bid * NTHR + threadIdx.x; i < n8; i += (size_t)nb * NTHR) { conv8(su, du, i); conv8(sv, dv, i); }
}

DI void phase_rmsnorm(const Params& p, const float* g, int bid, int nb) {
    const int wave = threadIdx.x >> 6, lane = threadIdx.x & 63;
    for (int t = bid * 4 + wave; t < T_TOK; t += nb * 4) rmsnorm_row_bf16(p.out + (size_t)t * DM, g, (u16*)(p.ws + WS_HN) + (size_t)t * DM, lane);
}
constexpr int G_LDS_ROW = 144;
constexpr int G_LDS_TILE = 128 * G_LDS_ROW;
constexpr int G_LDS_BYTES = 2 * G_LDS_TILE;

template <int WM, int WN>
DI void gemm_mainloop(const u16* __restrict__ A, int lda, const u16* __restrict__ Bt, int ldb, int K, char* smem, int wm0, int wn0, f32x16 (&acc)[WM][WN]) {
    const int tid = threadIdx.x, lane = tid & 63, r = lane & 31, half = lane >> 5;
    char* As = smem; char* Bs = smem + G_LDS_TILE;
    const int srow = tid >> 3, skc = tid & 7;
    const u16* ag = A + (size_t)srow * lda + skc * 8;
    const u16* bg = Bt + (size_t)srow * ldb + skc * 8;
    const int soff = srow * G_LDS_ROW + skc * 16;
    u32x4 ra[4], rb[4];
#pragma unroll
    for (int i = 0; i < 4; ++i) { ra[i] = *(const u32x4*)(ag + (size_t)(32 * i) * lda); rb[i] = *(const u32x4*)(bg + (size_t)(32 * i) * ldb); }
    const int nk = K >> 6;
    for (int kt = 0; kt < nk; ++kt) {
        __syncthreads();
#pragma unroll
        for (int i = 0; i < 4; ++i) { *(u32x4*)(As + soff + 32 * i * G_LDS_ROW) = ra[i]; *(u32x4*)(Bs + soff + 32 * i * G_LDS_ROW) = rb[i]; }
        __syncthreads();
        if (kt + 1 < nk) {
            const int ko = (kt + 1) * 64;
#pragma unroll
            for (int i = 0; i < 4; ++i) { ra[i] = *(const u32x4*)(ag + (size_t)(32 * i) * lda + ko); rb[i] = *(const u32x4*)(bg + (size_t)(32 * i) * ldb + ko); }
        }
#pragma unroll
        for (int ks = 0; ks < 4; ++ks) {
            bf16x8 af[WM], bfr[WN];
#pragma unroll
            for (int i = 0; i < WM; ++i) af[i] = lds_frag(As + (wm0 + 32 * i + r) * G_LDS_ROW + ks * 32 + half * 16);
#pragma unroll
            for (int j = 0; j < WN; ++j) bfr[j] = lds_frag(Bs + (wn0 + 32 * j + r) * G_LDS_ROW + ks * 32 + half * 16);
#pragma unroll
            for (int i = 0; i < WM; ++i)
#pragma unroll
                for (int j = 0; j < WN; ++j) acc[i][j] = MFMA32(af[i], bfr[j], acc[i][j]);
        }
    }
}

enum { EPI_GLA_IN = 0, EPI_RESID = 1, EPI_DIFF_IN = 2 };

template <int EPI>
DI void gemm_phase(const Params& p, const u16* A, const u16* Bt, int N, const float* resid, char* smem, int bid, int nb) {
    const int ntn = N / 128, ntm = T_TOK / 128;
    const int tid = threadIdx.x, wave = tid >> 6, lane = tid & 63, r = lane & 31, half = lane >> 5;
    const int wm0 = (wave >> 1) * 64, wn0 = (wave & 1) * 64;
    for (int u = bid; u < ntn * ntm; u += nb) {
        const int mt = u / ntn, nt = u - mt * ntn;
        const int m0 = mt * 128, n0 = nt * 128;
        f32x16 acc[2][2];
#pragma unroll
        for (int i = 0; i < 2; ++i)
#pragma unroll
            for (int j = 0; j < 2; ++j) acc[i][j] = zero16();
        gemm_mainloop<2, 2>(A + (size_t)m0 * 1024, 1024, Bt + (size_t)n0 * 1024, 1024, 1024, smem, wm0, wn0, acc);
#pragma unroll
        for (int ti = 0; ti < 2; ++ti)
#pragma unroll
            for (int tj = 0; tj < 2; ++tj) {
                const int col = n0 + wn0 + 32 * tj + r;
                const int rowb = m0 + wm0 + 32 * ti;
                if constexpr (EPI == EPI_GLA_IN) {
                    if (col < 3072) {
                        u16* o = (u16*)(p.ws + WS_PROJ);
#pragma unroll
                        for (int i = 0; i < 16; ++i) o[(size_t)(rowb + crow(i, half)) * 3072 + col] = f2bf(acc[ti][tj][i]);
                    } else if (col < 3088) {
                        float* o = (float*)(p.ws + WS_GLR);
#pragma unroll
                        for (int i = 0; i < 16; ++i) o[(size_t)(rowb + crow(i, half)) * 16 + (col - 3072)] = acc[ti][tj][i];
                    }
                } else if constexpr (EPI == EPI_RESID) {
#pragma unroll
                    for (int i = 0; i < 16; ++i) {
                        const size_t off = (size_t)(rowb + crow(i, half)) * 1024 + col;
                        p.out[off] = resid[off] + acc[ti][tj][i];
                    }
                } else if constexpr (EPI == EPI_DIFF_IN) {
                    if (col < 2048) {
                        const int c64 = col & 63;
                        const float qs = (col < 1024) ? 0.125f * 1.4426950408889634f : 1.0f;
                        const float2* cst = (const float2*)(p.ws + WS_ROPE);
                        u16* o = (u16*)(p.ws + WS_PROJ);
#pragma unroll
                        for (int i = 0; i < 16; ++i) {
                            const int row = rowb + crow(i, half);
                            float v = acc[ti][tj][i];
                            const float pv = __shfl_xor(v, 8);
                            if (c64 < 16) {
                                const float2 cs = cst[(size_t)row * 8 + (c64 & 7)];
                                v = (c64 < 8) ? (v * cs.x - pv * cs.y) : (v * cs.x + pv * cs.y);
                            }
                            o[(size_t)row * 2048 + col] = f2bf(v * qs);
                        }
                    } else {
                        const int hv = (col - 2048) >> 7, dv = (col - 2048) & 127;
                        const int b = rowb >> 14, s0 = rowb & (SEQ - 1);
                        u16* o = (u16*)(p.ws + WS_VT) + ((size_t)(b * 8 + hv) * 128 + dv) * SEQ + s0;
#pragma unroll
                        for (int g = 0; g < 4; ++g) {
                            u32x2 w = {pk2(acc[ti][tj][4 * g], acc[ti][tj][4 * g + 1]), pk2(acc[ti][tj][4 * g + 2], acc[ti][tj][4 * g + 3])};
                            *(u32x2*)(o + 8 * g + 4 * half) = w;
                        }
                    }
                }
            }
    }
}
constexpr int CUM_LD = 129;

DI float log_sigmoid(float z) { return fminf(z, 0.f) - log1pf(__expf(-fabsf(z))); }

DI void gla_cum(const Params& p, int tok0, int h, float* cumL, float* glrL) {
    const int tid = threadIdx.x, d = tid & 127, part = tid >> 7;
    const float* glr = (const float*)(p.ws + WS_GLR) + (size_t)tok0 * 16;
    ((f32x4*)glrL)[tid] = ((const f32x4*)glr)[tid];
    float w[16];
#pragma unroll
    for (int q = 0; q < 16; ++q) w[q] = p.gla_wgu[q * 512 + h * 128 + d];
    const float bias = p.gla_bg[h * 128 + d];
    __syncthreads();
    float run = 0.f;
    for (int c = part * 32; c < part * 32 + 32; ++c) {
        float z = bias;
#pragma unroll
        for (int q = 0; q < 16; ++q) z += glrL[c * 16 + q] * w[q];
        run += log_sigmoid(z) * (1.f / 16.f);
        cumL[c * CUM_LD + d] = run;
    }
    __syncthreads();
    if (part == 1) {
        const float add = cumL[31 * CUM_LD + d];
        for (int c = 32; c < 64; ++c) cumL[c * CUM_LD + d] += add;
    }
    __syncthreads();
}

DI void gla_pass1(const Params& p, char* smem, int bid, int nb) {
    const int tid = threadIdx.x, wave = tid >> 6, lane = tid & 63, r = lane & 31, half = lane >> 5;
    float* cumL = (float*)smem; char* vT = smem; char* kdT = smem + 36864; float* glrL = (float*)(smem + 36864);
    const u16* proj = (const u16*)(p.ws + WS_PROJ);
    for (int u = bid; u < 2048; u += nb) {
        const int bh = u >> 8, n = u & 255, b = bh >> 2, h = bh & 3;
        const int tok0 = b * SEQ + n * 64;
        __syncthreads();
        gla_cum(p, tok0, h, cumL, glrL);
        if (tid < 128) ((float*)(p.ws + WS_DEC))[(size_t)u * 128 + tid] = __expf(cumL[63 * CUM_LD + tid]);
#pragma unroll 1
        for (int it = 0; it < 4; ++it) {
            const int d0 = (wave + 4 * it) * 8;
            const u32x4 kreg = *(const u32x4*)(proj + (size_t)(tok0 + lane) * 3072 + 512 + h * 128 + d0);
            const unsigned wv[4] = {kreg.x, kreg.y, kreg.z, kreg.w};
            const float* cl = cumL + 63 * CUM_LD + d0; const float* cc = cumL + lane * CUM_LD + d0;
            char* dst = kdT + (d0 * 72 + lane) * 2;
#pragma unroll
            for (int i = 0; i < 8; ++i) {
                const float kv = (i & 1) ? bfhi(wv[i >> 1]) : bflo(wv[i >> 1]);
                const float e = __expf(cl[i] - cc[i]);
                *(u16*)(dst + i * 144) = f2bf(kv * e);
            }
        }
        __syncthreads();
#pragma unroll 1
        for (int it = 0; it < 8; ++it) {
            const int v0 = (wave + 4 * it) * 8;
            const u32x4 vr = *(const u32x4*)(proj + (size_t)(tok0 + lane) * 3072 + 1024 + h * 256 + v0);
            const unsigned wv[4] = {vr.x, vr.y, vr.z, vr.w};
            char* dst = vT + (v0 * 72 + lane) * 2;
#pragma unroll
            for (int i = 0; i < 8; ++i) *(u16*)(dst + i * 144) = (u16)((i & 1) ? (wv[i >> 1] >> 16) : (wv[i >> 1] & 0xffffu));
        }
        __syncthreads();
        u16* kvo = (u16*)(p.ws + WS_KV) + (size_t)u * 32768;
#pragma unroll 1
        for (int jh = 0; jh < 2; ++jh) {
            f32x16 acc[2][2];
#pragma unroll
            for (int i = 0; i < 2; ++i)
#pragma unroll
                for (int j = 0; j < 2; ++j) acc[i][j] = zero16();
#pragma unroll
            for (int ks = 0; ks < 4; ++ks) {
                bf16x8 af[2], bfr[2];
#pragma unroll
                for (int i = 0; i < 2; ++i) af[i] = lds_frag(vT + (64 * wave + 32 * i + r) * 144 + ks * 32 + half * 16);
#pragma unroll
                for (int j = 0; j < 2; ++j) bfr[j] = lds_frag(kdT + (64 * jh + 32 * j + r) * 144 + ks * 32 + half * 16);
#pragma unroll
                for (int i = 0; i < 2; ++i)
#pragma unroll
                    for (int j = 0; j < 2; ++j) acc[i][j] = MFMA32(af[i], bfr[j], acc[i][j]);
            }
#pragma unroll
            for (int i = 0; i < 2; ++i)
#pragma unroll
                for (int j = 0; j < 2; ++j)
#pragma unroll
                    for (int q = 0; q < 16; ++q) kvo[(64 * wave + 32 * i + crow(q, half)) * 128 + 64 * jh + 32 * j + r] = f2bf(acc[i][j][q]);
        }
    }
}

DI void gla_scan(const Params& p, int bid, int nb) {
    u16* kv = (u16*)(p.ws + WS_KV);
    const float* dec = (const float*)(p.ws + WS_DEC);
    for (int g = bid * NTHR + threadIdx.x; g < 32768; g += nb * NTHR) {
        const int bh = g >> 12, rem = g & 4095;
        const int dch = rem & 15;
        float st[8];
#pragma unroll
        for (int i = 0; i < 8; ++i) st[i] = 0.f;
        const size_t base = (size_t)bh * 256 * 32768 + (size_t)rem * 8;
        const float* dbase = dec + (size_t)bh * 256 * 128 + dch * 8;
        for (int n0 = 0; n0 < 256; n0 += 8) {
            u32x4 kk[8]; f32x4 d0[8], d1[8];
#pragma unroll
            for (int j = 0; j < 8; ++j) {
                kk[j] = *(const u32x4*)(kv + base + (size_t)(n0 + j) * 32768);
                d0[j] = *(const f32x4*)(dbase + (size_t)(n0 + j) * 128);
                d1[j] = *(const f32x4*)(dbase + (size_t)(n0 + j) * 128 + 4);
            }
#pragma unroll
            for (int j = 0; j < 8; ++j) {
                const u32x4 o = u32x4{pk2(st[0], st[1]), pk2(st[2], st[3]), pk2(st[4], st[5]), pk2(st[6], st[7])};
                *(u32x4*)(kv + base + (size_t)(n0 + j) * 32768) = o;
                const float dd[8] = {d0[j].x, d0[j].y, d0[j].z, d0[j].w, d1[j].x, d1[j].y, d1[j].z, d1[j].w};
                const unsigned wv[4] = {kk[j].x, kk[j].y, kk[j].z, kk[j].w};
#pragma unroll
                for (int i = 0; i < 8; ++i) st[i] = dd[i] * st[i] + ((i & 1) ? bfhi(wv[i >> 1]) : bflo(wv[i >> 1]));
            }
        }
    }
}

DI void gla_pass3(const Params& p, char* smem, int bid, int nb) {
    const int tid = threadIdx.x, wave = tid >> 6, lane = tid & 63, r = lane & 31, half = lane >> 5;
    float* cumL = (float*)smem; char* vT = smem; char* aM = smem + 18432; char* qd = smem + 36864; char* kq = smem + 54272; float* glrL = (float*)(smem + 36864);
    float* oL = (float*)smem;
    const u16* proj = (const u16*)(p.ws + WS_PROJ);
    const float scale = 0.08838834764831845f;
    for (int u = bid; u < 2048; u += nb) {
        const int bh = u >> 8, n = u & 255, b = bh >> 2, h = bh & 3;
        const int tok0 = b * SEQ + n * 64;
        __syncthreads();
        gla_cum(p, tok0, h, cumL, glrL);
#pragma unroll
        for (int it = 0; it < 4; ++it) {
            const int id = tid + 256 * it, c = id >> 4, dch = id & 15;
            const u32x4 qr = *(const u32x4*)(proj + (size_t)(tok0 + c) * 3072 + h * 128 + dch * 8);
            const u32x4 kr = *(const u32x4*)(proj + (size_t)(tok0 + c) * 3072 + 512 + h * 128 + dch * 8);
            const unsigned qw[4] = {qr.x, qr.y, qr.z, qr.w}, kw[4] = {kr.x, kr.y, kr.z, kr.w};
            unsigned qo[4], ko[4];
#pragma unroll
            for (int i = 0; i < 4; ++i) {
                const int d = dch * 8 + 2 * i;
                const float e0 = cumL[c * CUM_LD + d] - cumL[31 * CUM_LD + d], e1 = cumL[c * CUM_LD + d + 1] - cumL[31 * CUM_LD + d + 1];
                qo[i] = pk2(bflo(qw[i]) * scale * __expf(e0), bfhi(qw[i]) * scale * __expf(e1));
                ko[i] = pk2(bflo(kw[i]) * __expf(-e0), bfhi(kw[i]) * __expf(-e1));
            }
            *(u32x4*)(qd + c * 272 + dch * 16) = u32x4{qo[0], qo[1], qo[2], qo[3]};
            *(u32x4*)(kq + c * 272 + dch * 16) = u32x4{ko[0], ko[1], ko[2], ko[3]};
        }
        __syncthreads();
        const int rb = wave >> 1, cb = wave & 1;
        f32x16 aacc = zero16();
        if (cb <= rb) {
#pragma unroll
            for (int ks = 0; ks < 8; ++ks) {
                const bf16x8 af = lds_frag(qd + (32 * rb + r) * 272 + ks * 32 + half * 16);
                const bf16x8 bf = lds_frag(kq + (32 * cb + r) * 272 + ks * 32 + half * 16);
                aacc = MFMA32(af, bf, aacc);
            }
        }
        __syncthreads();
#pragma unroll
        for (int it = 0; it < 4; ++it) {
            const int id = tid + 256 * it, c = id >> 4, dch = id & 15;
            const u32x4 qr = *(const u32x4*)(proj + (size_t)(tok0 + c) * 3072 + h * 128 + dch * 8);
            const unsigned qw[4] = {qr.x, qr.y, qr.z, qr.w};
            unsigned qo[4];
#pragma unroll
            for (int i = 0; i < 4; ++i) {
                const int d = dch * 8 + 2 * i;
                qo[i] = pk2(bflo(qw[i]) * scale * __expf(cumL[c * CUM_LD + d]), bfhi(qw[i]) * scale * __expf(cumL[c * CUM_LD + d + 1]));
            }
            *(u32x4*)(kq + c * 272 + dch * 16) = u32x4{qo[0], qo[1], qo[2], qo[3]};
        }
        __syncthreads();
#pragma unroll
        for (int q = 0; q < 16; ++q) {
            const int c = 32 * rb + crow(q, half), j = 32 * cb + r;
            *(u16*)(aM + (c * 72 + j) * 2) = f2bf((j <= c) ? aacc[q] : 0.f);
        }
        f32x16 o[2][2];
#pragma unroll
        for (int i = 0; i < 2; ++i)
#pragma unroll
            for (int j = 0; j < 2; ++j) o[i][j] = zero16();
        const u16* st = (const u16*)(p.ws + WS_KV) + (size_t)u * 32768;
#pragma unroll
        for (int ps = 0; ps < 2; ++ps) {
            if (ps == 1) __syncthreads();
#pragma unroll 1
            for (int it = 0; it < 4; ++it) {
                const int q = wave + 4 * it, wq = q >> 2, vv0 = (q & 3) * 8;
                const u32x4 vr = *(const u32x4*)(proj + (size_t)(tok0 + lane) * 3072 + 1024 + h * 256 + 64 * wq + 32 * ps + vv0);
                const unsigned wv[4] = {vr.x, vr.y, vr.z, vr.w};
                char* dst = vT + ((wq * 32 + vv0) * 72 + lane) * 2;
#pragma unroll
                for (int i = 0; i < 8; ++i) *(u16*)(dst + i * 144) = (u16)((i & 1) ? (wv[i >> 1] >> 16) : (wv[i >> 1] & 0xffffu));
            }
            __syncthreads();
#pragma unroll
            for (int ks = 0; ks < 4; ++ks) {
                const bf16x8 bf = lds_frag(vT + (wave * 32 + r) * 144 + ks * 32 + half * 16);
#pragma unroll
                for (int i = 0; i < 2; ++i) {
                    const bf16x8 af = lds_frag(aM + (32 * i + r) * 144 + ks * 32 + half * 16);
                    o[ps][i] = MFMA32(af, bf, o[ps][i]);
                }
            }
#pragma unroll
            for (int ks = 0; ks < 8; ++ks) {
                const u32x4 sv = *(const u32x4*)(st + (size_t)(64 * wave + 32 * ps + r) * 128 + ks * 16 + half * 8);
                const bf16x8 bf = __builtin_bit_cast(bf16x8, sv);
#pragma unroll
                for (int i = 0; i < 2; ++i) {
                    const bf16x8 af = lds_frag(kq + (32 * i + r) * 272 + ks * 32 + half * 16);
                    o[ps][i] = MFMA32(af, bf, o[ps][i]);
                }
            }
        }
        __syncthreads();
#pragma unroll
        for (int ps = 0; ps < 2; ++ps)
#pragma unroll
            for (int i = 0; i < 2; ++i)
#pragma unroll
                for (int q = 0; q < 16; ++q) oL[(32 * i + crow(q, half)) * 260 + 64 * wave + 32 * ps + r] = o[ps][i][q];
        __syncthreads();
        {
            const int c = tid >> 2, qq = tid & 3;
            f32x4 vals[16]; float ss = 0.f;
#pragma unroll
            for (int j = 0; j < 16; ++j) {
                vals[j] = *(const f32x4*)(oL + c * 260 + 16 * j + 4 * qq);
                ss += vals[j].x * vals[j].x + vals[j].y * vals[j].y + vals[j].z * vals[j].z + vals[j].w * vals[j].w;
            }
            ss += __shfl_xor(ss, 1); ss += __shfl_xor(ss, 2);
            const float rinv = rsqrtf(ss * (1.f / 256.f) + 1e-6f);
            const u16* rrow = proj + (size_t)(tok0 + c) * 3072 + 2048 + h * 256;
            const float* gn = p.gla_norm + h * 256;
            u16* orow = (u16*)(p.ws + WS_HN) + (size_t)(tok0 + c) * 1024 + h * 256;
#pragma unroll
            for (int j = 0; j < 16; ++j) {
                const int v0 = 16 * j + 4 * qq;
                const u32x2 rr = *(const u32x2*)(rrow + v0);
                const f32x4 g4 = *(const f32x4*)(gn + v0);
                const float r0 = bflo(rr.x), r1 = bfhi(rr.x), r2 = bflo(rr.y), r3 = bfhi(rr.y);
                const float o0 = vals[j].x * rinv * g4.x * (r0 / (1.f + __expf(-r0)));
                const float o1 = vals[j].y * rinv * g4.y * (r1 / (1.f + __expf(-r1)));
                const float o2 = vals[j].z * rinv * g4.z * (r2 / (1.f + __expf(-r2)));
                const float o3 = vals[j].w * rinv * g4.w * (r3 / (1.f + __expf(-r3)));
                *(u32x2*)(orow + v0) = u32x2{pk2(o0, o1), pk2(o2, o3)};
            }
        }
    }
}
DI unsigned sortable(float v) { const unsigned u = __float_as_uint(v); return (u & 0x80000000u) ? ~u : (u | 0x80000000u); }
DI float unsortable(unsigned k) { const unsigned u = (k & 0x80000000u) ? (k & 0x7fffffffu) : ~k; return __uint_as_float(u); }
DI void ins16(unsigned (&L)[16], unsigned x) {
#pragma unroll
    for (int i = 0; i < 16; ++i) { const unsigned hi = max(L[i], x); x = min(L[i], x); L[i] = hi; }
}

constexpr int PQ_LDS_BYTES = G_LDS_BYTES + 128 * 272;
DI void peer_query_phase(const Params& p, int layer, char* smem, int bid, int nb) {
    const int tid = threadIdx.x, wave = tid >> 6, lane = tid & 63, r = lane & 31, half = lane >> 5;
    const u16* hn = (const u16*)(p.ws + WS_HN);
    const u16* wq = (const u16*)(p.ws + WS_WPQ) + (size_t)layer * 2048 * 1024;
    const u16* sk = (const u16*)(p.ws + WS_SK) + (size_t)layer * 8 * 2 * 128 * 128;
    char* Bk = smem + G_LDS_BYTES;
    for (int u = bid; u < 2048; u += nb) {
        const int tb = u >> 3, h = u & 7;
        unsigned Lp[2][16];
#pragma unroll
        for (int pp = 0; pp < 2; ++pp) {
            __syncthreads();
            const u16* skt = sk + (size_t)(h * 2 + pp) * 128 * 128;
#pragma unroll 1
            for (int it = 0; it < 8; ++it) {
                const int id = tid + 256 * it, n = id >> 4, ch = id & 15;
                *(u32x4*)(Bk + n * 272 + ch * 16) = *(const u32x4*)(skt + n * 128 + ch * 8);
            }
            f32x16 acc[4][1];
#pragma unroll
            for (int i = 0; i < 4; ++i) acc[i][0] = zero16();
            gemm_mainloop<4, 1>(wq + (size_t)((h * 2 + pp) * 128) * 1024, 1024, hn + (size_t)(tb * 128) * 1024, 1024, 1024, smem, 0, 32 * wave, acc);
            f32x16 sc[4];
#pragma unroll
            for (int i = 0; i < 4; ++i) sc[i] = zero16();
#pragma unroll
            for (int di = 0; di < 4; ++di)
#pragma unroll
                for (int s = 0; s < 2; ++s) {
                    const bf16x8 bq = pack8(acc[di][0], s);
#pragma unroll
                    for (int kb = 0; kb < 4; ++kb) {
                        const char* rowp = Bk + (32 * kb + r) * 272 + (32 * di + 16 * s + 4 * half) * 2;
                        const bf16x8 ak = lds_frag2(rowp, rowp + 16);
                        sc[kb] = MFMA32(ak, bq, sc[kb]);
                    }
                }
            unsigned L[16];
#pragma unroll
            for (int i = 0; i < 16; ++i) L[i] = 0u;
#pragma unroll
            for (int kb = 0; kb < 4; ++kb)
#pragma unroll
                for (int q = 0; q < 16; ++q) {
                    const int n = 32 * kb + crow(q, half);
                    ins16(L, (sortable(sc[kb][q]) & 0xffffff80u) | (unsigned)(127 - n));
                }
            unsigned O[16];
#pragma unroll
            for (int i = 0; i < 16; ++i) O[i] = __shfl_xor(L[i], 32);
#pragma unroll
            for (int i = 0; i < 16; ++i) ins16(L, O[i]);
#pragma unroll
            for (int i = 0; i < 16; ++i) Lp[pp][i] = L[i];
        }
        float s1[16], s2[16]; int i1[16], i2[16];
#pragma unroll
        for (int i = 0; i < 16; ++i) {
            s1[i] = unsortable(Lp[0][i] & 0xffffff80u); i1[i] = 127 - (int)(Lp[0][i] & 127u);
            s2[i] = unsortable(Lp[1][i] & 0xffffff80u); i2[i] = 127 - (int)(Lp[1][i] & 127u);
        }
        float bs[16]; int bi[16];
#pragma unroll
        for (int i = 0; i < 16; ++i) { bs[i] = -3.0e38f; bi[i] = 0; }
#define CAND2(a0, b0, a1, b1) { float xs = half ? (s1[a1] + s2[b1]) : (s1[a0] + s2[b0]); int xi = half ? (i1[a1] * 128 + i2[b1]) : (i1[a0] * 128 + i2[b0]); \
            _Pragma("unroll") for (int i = 0; i < 16; ++i) { const bool gt = xs > bs[i]; const float ts = gt ? bs[i] : xs; const int ti = gt ? bi[i] : xi; \
                bs[i] = gt ? xs : bs[i]; bi[i] = gt ? xi : bi[i]; xs = ts; xi = ti; } }
        CAND2(0, 0, 0, 1)
        CAND2(0, 2, 0, 3)
        CAND2(0, 4, 0, 5)
        CAND2(0, 6, 0, 7)
        CAND2(0, 8, 0, 9)
        CAND2(0, 10, 0, 11)
        CAND2(0, 12, 0, 13)
        CAND2(0, 14, 0, 15)
        CAND2(1, 0, 1, 1)
        CAND2(1, 2, 1, 3)
        CAND2(1, 4, 1, 5)
        CAND2(1, 6, 1, 7)
        CAND2(2, 0, 2, 1)
        CAND2(2, 2, 2, 3)
        CAND2(2, 4, 3, 0)
        CAND2(3, 1, 3, 2)
        CAND2(3, 3, 4, 0)
        CAND2(4, 1, 4, 2)
        CAND2(5, 0, 5, 1)
        CAND2(6, 0, 6, 1)
        CAND2(7, 0, 7, 1)
        CAND2(8, 0, 9, 0)
        CAND2(10, 0, 11, 0)
        CAND2(12, 0, 13, 0)
        CAND2(14, 0, 15, 0)
#undef CAND2
        {
            float os[16]; int oi[16];
#pragma unroll
            for (int i = 0; i < 16; ++i) { os[i] = __shfl_xor(bs[i], 32); oi[i] = __shfl_xor(bi[i], 32); }
#pragma unroll
            for (int j = 0; j < 16; ++j) {
                float xs = os[j]; int xi = oi[j];
#pragma unroll
                for (int i = 0; i < 16; ++i) {
                    const bool gt = xs > bs[i];
                    const float ts = gt ? bs[i] : xs; const int ti = gt ? bi[i] : xi;
                    bs[i] = gt ? xs : bs[i]; bi[i] = gt ? xi : bi[i];
                    xs = ts; xi = ti;
                }
            }
        }
        float den = 0.f, ex[16];
#pragma unroll
        for (int i = 0; i < 16; ++i) { ex[i] = __expf(bs[i] - bs[0]); den += ex[i]; }
        const float rden = 1.f / den;
        const int tok = tb * 128 + 32 * wave + r;
        int* io = (int*)(p.ws + WS_IDX) + (size_t)tok * 128 + h * 16 + 8 * half;
        float* go = (float*)(p.ws + WS_GATE) + (size_t)tok * 128 + h * 16 + 8 * half;
        if (half == 0) {
            *(u32x4*)(io) = u32x4{(unsigned)bi[0], (unsigned)bi[1], (unsigned)bi[2], (unsigned)bi[3]};
            *(u32x4*)(io + 4) = u32x4{(unsigned)bi[4], (unsigned)bi[5], (unsigned)bi[6], (unsigned)bi[7]};
            *(f32x4*)(go) = f32x4{ex[0] * rden, ex[1] * rden, ex[2] * rden, ex[3] * rden};
            *(f32x4*)(go + 4) = f32x4{ex[4] * rden, ex[5] * rden, ex[6] * rden, ex[7] * rden};
        } else {
            *(u32x4*)(io) = u32x4{(unsigned)bi[8], (unsigned)bi[9], (unsigned)bi[10], (unsigned)bi[11]};
            *(u32x4*)(io + 4) = u32x4{(unsigned)bi[12], (unsigned)bi[13], (unsigned)bi[14], (unsigned)bi[15]};
            *(f32x4*)(go) = f32x4{ex[8] * rden, ex[9] * rden, ex[10] * rden, ex[11] * rden};
            *(f32x4*)(go + 4) = f32x4{ex[12] * rden, ex[13] * rden, ex[14] * rden, ex[15] * rden};
        }
    }
}

DI float gelu_exact(float a) { return 0.5f * a * (1.f + erff(a * 0.7071067811865476f)); }
DI float dot8(const u32x4& w, const float (&x)[8]) {
    return bflo(w.x) * x[0] + bfhi(w.x) * x[1] + bflo(w.y) * x[2] + bfhi(w.y) * x[3] + bflo(w.z) * x[4] + bfhi(w.z) * x[5] + bflo(w.w) * x[6] + bfhi(w.w) * x[7];
}
DI void axpy8(float (&o)[8], float c, const u32x4& w) {
    o[0] += c * bflo(w.x); o[1] += c * bfhi(w.x); o[2] += c * bflo(w.y); o[3] += c * bfhi(w.y);
    o[4] += c * bflo(w.z); o[5] += c * bfhi(w.z); o[6] += c * bflo(w.w); o[7] += c * bfhi(w.w);
}
constexpr int PG_LDS_BYTES = 4096;
template <bool FINAL>
DI void peer_gather_phase(const Params& p, const float* gnext, char* smem, int bid, int nb) {
    const int wave = threadIdx.x >> 6, lane = threadIdx.x & 63;
    int* idxL = (int*)(smem + wave * 1024); float* cL = (float*)(smem + wave * 1024 + 512);
    const u16* tu = (const u16*)(p.ws + WS_TAB); const u16* tv = tu + (size_t)16384 * 1024;
    const u16* hn = (const u16*)(p.ws + WS_HN);
    for (int t = bid * 4 + wave; t < T_TOK; t += nb * 4) {
        const int* ig = (const int*)(p.ws + WS_IDX) + (size_t)t * 128;
        const float* gg = (const float*)(p.ws + WS_GATE) + (size_t)t * 128;
        idxL[lane] = ig[lane]; idxL[lane + 64] = ig[lane + 64];
        const float g0 = gg[lane], g1 = gg[lane + 64];
        const u32x4 xa = *(const u32x4*)(hn + (size_t)t * 1024 + 8 * lane), xb = *(const u32x4*)(hn + (size_t)t * 1024 + 512 + 8 * lane);
        float xlo[8] = {bflo(xa.x), bfhi(xa.x), bflo(xa.y), bfhi(xa.y), bflo(xa.z), bfhi(xa.z), bflo(xa.w), bfhi(xa.w)};
        float xhi[8] = {bflo(xb.x), bfhi(xb.x), bflo(xb.y), bfhi(xb.y), bflo(xb.z), bfhi(xb.z), bflo(xb.w), bfhi(xb.w)};
        float myd0 = 0.f, myd1 = 0.f;
#pragma unroll 1
        for (int bt = 0; bt < 16; ++bt) {
            float pr[8];
#pragma unroll
            for (int j = 0; j < 8; ++j) {
                const int e = idxL[bt * 8 + j];
                const u16* row = tu + (size_t)e * 1024;
                const u32x4 wa = *(const u32x4*)(row + 8 * lane), wb = *(const u32x4*)(row + 512 + 8 * lane);
                pr[j] = dot8(wa, xlo) + dot8(wb, xhi);
            }
            float q4[4], q2[2], q1;
            {
                const bool up = (lane & 32) != 0;
#pragma unroll
                for (int i = 0; i < 4; ++i) { const float send = up ? pr[i] : pr[i + 4]; const float keep = up ? pr[i + 4] : pr[i]; q4[i] = keep + __shfl_xor(send, 32); }
            }
            {
                const bool up = (lane & 16) != 0;
#pragma unroll
                for (int i = 0; i < 2; ++i) { const float send = up ? q4[i] : q4[i + 2]; const float keep = up ? q4[i + 2] : q4[i]; q2[i] = keep + __shfl_xor(send, 16); }
            }
            {
                const bool up = (lane & 8) != 0;
                const float send = up ? q2[0] : q2[1]; const float keep = up ? q2[1] : q2[0]; q1 = keep + __shfl_xor(send, 8);
            }
            q1 += __shfl_xor(q1, 4); q1 += __shfl_xor(q1, 2); q1 += __shfl_xor(q1, 1);
            const int jj = ((lane >> 5) & 1) * 4 + ((lane >> 4) & 1) * 2 + ((lane >> 3) & 1);
            if ((lane & 7) == 0) cL[bt * 8 + jj] = q1;
        }
        {
            const float d0 = cL[lane], d1 = cL[lane + 64];
            cL[lane] = g0 * gelu_exact(d0); cL[lane + 64] = g1 * gelu_exact(d1);
        }
        (void)myd0; (void)myd1;
        float olo[8], ohi[8];
#pragma unroll
        for (int i = 0; i < 8; ++i) { olo[i] = 0.f; ohi[i] = 0.f; }
#pragma unroll 1
        for (int bt = 0; bt < 16; ++bt) {
#pragma unroll
            for (int j = 0; j < 8; ++j) {
                const int e = idxL[bt * 8 + j]; const float c = cL[bt * 8 + j];
                const u16* row = tv + (size_t)e * 1024;
                const u32x4 wa = *(const u32x4*)(row + 8 * lane), wb = *(const u32x4*)(row + 512 + 8 * lane);
                axpy8(olo, c, wa); axpy8(ohi, c, wb);
            }
        }
        float* hr = p.out + (size_t)t * 1024;
        f32x4 h0 = *(f32x4*)(hr + 8 * lane), h1 = *(f32x4*)(hr + 8 * lane + 4), h2 = *(f32x4*)(hr + 512 + 8 * lane), h3 = *(f32x4*)(hr + 512 + 8 * lane + 4);
        h0 += f32x4{olo[0], olo[1], olo[2], olo[3]}; h1 += f32x4{olo[4], olo[5], olo[6], olo[7]};
        h2 += f32x4{ohi[0], ohi[1], ohi[2], ohi[3]}; h3 += f32x4{ohi[4], ohi[5], ohi[6], ohi[7]};
        float ss = h0.x * h0.x + h0.y * h0.y + h0.z * h0.z + h0.w * h0.w + h1.x * h1.x + h1.y * h1.y + h1.z * h1.z + h1.w * h1.w
                 + h2.x * h2.x + h2.y * h2.y + h2.z * h2.z + h2.w * h2.w + h3.x * h3.x + h3.y * h3.y + h3.z * h3.z + h3.w * h3.w;
        ss = wave_sum(ss);
        const float rn = rsqrtf(ss * (1.f / 1024.f) + 1e-6f);
        const f32x4 g0v = *(const f32x4*)(gnext + 8 * lane), g1v = *(const f32x4*)(gnext + 8 * lane + 4), g2v = *(const f32x4*)(gnext + 512 + 8 * lane), g3v = *(const f32x4*)(gnext + 512 + 8 * lane + 4);
        if constexpr (FINAL) {
            *(f32x4*)(hr + 8 * lane) = h0 * rn * g0v; *(f32x4*)(hr + 8 * lane + 4) = h1 * rn * g1v;
            *(f32x4*)(hr + 512 + 8 * lane) = h2 * rn * g2v; *(f32x4*)(hr + 512 + 8 * lane + 4) = h3 * rn * g3v;
        } else {
            *(f32x4*)(hr + 8 * lane) = h0; *(f32x4*)(hr + 8 * lane + 4) = h1; *(f32x4*)(hr + 512 + 8 * lane) = h2; *(f32x4*)(hr + 512 + 8 * lane + 4) = h3;
            const f32x4 n0 = h0 * rn * g0v, n1 = h1 * rn * g1v, n2 = h2 * rn * g2v, n3 = h3 * rn * g3v;
            u16* hno = (u16*)(p.ws + WS_HN) + (size_t)t * 1024;
            *(u32x4*)(hno + 8 * lane) = u32x4{pk2(n0.x, n0.y), pk2(n0.z, n0.w), pk2(n1.x, n1.y), pk2(n1.z, n1.w)};
            *(u32x4*)(hno + 512 + 8 * lane) = u32x4{pk2(n2.x, n2.y), pk2(n2.z, n2.w), pk2(n3.x, n3.y), pk2(n3.z, n3.w)};
        }
    }
}
constexpr int AT_LDS_BYTES = 17408 + 18432 + 34816;
constexpr float LAMBDA_INIT = 0.35550906759096927f;

DI void attn_map(const char* Ks, const char* VTs, int m, const char* Qw, f32x16 (&O)[4], float& mrun, float& lrun,
                 bool diag, int k0, int qidx, int r, int half) {
    f32x16 S[2];
#pragma unroll
    for (int kb = 0; kb < 2; ++kb) {
        S[kb] = zero16();
#pragma unroll
        for (int ks = 0; ks < 4; ++ks) {
            const bf16x8 a = lds_frag(Ks + (32 * kb + r) * 272 + m * 128 + ks * 32 + half * 16);
            const bf16x8 qf = lds_frag(Qw + m * 128 + ks * 32);
            S[kb] = MFMA32(a, qf, S[kb]);
        }
    }
    __builtin_amdgcn_sched_barrier(0);
    if (diag) {
#pragma unroll
        for (int kb = 0; kb < 2; ++kb)
#pragma unroll
            for (int i = 0; i < 16; ++i) if (k0 + 32 * kb + crow(i, half) > qidx) S[kb][i] = -INFINITY;
    }
    float mx = S[0][0];
#pragma unroll
    for (int kb = 0; kb < 2; ++kb)
#pragma unroll
        for (int i = 0; i < 16; ++i) mx = fmaxf(mx, S[kb][i]);
    mx = fmaxf(mx, __shfl_xor(mx, 32));
    const float mnew = fmaxf(mrun, mx);
    const float alpha = exp2f(mrun - mnew);
    float psum = 0.f;
#pragma unroll
    for (int kb = 0; kb < 2; ++kb)
#pragma unroll
        for (int i = 0; i < 16; ++i) { const float pv = exp2f(S[kb][i] - mnew); S[kb][i] = pv; psum += pv; }
    lrun = lrun * alpha + psum; mrun = mnew;
#pragma unroll
    for (int d = 0; d < 4; ++d) O[d] *= alpha;
    bf16x8 Pf[4];
    Pf[0] = pack8(S[0], 0); Pf[1] = pack8(S[0], 1); Pf[2] = pack8(S[1], 0); Pf[3] = pack8(S[1], 1);
    __builtin_amdgcn_sched_barrier(0);
#pragma unroll
    for (int ks2 = 0; ks2 < 4; ++ks2) {
#pragma unroll
        for (int d = 0; d < 4; ++d) {
            const char* rowp = VTs + (32 * d + r) * 144 + (16 * ks2 + 4 * half) * 2;
            const bf16x8 a = lds_frag2(rowp, rowp + 16);
            O[d] = MFMA32(a, Pf[ks2], O[d]);
        }
        __builtin_amdgcn_sched_barrier(0);
    }
}

DI void attn_phase(const Params& p, char* smem, int bid, int nb) {
    const int tid = threadIdx.x, wave = tid >> 6, lane = tid & 63, r = lane & 31, half = lane >> 5;
    char* Ks = smem; char* VTs = smem + 17408; char* Qs = smem + 35840;
    const u16* qk = (const u16*)(p.ws + WS_PROJ);
    const u16* vt = (const u16*)(p.ws + WS_VT);
    float lam;
    {
        const float a = p.lq1[lane] * p.lk1[lane], bq = p.lq2[lane] * p.lk2[lane];
        lam = __expf(wave_sum(a)) - __expf(wave_sum(bq)) + LAMBDA_INIT;
    }
    const int nrounds = (2048 + nb - 1) / nb;
    for (int j = 0; j < nrounds; ++j) {
        const int rank = j * nb + ((j & 1) ? (nb - 1 - bid) : bid);
        if (rank >= 2048) continue;
        const int qb = 127 - (rank >> 4), bh = rank & 15, b = bh >> 3, h = bh & 7;
        const int q0 = qb * 128, tokbase = b * SEQ, qlo = q0 + 32 * wave, qidx = qlo + r;
        __syncthreads();
#pragma unroll 1
        for (int i = 0; i < 8; ++i) {
            const int id = tid + 256 * i, row = id >> 4, ch = id & 15;
            *(u32x4*)(Qs + row * 272 + ch * 16) = *(const u32x4*)(qk + (size_t)(tokbase + q0 + row) * 2048 + h * 128 + ch * 8);
        }
        const char* Qw = Qs + (32 * wave + r) * 272 + half * 16;
        f32x16 O1[4], O2[4];
#pragma unroll
        for (int d = 0; d < 4; ++d) { O1[d] = zero16(); O2[d] = zero16(); }
        float m1 = -INFINITY, m2 = -INFINITY, l1 = 0.f, l2 = 0.f;
        const int nkt = 2 * (qb + 1);
        const u16* kbase = qk + (size_t)tokbase * 2048 + 1024 + h * 128;
        const u16* vbase = vt + (size_t)(b * 8 + h) * 128 * SEQ;
        for (int kt = 0; kt < nkt; ++kt) {
            const int k0 = kt * 64;
            __syncthreads();
#pragma unroll 1
            for (int i = 0; i < 4; ++i) {
                const int id = tid + 256 * i;
                const int key = id >> 4, ch = id & 15;
                *(u32x4*)(Ks + key * 272 + ch * 16) = *(const u32x4*)(kbase + (size_t)(k0 + key) * 2048 + ch * 8);
                const int dv = id >> 3, kc = id & 7;
                *(u32x4*)(VTs + dv * 144 + kc * 16) = *(const u32x4*)(vbase + (size_t)dv * SEQ + k0 + kc * 8);
            }
            __syncthreads();
            if (k0 <= qlo + 31) {
                const bool diag = (k0 + 63 > qlo);
                attn_map(Ks, VTs, 0, Qw, O1, m1, l1, diag, k0, qidx, r, half);
                attn_map(Ks, VTs, 1, Qw, O2, m2, l2, diag, k0, qidx, r, half);
            }
        }
        l1 += __shfl_xor(l1, 32); l2 += __shfl_xor(l2, 32);
        const float i1 = 1.f / l1, i2 = lam / l2;
        float ss = 0.f;
#pragma unroll
        for (int d = 0; d < 4; ++d)
#pragma unroll
            for (int i = 0; i < 16; ++i) { const float v = O1[d][i] * i1 - O2[d][i] * i2; O1[d][i] = v; ss += v * v; }
        ss += __shfl_xor(ss, 32);
        const float rn = rsqrtf(ss * (1.f / 128.f) + 1e-6f) * (1.f - LAMBDA_INIT);
        u16* orow = (u16*)(p.ws + WS_HN) + (size_t)(tokbase + qidx) * 1024 + h * 128;
        const float* gn = p.diff_norm + h * 128;
#pragma unroll
        for (int d = 0; d < 4; ++d)
#pragma unroll
            for (int g = 0; g < 4; ++g) {
                const int c0 = 32 * d + 8 * g + 4 * half;
                const f32x4 gv = *(const f32x4*)(gn + c0);
                *(u32x2*)(orow + c0) = u32x2{pk2(O1[d][4 * g] * rn * gv.x, O1[d][4 * g + 1] * rn * gv.y), pk2(O1[d][4 * g + 2] * rn * gv.z, O1[d][4 * g + 3] * rn * gv.w)};
            }
    }
}
extern __shared__ __attribute__((aligned(16))) char dyn_smem[];

__global__ void __launch_bounds__(256, 2) k_prep(Params p) { phase_prep(p, blockIdx.x, gridDim.x); }
__global__ void __launch_bounds__(256, 2) k_gemm_gla_in(Params p) { gemm_phase<EPI_GLA_IN>(p, (const u16*)(p.ws + WS_HN), (const u16*)(p.ws + WS_WGIN), GLA_NPAD, nullptr, dyn_smem, blockIdx.x, gridDim.x); }
__global__ void __launch_bounds__(256, 2) k_gla1(Params p) { gla_pass1(p, dyn_smem, blockIdx.x, gridDim.x); }
__global__ void __launch_bounds__(256, 2) k_gla2(Params p) { gla_scan(p, blockIdx.x, gridDim.x); }
__global__ void __launch_bounds__(256, 2) k_gla3(Params p) { gla_pass3(p, dyn_smem, blockIdx.x, gridDim.x); }
__global__ void __launch_bounds__(256, 2) k_gemm_gla_out(Params p) { gemm_phase<EPI_RESID>(p, (const u16*)(p.ws + WS_HN), (const u16*)(p.ws + WS_WGOUT), 1024, p.x, dyn_smem, blockIdx.x, gridDim.x); }
__global__ void __launch_bounds__(256, 2) k_norm_tab(Params p, int layer) { phase_rmsnorm(p, p.norm_ffn + layer * 1024, blockIdx.x, gridDim.x); phase_tabconv(p, layer, blockIdx.x, gridDim.x); }
__global__ void __launch_bounds__(256, 2) k_peer_q(Params p, int layer) { peer_query_phase(p, layer, dyn_smem, blockIdx.x, gridDim.x); }
__global__ void __launch_bounds__(256, 2) k_peer_g0(Params p) { peer_gather_phase<false>(p, p.norm_mix + 1024, dyn_smem, blockIdx.x, gridDim.x); }
__global__ void __launch_bounds__(256, 2) k_peer_g1(Params p) { peer_gather_phase<true>(p, p.norm_final, dyn_smem, blockIdx.x, gridDim.x); }
__global__ void __launch_bounds__(256, 2) k_gemm_diff_in(Params p) { gemm_phase<EPI_DIFF_IN>(p, (const u16*)(p.ws + WS_HN), (const u16*)(p.ws + WS_WDIN), 3072, nullptr, dyn_smem, blockIdx.x, gridDim.x); }
__global__ void __launch_bounds__(256, 2) k_attn(Params p) { attn_phase(p, dyn_smem, blockIdx.x, gridDim.x); }
__global__ void __launch_bounds__(256, 2) k_gemm_diff_out(Params p) { gemm_phase<EPI_RESID>(p, (const u16*)(p.ws + WS_HN), (const u16*)(p.ws + WS_WDOUT), 1024, p.out, dyn_smem, blockIdx.x, gridDim.x); }
__global__ void __launch_bounds__(256, 2) k_final(Params p) {
    const int wave = threadIdx.x >> 6, lane = threadIdx.x & 63;
    for (int t = blockIdx.x * 4 + wave; t < T_TOK; t += gridDim.x * 4) {
        f32x4* xr = (f32x4*)(p.out + (size_t)t * DM);
        f32x4 v[4]; float ss = 0.f;
        for (int i = 0; i < 4; ++i) { v[i] = xr[lane + 64 * i]; ss += v[i].x * v[i].x + v[i].y * v[i].y + v[i].z * v[i].z + v[i].w * v[i].w; }
        ss = wave_sum(ss);
        const float r = rsqrtf(ss * (1.f / 1024.f) + 1e-6f);
        for (int i = 0; i < 4; ++i) { const f32x4 g = ((const f32x4*)p.norm_final)[lane + 64 * i]; xr[lane + 64 * i] = v[i] * r * g; }
    }
}

extern "C" void kernel_launch(void* const* d_in, const int* in_sizes, int n_in, void* d_out, int out_size, void* d_ws, size_t ws_size, hipStream_t stream) {
    Params p{};
    p.x = (const float*)d_in[0]; p.pos = (const int*)d_in[1]; p.norm_mix = (const float*)d_in[2]; p.norm_ffn = (const float*)d_in[3]; p.norm_final = (const float*)d_in[4];
    p.gla_w_in = (const float*)d_in[5]; p.gla_wgu = (const float*)d_in[6]; p.gla_bg = (const float*)d_in[7]; p.gla_norm = (const float*)d_in[8]; p.gla_w_out = (const float*)d_in[9];
    p.diff_w_in = (const float*)d_in[10]; p.lq1 = (const float*)d_in[11]; p.lk1 = (const float*)d_in[12]; p.lq2 = (const float*)d_in[13]; p.lk2 = (const float*)d_in[14];
    p.diff_norm = (const float*)d_in[15]; p.diff_w_out = (const float*)d_in[16];
    p.peer_wq = (const float*)d_in[17]; p.peer_sk = (const float*)d_in[18]; p.peer_u = (const float*)d_in[19]; p.peer_v = (const float*)d_in[20];
    p.out = (float*)d_out; p.ws = (char*)d_ws;
    static bool attr = false;
    if (!attr) {
        hipFuncSetAttribute((const void*)k_gemm_gla_in, hipFuncAttributeMaxDynamicSharedMemorySize, 80 * 1024);
        hipFuncSetAttribute((const void*)k_gla1, hipFuncAttributeMaxDynamicSharedMemorySize, 80 * 1024);
        hipFuncSetAttribute((const void*)k_gla3, hipFuncAttributeMaxDynamicSharedMemorySize, 80 * 1024);
        hipFuncSetAttribute((const void*)k_gemm_gla_out, hipFuncAttributeMaxDynamicSharedMemorySize, 80 * 1024);
        hipFuncSetAttribute((const void*)k_peer_q, hipFuncAttributeMaxDynamicSharedMemorySize, 80 * 1024);
        attr = true;
    }
    const int G = 1024;
    k_prep<<<G, 256, 0, stream>>>(p);
    k_gemm_gla_in<<<G, 256, G_LDS_BYTES, stream>>>(p);
    k_gla1<<<G, 256, 55296, stream>>>(p);
    k_gla2<<<128, 256, 0, stream>>>(p);
    k_gla3<<<G, 256, 71680, stream>>>(p);
    k_gemm_gla_out<<<G, 256, G_LDS_BYTES, stream>>>(p);
    k_norm_tab<<<G, 256, 0, stream>>>(p, 0);
    k_peer_q<<<G, 256, PQ_LDS_BYTES, stream>>>(p, 0);
    k_peer_g0<<<G, 256, PG_LDS_BYTES, stream>>>(p);
    k_gemm_diff_in<<<G, 256, G_LDS_BYTES, stream>>>(p);
    k_attn<<<512, 256, AT_LDS_BYTES, stream>>>(p);
    k_gemm_diff_out<<<G, 256, G_LDS_BYTES, stream>>>(p);
    k_norm_tab<<<G, 256, 0, stream>>>(p, 1);
    k_peer_q<<<G, 256, PQ_LDS_BYTES, stream>>>(p, 1);
    k_peer_g1<<<G, 256, PG_LDS_BYTES, stream>>>(p);
}
```

```cpp
#include <hip/hip_runtime.h>
#include <stdint.h>

#define DI __device__ __forceinline__
typedef unsigned short u16;
typedef __attribute__((ext_vector_type(8))) short bf16x8;
typedef __attribute__((ext_vector_type(16))) float f32x16;
typedef __attribute__((ext_vector_type(2))) __bf16 bf2_t;
typedef __attribute__((ext_vector_type(4))) unsigned u32x4;
typedef __attribute__((ext_vector_type(2))) unsigned u32x2;
typedef __attribute__((ext_vector_type(4))) float f32x4;
#define MFMA32(a, b, c) __builtin_amdgcn_mfma_f32_32x32x16_bf16((a), (b), (c), 0, 0, 0)

constexpr int T_TOK = 32768, SEQ = 16384, DM = 1024;
constexpr int GLA_NPAD = 3328;
constexpr int NTHR = 256;

constexpr size_t MB = 1024ull * 1024ull;
constexpr size_t WS_BAR    = 0;
constexpr size_t WS_ROPE   = 64 * 1024;
constexpr size_t WS_WGIN   = WS_ROPE + 2 * MB;
constexpr size_t WS_WGOUT  = WS_WGIN + (size_t)GLA_NPAD * 1024 * 2;
constexpr size_t WS_WDIN   = WS_WGOUT + 2 * MB;
constexpr size_t WS_WDOUT  = WS_WDIN + 6 * MB;
constexpr size_t WS_WPQ    = WS_WDOUT + 2 * MB;
constexpr size_t WS_SK     = WS_WPQ + 8 * MB;
constexpr size_t WS_GLR    = WS_SK + 1 * MB;
constexpr size_t WS_DEC    = WS_GLR + 2 * MB;
constexpr size_t WS_TAB    = WS_DEC + 1 * MB;
constexpr size_t WS_HN     = WS_TAB + 64 * MB;
constexpr size_t WS_PROJ   = WS_HN + 64 * MB;
constexpr size_t WS_KV     = WS_PROJ + 192 * MB;
constexpr size_t WS_END    = WS_KV + 128 * MB;
static_assert(WS_END <= 512 * MB, "workspace overflow");
constexpr size_t WS_VT     = WS_PROJ + 128 * MB;
constexpr size_t WS_IDX    = WS_KV;
constexpr size_t WS_GATE   = WS_KV + 16 * MB;
constexpr size_t WS_DOT    = WS_KV + 32 * MB;

struct Params {
    const float* x; const int* pos; const float* norm_mix; const float* norm_ffn; const float* norm_final;
    const float* gla_w_in; const float* gla_wgu; const float* gla_bg; const float* gla_norm; const float* gla_w_out;
    const float* diff_w_in; const float* lq1; const float* lk1; const float* lq2; const float* lk2;
    const float* diff_norm; const float* diff_w_out;
    const float* peer_wq; const float* peer_sk; const float* peer_u; const float* peer_v;
    float* out; char* ws;
    int wv; int pad_;
};

DI int opaque_tid(const Params& p) { int l; asm volatile("v_mbcnt_lo_u32_b32 %0, -1, 0\n\tv_mbcnt_hi_u32_b32 %0, -1, %0" : "=v"(l)); return (p.wv << 6) | l; }
DI unsigned pk2(float a, float b) { bf2_t v = {(__bf16)a, (__bf16)b}; return __builtin_bit_cast(unsigned, v); }
DI u16 f2bf(float a) { return (u16)(pk2(a, 0.f) & 0xffffu); }
DI float bflo(unsigned w) { return __uint_as_float(w << 16); }
DI float bfhi(unsigned w) { return __uint_as_float(w & 0xffff0000u); }
DI float bf2f(u16 h) { return __uint_as_float(((unsigned)h) << 16); }
DI int xcd_unit(int j, int bid, int nb) { return ((nb & 7) == 0) ? j * nb + (bid & 7) * (nb >> 3) + (bid >> 3) : j * nb + bid; }
DI int crow(int i, int half) { return (i & 3) + 8 * (i >> 2) + 4 * half; }
template <int MASK> DI unsigned sxu(unsigned v, int half) {
    if constexpr (MASK < 32) return (unsigned)__builtin_amdgcn_ds_swizzle((int)v, (MASK << 10) | 0x1f);
    else { auto r = __builtin_amdgcn_permlane32_swap(v, v, false, false); return half ? r[0] : r[1]; }
}
template <int MASK> DI float sxf(float v, int half) { return __uint_as_float(sxu<MASK>(__float_as_uint(v), half)); }
template <int MASK> DI int sxi(int v, int half) { return (int)sxu<MASK>((unsigned)v, half); }
DI float wave_sum(float v, int half) { v += sxf<32>(v, half); v += sxf<16>(v, half); v += sxf<8>(v, half); v += sxf<4>(v, half); v += sxf<2>(v, half); v += sxf<1>(v, half); return v; }
DI f32x16 zero16() { f32x16 z; for (int i = 0; i < 16; ++i) z[i] = 0.f; return z; }
DI bf16x8 lds_frag(const char* p) { return *(const bf16x8*)p; }
DI bf16x8 lds_frag2(const char* p0, const char* p1) {
    u32x2 a = *(const u32x2*)p0, b = *(const u32x2*)p1; u32x4 r = {a.x, a.y, b.x, b.y}; return __builtin_bit_cast(bf16x8, r);
}
DI bf16x8 pack8(const f32x16& x, int s) {
    u32x4 r = {pk2(x[8 * s], x[8 * s + 1]), pk2(x[8 * s + 2], x[8 * s + 3]), pk2(x[8 * s + 4], x[8 * s + 5]), pk2(x[8 * s + 6], x[8 * s + 7])};
    return __builtin_bit_cast(bf16x8, r);
}
#define XB_TMO      128
#define XB_XCNT(j)  (256  + 64 * (j))
#define XB_XSUB(j)  (1280 + 64 * (j))
#define XB_XGEN(j)  (2304 + 64 * (j))
#define XB_TOP      3328
#define XB_TOPGEN   3392
#define XCD_BAR_WORDS 3456
#define XB_SPIN_CAP (1u << 18)
#define LAS __attribute__((address_space(3)))

__device__ __forceinline__ unsigned xb_ld(unsigned* p)              { return __hip_atomic_load(p, __ATOMIC_RELAXED, __HIP_MEMORY_SCOPE_AGENT); }
__device__ __forceinline__ unsigned xb_add(unsigned* p, unsigned v) { return __hip_atomic_fetch_add(p, v, __ATOMIC_RELAXED, __HIP_MEMORY_SCOPE_AGENT); }
__device__ __forceinline__ unsigned xb_xcc_id() { return (unsigned)__builtin_amdgcn_s_getreg((3 << 11) | 20) & 0xFu; }
#define XB_SPIN(cond, bar) do { unsigned _sp = 0; while (cond) { __builtin_amdgcn_s_sleep(1); \
    if ((++_sp & 255u) == 0u) { if (xb_ld(&(bar)[XB_TMO])) break; if (_sp > XB_SPIN_CAP) { atomicAdd(&(bar)[XB_TMO], 1u); break; } } } } while (0)

struct XcdBarrier {
    unsigned* bar; unsigned x;
    volatile LAS unsigned* st;
};

__device__ __forceinline__ XcdBarrier xcd_barrier_post(unsigned* bar, volatile LAS unsigned* st, bool t0) {
    XcdBarrier b; b.bar = bar; b.x = xb_xcc_id(); b.st = st;
    if (t0) (void)xb_add(&bar[XB_XCNT(b.x)], 1u);
    return b;
}
__device__ __forceinline__ void xcd_barrier_complete(unsigned* bar, unsigned x, unsigned& nloc, unsigned& nx) {
    const unsigned G = gridDim.x * gridDim.y * gridDim.z;
    unsigned sum, cnt, mine, sp = 0u;
    for (;;) {
        sum = 0u; cnt = 0u; mine = 0u;
#pragma unroll
        for (unsigned j = 0; j < 16; ++j) { const unsigned c = xb_ld(&bar[XB_XCNT(j)]); sum += c; cnt += (c > 0u) ? 1u : 0u; mine = (j == x) ? c : mine; }
        if (sum == G) break;
        __builtin_amdgcn_s_sleep(1);
        if ((++sp & 255u) == 0u) { if (xb_ld(&bar[XB_TMO])) break; if (sp > XB_SPIN_CAP) { atomicAdd(&bar[XB_TMO], 1u); break; } }
    }
    nloc = mine > 0u ? mine : 1u; nx = cnt > 0u ? cnt : 1u;
}

__device__ __forceinline__ void xcd_barrier(const XcdBarrier& b, bool t0) {
    asm volatile("s_waitcnt vmcnt(0)" ::: "memory");
    __syncthreads();
    if (t0) {
        unsigned* bar = b.bar;
        __builtin_amdgcn_s_waitcnt(0);
        unsigned nloc = b.st[0], nx = b.st[1];
        if (nloc == 0u) { xcd_barrier_complete(bar, b.x, nloc, nx); b.st[0] = nloc; b.st[1] = nx; }
        const unsigned old = xb_add(&bar[XB_XSUB(b.x)], 1u);
        const unsigned gen = old / nloc;
        if (old + 1u == (gen + 1u) * nloc) {
            __builtin_amdgcn_fence(__ATOMIC_RELEASE, "agent");
            asm volatile("s_waitcnt vmcnt(0)" ::: "memory");
            const unsigned og = xb_add(&bar[XB_TOP], 1u);
            const unsigned tg = og / nx;
            if (og + 1u == (tg + 1u) * nx) xb_add(&bar[XB_TOPGEN], 1u);
            else XB_SPIN(xb_ld(&bar[XB_TOPGEN]) == tg, bar);
            __builtin_amdgcn_fence(__ATOMIC_ACQUIRE, "agent");
            xb_add(&bar[XB_XGEN(b.x)], 1u);
            asm volatile("s_waitcnt vmcnt(0)" ::: "memory");
        } else {
            XB_SPIN(xb_ld(&bar[XB_XGEN(b.x)]) == gen, bar);
            __builtin_amdgcn_fence(__ATOMIC_ACQUIRE, "agent");
            asm volatile("s_waitcnt vmcnt(0)" ::: "memory");
        }
    }
    __syncthreads();
}
DI void rmsnorm_row_bf16(const float* __restrict__ src, const float* __restrict__ g, u16* __restrict__ dst, int lane) {
    const f32x4* xr = (const f32x4*)src;
    f32x4 a0 = xr[lane * 2], a1 = xr[lane * 2 + 1], b0 = xr[128 + lane * 2], b1 = xr[128 + lane * 2 + 1];
    float ss = a0.x * a0.x + a0.y * a0.y + a0.z * a0.z + a0.w * a0.w + a1.x * a1.x + a1.y * a1.y + a1.z * a1.z + a1.w * a1.w
             + b0.x * b0.x + b0.y * b0.y + b0.z * b0.z + b0.w * b0.w + b1.x * b1.x + b1.y * b1.y + b1.z * b1.z + b1.w * b1.w;
    ss = wave_sum(ss, lane >> 5);
    const float r = rsqrtf(ss * (1.f / 1024.f) + 1e-6f);
    const f32x4* gr = (const f32x4*)g;
    f32x4 g0 = gr[lane * 2], g1 = gr[lane * 2 + 1], g2 = gr[128 + lane * 2], g3 = gr[128 + lane * 2 + 1];
    u32x4 o0 = u32x4{pk2(a0.x * r * g0.x, a0.y * r * g0.y), pk2(a0.z * r * g0.z, a0.w * r * g0.w), pk2(a1.x * r * g1.x, a1.y * r * g1.y), pk2(a1.z * r * g1.z, a1.w * r * g1.w)};
    u32x4 o1 = u32x4{pk2(b0.x * r * g2.x, b0.y * r * g2.y), pk2(b0.z * r * g2.z, b0.w * r * g2.w), pk2(b1.x * r * g3.x, b1.y * r * g3.y), pk2(b1.z * r * g3.z, b1.w * r * g3.w)};
    ((u32x4*)dst)[lane] = o0;
    ((u32x4*)dst)[64 + lane] = o1;
}

DI void tconv_item(const float* __restrict__ src, u16* __restrict__ dst, int K, int N, int item, int lane) {
    const int kgroups = K >> 3;
    const int ng = item / kgroups, kg = item - ng * kgroups;
    const int n = ng * 64 + lane, k0 = kg * 8;
    float v[8];
#pragma unroll
    for (int i = 0; i < 8; ++i) v[i] = (n < N) ? src[(size_t)(k0 + i) * N + n] : 0.f;
    u32x4 o = u32x4{pk2(v[0], v[1]), pk2(v[2], v[3]), pk2(v[4], v[5]), pk2(v[6], v[7])};
    *(u32x4*)(dst + (size_t)n * K + k0) = o;
}

DI void conv8(const float* __restrict__ src, u16* __restrict__ dst, size_t i8) {
    const f32x4* s = (const f32x4*)(src + i8 * 8);
    f32x4 a = s[0], b = s[1];
    *(u32x4*)(dst + i8 * 8) = u32x4{pk2(a.x, a.y), pk2(a.z, a.w), pk2(b.x, b.y), pk2(b.z, b.w)};
}

DI void phase_prep_a(const Params& p, int bid, int nb) {
    const int wave = opaque_tid(p) >> 6, lane = opaque_tid(p) & 63;
    const int gw = bid * 4 + wave, nw = nb * 4;
    char* ws = p.ws;
    for (int t = gw; t < T_TOK; t += nw) rmsnorm_row_bf16(p.x + (size_t)t * DM, p.norm_mix, (u16*)(ws + WS_HN) + (size_t)t * DM, lane);
    const int n0 = (GLA_NPAD / 64) * 128, n1 = n0 + 16 * 128;
    for (int it = gw; it < n1; it += nw) {
        if (it < n0) tconv_item(p.gla_w_in, (u16*)(ws + WS_WGIN), 1024, 3088, it, lane);
        else         tconv_item(p.gla_w_out, (u16*)(ws + WS_WGOUT), 1024, 1024, it - n0, lane);
    }
}
DI void phase_prep_b(const Params& p, int bid, int nb) {
    const int wave = opaque_tid(p) >> 6, lane = opaque_tid(p) & 63;
    const int gw = bid * 4 + wave, nw = nb * 4;
    char* ws = p.ws;
    {
        const int n2 = 48 * 128, n3 = n2 + 16 * 128, n4 = n3 + 32 * 128, n5 = n4 + 32 * 128;
        for (int it = gw; it < n5; it += nw) {
            if (it < n2)      tconv_item(p.diff_w_in, (u16*)(ws + WS_WDIN), 1024, 3072, it, lane);
            else if (it < n3) tconv_item(p.diff_w_out, (u16*)(ws + WS_WDOUT), 1024, 1024, it - n2, lane);
            else if (it < n4) tconv_item(p.peer_wq, (u16*)(ws + WS_WPQ), 1024, 2048, it - n3, lane);
            else              tconv_item(p.peer_wq + (size_t)1024 * 2048, (u16*)(ws + WS_WPQ) + (size_t)2048 * 1024, 1024, 2048, it - n4, lane);
        }
    }
    for (int i = gw * 64 + lane; i < 65536; i += nw * 64) conv8(p.peer_sk, (u16*)(ws + WS_SK), (size_t)i);
    for (int i = gw * 64 + lane; i < T_TOK * 8; i += nw * 64) {
        const int t = i >> 3, f = i & 7;
        const float inv = exp2f(-(float)f * (18.931568569324174f / 8.f));
        const float ang = (float)p.pos[t] * inv;
        float sn, cs; sincosf(ang, &sn, &cs);
        ((float2*)(ws + WS_ROPE))[i] = make_float2(cs, sn);
    }
}

constexpr float TAB_SCALE_U = 64.f, TAB_SCALE_V = 6.f;
DI float clamp6(float a) { return fminf(fmaxf(a, -6.f), 6.f); }
DI unsigned pk8_fp4(f32x4 a, f32x4 b, float s) {
    unsigned w = 0;
    w = __builtin_amdgcn_cvt_scalef32_pk_fp4_f32(w, clamp6(a.x * s), clamp6(a.y * s), 1.0f, 0);
    w = __builtin_amdgcn_cvt_scalef32_pk_fp4_f32(w, clamp6(a.z * s), clamp6(a.w * s), 1.0f, 1);
    w = __builtin_amdgcn_cvt_scalef32_pk_fp4_f32(w, clamp6(b.x * s), clamp6(b.y * s), 1.0f, 2);
    w = __builtin_amdgcn_cvt_scalef32_pk_fp4_f32(w, clamp6(b.z * s), clamp6(b.w * s), 1.0f, 3);
    return w;
}
constexpr float TAB_SCALE_UI = 90.f;
DI unsigned pk8_i4(f32x4 a, f32x4 b, float s) {
    const float f[8] = {a.x, a.y, a.z, a.w, b.x, b.y, b.z, b.w};
    unsigned w = 0;
#pragma unroll
    for (int j = 0; j < 8; ++j) { const int q = (int)rintf(fminf(fmaxf(f[j] * s, -7.f), 7.f)); w |= ((unsigned)q & 15u) << (4 * j); }
    return w;
}
DI void phase_tabconv(const Params& p, int layer, int bid, int nb) {
    const size_t n16 = (size_t)16384 * 1024 / 16;
    const float* su = p.peer_u + (size_t)layer * 16384 * 1024;
    const float* sv = p.peer_v + (size_t)layer * 16384 * 1024;
    unsigned char* du = (unsigned char*)(p.ws + WS_TAB) + (size_t)layer * 16 * MB; unsigned char* dv = du + (size_t)16384 * 512;
    for (size_t i = (size_t)bid * NTHR + opaque_tid(p); i < n16; i += (size_t)nb * NTHR) {
        const f32x4* a = (const f32x4*)(su + i * 16); const f32x4* b = (const f32x4*)(sv + i * 16);
        const f32x4 a0 = __builtin_nontemporal_load(a), a1 = __builtin_nontemporal_load(a + 1), a2 = __builtin_nontemporal_load(a + 2), a3 = __builtin_nontemporal_load(a + 3);
        const f32x4 b0 = __builtin_nontemporal_load(b), b1 = __builtin_nontemporal_load(b + 1), b2 = __builtin_nontemporal_load(b + 2), b3 = __builtin_nontemporal_load(b + 3);
        *(u32x2*)(du + i * 8) = u32x2{pk8_i4(a0, a1, TAB_SCALE_UI), pk8_i4(a2, a3, TAB_SCALE_UI)};
        *(u32x2*)(dv + i * 8) = u32x2{pk8_fp4(b0, b1, TAB_SCALE_V), pk8_fp4(b2, b3, TAB_SCALE_V)};
    }
}

DI void phase_rmsnorm(const Params& p, const float* g, int bid, int nb) {
    const int wave = opaque_tid(p) >> 6, lane = opaque_tid(p) & 63;
    for (int t = bid * 4 + wave; t < T_TOK; t += nb * 4) rmsnorm_row_bf16(p.out + (size_t)t * DM, g, (u16*)(p.ws + WS_HN) + (size_t)t * DM, lane);
}
constexpr int G_ROW = 64;
constexpr int G_SLOT = 384 * G_ROW;
constexpr int G_LDS_BYTES = 3 * G_SLOT;
DI const char* uni_ptr(const char* p) {
    const unsigned long long v = (unsigned long long)p;
    const unsigned lo = __builtin_amdgcn_readfirstlane((unsigned)v), hi = __builtin_amdgcn_readfirstlane((unsigned)(v >> 32));
    return (const char*)(((unsigned long long)hi << 32) | lo);
}
DI void dma16(const char* ubase, unsigned voff, char* lds_wave_base) { __builtin_amdgcn_global_load_lds((const unsigned*)(uni_ptr(ubase) + voff), (unsigned*)lds_wave_base, 16, 0, 0); }

template <int WM, int WN, int BROWS = 128, int AROWS = 128>
DI void gemm_mainloop(const Params& p, const u16* __restrict__ A, int ld, const u16* __restrict__ Bt, int  , int K, char* smem, int wm0, int wn0, f32x16 (&acc)[WM][WN]) {
    static_assert(AROWS + BROWS == 384 && (AROWS % 64) == 0, "slot shape");
    const int tid = opaque_tid(p), lane = tid & 63, r = lane & 31, half = lane >> 5;
    const int wave = p.wv;
    const unsigned voff = (unsigned)(lane >> 2) * (unsigned)(ld * 2) + (unsigned)(((lane & 3) ^ ((lane >> 4) & 3)) << 4);
    const char* ab = (const char*)A + (size_t)(wave * 16) * ld * 2;
    const char* bb = (const char*)Bt + (size_t)(wave * 16) * ld * 2;
    const size_t pstep = (size_t)64 * ld * 2;
    char* dbase = smem + wave * 1024;
    constexpr int NPA = AROWS / 64, NPB = BROWS / 64;
#define G_ISSUE(kt_, slot_) do { const size_t ko_ = (size_t)(kt_) * 64; char* d_ = dbase + (slot_) * G_SLOT; \
        _Pragma("unroll") for (int i_ = 0; i_ < NPA; ++i_) dma16(ab + i_ * pstep + ko_, voff, d_ + i_ * 4096); \
        _Pragma("unroll") for (int i_ = 0; i_ < NPB; ++i_) dma16(bb + i_ * pstep + ko_, voff, d_ + (NPA + i_) * 4096); } while (0)
    const int nk = K >> 5;
    asm volatile("s_waitcnt vmcnt(0)\n\ts_barrier" ::: "memory");
    G_ISSUE(0, 0); G_ISSUE(1, 1); G_ISSUE(2, 2);
    const int sw = (r >> 2) & 3;
    const int fo0 = r * G_ROW + ((half ^ sw) << 4), fo1 = r * G_ROW + (((2 + half) ^ sw) << 4);
    int slot = 0;
    for (int kt = 0; kt < nk; ++kt) {
        if (kt + 2 < nk)      asm volatile("s_waitcnt vmcnt(12)\n\ts_barrier" ::: "memory");
        else if (kt + 1 < nk) asm volatile("s_waitcnt vmcnt(6)\n\ts_barrier" ::: "memory");
        else                  asm volatile("s_waitcnt vmcnt(0)\n\ts_barrier" ::: "memory");
        const char* As = smem + slot * G_SLOT; const char* Bs = As + AROWS * G_ROW;
        bf16x8 af[2][WM], bfr[2][WN];
#pragma unroll
        for (int ks = 0; ks < 2; ++ks) {
            const int fo = ks ? fo1 : fo0;
#pragma unroll
            for (int i = 0; i < WM; ++i) af[ks][i] = lds_frag(As + (wm0 + 32 * i) * G_ROW + fo);
#pragma unroll
            for (int j = 0; j < WN; ++j) bfr[ks][j] = lds_frag(Bs + (wn0 + 32 * j) * G_ROW + fo);
        }
        asm volatile("s_waitcnt lgkmcnt(0)\n\ts_barrier" ::: "memory");
        if (kt + 3 < nk) G_ISSUE(kt + 3, slot);
#pragma unroll
        for (int ks = 0; ks < 2; ++ks)
#pragma unroll
            for (int i = 0; i < WM; ++i)
#pragma unroll
                for (int j = 0; j < WN; ++j) acc[i][j] = MFMA32(af[ks][i], bfr[ks][j], acc[i][j]);
        slot = (slot == 2) ? 0 : slot + 1;
    }
#undef G_ISSUE
}

enum { EPI_GLA_IN = 0, EPI_RESID = 1, EPI_DIFF_IN = 2 };

template <int EPI, int BN = 256>
DI void gemm_phase(const Params& p, const u16* A, const u16* Bt, int N, const float* resid, char* smem, int bid, int nb) {
    constexpr int TN = BN / 64;
    const int ntn = N / BN, ntm = T_TOK / 128;
    const int tid = opaque_tid(p), wave = tid >> 6, lane = tid & 63, r = lane & 31, half = lane >> 5;
    const int wm0 = (wave >> 1) * 64, wn0 = (wave & 1) * (BN / 2);
    for (int j = 0; j * nb < ntn * ntm; ++j) {
        const int u = xcd_unit(j, bid, nb);
        if (u >= ntn * ntm) continue;
        const int mt = u / ntn, nt = u - mt * ntn;
        const int m0 = mt * 128, n0 = nt * BN;
        f32x16 acc[2][TN];
#pragma unroll
        for (int i = 0; i < 2; ++i)
#pragma unroll
            for (int j = 0; j < TN; ++j) acc[i][j] = zero16();
        gemm_mainloop<2, TN, BN>(p, A + (size_t)m0 * 1024, 1024, Bt + (size_t)n0 * 1024, 1024, 1024, smem, wm0, wn0, acc);
        if constexpr (EPI == EPI_RESID) {
#pragma unroll
            for (int ti = 0; ti < 2; ++ti)
#pragma unroll
                for (int tj0 = 0; tj0 < TN; tj0 += 2) {
                    float rv[2][16];
#pragma unroll
                    for (int tt = 0; tt < 2; ++tt)
#pragma unroll
                        for (int i = 0; i < 16; ++i) rv[tt][i] = resid[(size_t)(m0 + wm0 + 32 * ti + crow(i, half)) * 1024 + n0 + wn0 + 32 * (tj0 + tt) + r];
#pragma unroll
                    for (int tt = 0; tt < 2; ++tt)
#pragma unroll
                        for (int i = 0; i < 16; ++i) p.out[(size_t)(m0 + wm0 + 32 * ti + crow(i, half)) * 1024 + n0 + wn0 + 32 * (tj0 + tt) + r] = rv[tt][i] + acc[ti][tj0 + tt][i];
                }
        } else
#pragma unroll
        for (int ti = 0; ti < 2; ++ti)
#pragma unroll
            for (int tj = 0; tj < TN; ++tj) {
                const int col = n0 + wn0 + 32 * tj + r;
                const int rowb = m0 + wm0 + 32 * ti;
                if constexpr (EPI == EPI_GLA_IN) {
                    if (col < 3072) {
                        u16* o = (u16*)(p.ws + WS_PROJ);
#pragma unroll
                        for (int i = 0; i < 16; ++i) o[(size_t)(rowb + crow(i, half)) * 3072 + col] = f2bf(acc[ti][tj][i]);
                    } else if (col < 3088) {
                        float* o = (float*)(p.ws + WS_GLR);
#pragma unroll
                        for (int i = 0; i < 16; ++i) o[(size_t)(rowb + crow(i, half)) * 16 + (col - 3072)] = acc[ti][tj][i];
                    }
                } else if constexpr (EPI == EPI_RESID) {
#pragma unroll
                    for (int i = 0; i < 16; ++i) {
                        const size_t off = (size_t)(rowb + crow(i, half)) * 1024 + col;
                        p.out[off] = resid[off] + acc[ti][tj][i];
                    }
                } else if constexpr (EPI == EPI_DIFF_IN) {
                    if (col < 2048) {
                        const int c64 = col & 63;
                        const float qs = (col < 1024) ? 0.125f * 1.4426950408889634f : 1.0f;
                        const float2* cst = (const float2*)(p.ws + WS_ROPE);
                        u16* o = (u16*)(p.ws + WS_PROJ);
                        const bool rot = ((32 * tj) & 63) == 0;
                        float2 csr[16];
                        if (rot) {
#pragma unroll
                            for (int i = 0; i < 16; ++i) csr[i] = cst[(size_t)(rowb + crow(i, half)) * 8 + (c64 & 7)];
                        }
#pragma unroll
                        for (int i = 0; i < 16; ++i) {
                            const int row = rowb + crow(i, half);
                            float v = acc[ti][tj][i];
                            if (rot) {
                                const float pv = sxf<8>(v, half);
                                const float2 cs = csr[i];
                                if (c64 < 16) v = (c64 < 8) ? (v * cs.x - pv * cs.y) : (v * cs.x + pv * cs.y);
                            }
                            o[(size_t)row * 2048 + col] = f2bf(v * qs);
                        }
                    } else {
                        const int hv = (col - 2048) >> 7, dv = (col - 2048) & 127;
                        const int b = rowb >> 14, s0 = rowb & (SEQ - 1);
                        u16* o = (u16*)(p.ws + WS_VT) + ((size_t)(b * 8 + hv) * 128 + dv) * SEQ + s0;
#pragma unroll
                        for (int g = 0; g < 4; ++g) {
                            u32x2 w = {pk2(acc[ti][tj][4 * g], acc[ti][tj][4 * g + 1]), pk2(acc[ti][tj][4 * g + 2], acc[ti][tj][4 * g + 3])};
                            *(u32x2*)(o + 16 * (g >> 1) + 8 * half + 4 * (g & 1)) = w;
                        }
                    }
                }
            }
    }
}
constexpr int CUM_LD = 129;

DI float log_sigmoid(float z) {
    const float e = __builtin_amdgcn_exp2f(-fabsf(z) * 1.4426950408889634f);
    return fminf(z, 0.f) - __builtin_amdgcn_logf(1.f + e) * 0.6931471805599453f;
}

DI void gla_cum(const Params& p, int tok0, int h, float* cumL, float* glrL) {
    const int tid = opaque_tid(p), d = tid & 127, part = tid >> 7;
    const float* glr = (const float*)(p.ws + WS_GLR) + (size_t)tok0 * 16;
    ((f32x4*)glrL)[tid] = ((const f32x4*)glr)[tid];
    float w[16];
#pragma unroll
    for (int q = 0; q < 16; ++q) w[q] = p.gla_wgu[q * 512 + h * 128 + d];
    const float bias = p.gla_bg[h * 128 + d];
    __syncthreads();
    float run = 0.f;
#pragma unroll 1
    for (int c0 = part * 32; c0 < part * 32 + 32; c0 += 8) {
        float gl[8];
#pragma unroll
        for (int j = 0; j < 8; ++j) {
            const f32x4* gr = (const f32x4*)(glrL + (c0 + j) * 16);
            const f32x4 g0 = gr[0], g1 = gr[1], g2 = gr[2], g3 = gr[3];
            const float p0 = g0.x * w[0] + g0.y * w[1] + g0.z * w[2] + g0.w * w[3];
            const float p1 = g1.x * w[4] + g1.y * w[5] + g1.z * w[6] + g1.w * w[7];
            const float p2 = g2.x * w[8] + g2.y * w[9] + g2.z * w[10] + g2.w * w[11];
            const float p3 = g3.x * w[12] + g3.y * w[13] + g3.z * w[14] + g3.w * w[15];
            gl[j] = log_sigmoid(bias + ((p0 + p1) + (p2 + p3))) * (1.f / 16.f);
        }
#pragma unroll
        for (int j = 0; j < 8; ++j) { run += gl[j]; cumL[(c0 + j) * CUM_LD + d] = run; }
    }
    __syncthreads();
    if (part == 1) {
        const float add = cumL[31 * CUM_LD + d];
#pragma unroll 8
        for (int c = 32; c < 64; ++c) cumL[c * CUM_LD + d] += add;
    }
    __syncthreads();
}

DI void gla_pass1(const Params& p, char* smem, int bid, int nb) {
    const int tid = opaque_tid(p), wave = tid >> 6, lane = tid & 63, r = lane & 31, half = lane >> 5;
    float* cumL = (float*)smem; char* vT = smem; char* kdT = smem + 36864; float* glrL = (float*)(smem + 36864);
    const u16* proj = (const u16*)(p.ws + WS_PROJ);
    for (int u = bid; u < 2048; u += nb) {
        const int bh = u >> 8, n = u & 255, b = bh >> 2, h = bh & 3;
        const int tok0 = b * SEQ + n * 64;
        __syncthreads();
        gla_cum(p, tok0, h, cumL, glrL);
        if (tid < 128) ((float*)(p.ws + WS_DEC))[(size_t)u * 128 + tid] = __expf(cumL[63 * CUM_LD + tid]);
#pragma unroll 1
        for (int it = 0; it < 4; ++it) {
            const int d0 = (wave + 4 * it) * 8;
            const u32x4 kreg = *(const u32x4*)(proj + (size_t)(tok0 + lane) * 3072 + 512 + h * 128 + d0);
            const unsigned wv[4] = {kreg.x, kreg.y, kreg.z, kreg.w};
            const float* cl = cumL + 63 * CUM_LD + d0; const float* cc = cumL + lane * CUM_LD + d0;
            char* dst = kdT + (d0 * 72 + lane) * 2;
#pragma unroll
            for (int i = 0; i < 8; ++i) {
                const float kv = (i & 1) ? bfhi(wv[i >> 1]) : bflo(wv[i >> 1]);
                const float e = __expf(cl[i] - cc[i]);
                *(u16*)(dst + i * 144) = f2bf(kv * e);
            }
        }
        __syncthreads();
#pragma unroll 1
        for (int it = 0; it < 8; ++it) {
            const int v0 = (wave + 4 * it) * 8;
            const u32x4 vr = *(const u32x4*)(proj + (size_t)(tok0 + lane) * 3072 + 1024 + h * 256 + v0);
            const unsigned wv[4] = {vr.x, vr.y, vr.z, vr.w};
            char* dst = vT + (v0 * 72 + lane) * 2;
#pragma unroll
            for (int i = 0; i < 8; ++i) *(u16*)(dst + i * 144) = (u16)((i & 1) ? (wv[i >> 1] >> 16) : (wv[i >> 1] & 0xffffu));
        }
        __syncthreads();
        u16* kvo = (u16*)(p.ws + WS_KV) + (size_t)u * 32768;
#pragma unroll 1
        for (int jh = 0; jh < 2; ++jh) {
            f32x16 acc[2][2];
#pragma unroll
            for (int i = 0; i < 2; ++i)
#pragma unroll
                for (int j = 0; j < 2; ++j) acc[i][j] = zero16();
#pragma unroll
            for (int ks = 0; ks < 4; ++ks) {
                bf16x8 af[2], bfr[2];
#pragma unroll
                for (int i = 0; i < 2; ++i) af[i] = lds_frag(vT + (64 * wave + 32 * i + r) * 144 + ks * 32 + half * 16);
#pragma unroll
                for (int j = 0; j < 2; ++j) bfr[j] = lds_frag(kdT + (64 * jh + 32 * j + r) * 144 + ks * 32 + half * 16);
#pragma unroll
                for (int i = 0; i < 2; ++i)
#pragma unroll
                    for (int j = 0; j < 2; ++j) acc[i][j] = MFMA32(af[i], bfr[j], acc[i][j]);
            }
#pragma unroll
            for (int i = 0; i < 2; ++i)
#pragma unroll
                for (int j = 0; j < 2; ++j)
#pragma unroll
                    for (int q = 0; q < 16; ++q) kvo[(64 * wave + 32 * i + crow(q, half)) * 128 + 64 * jh + 32 * j + r] = f2bf(acc[i][j][q]);
        }
    }
}

DI void gla_scan(const Params& p, int bid, int nb) {
    u16* kv = (u16*)(p.ws + WS_KV);
    const float* dec = (const float*)(p.ws + WS_DEC);
    for (int g = bid * NTHR + opaque_tid(p); g < 32768; g += nb * NTHR) {
        const int bh = g >> 12, rem = g & 4095;
        const int dch = rem & 15;
        float st[8];
#pragma unroll
        for (int i = 0; i < 8; ++i) st[i] = 0.f;
        const size_t base = (size_t)bh * 256 * 32768 + (size_t)rem * 8;
        const float* dbase = dec + (size_t)bh * 256 * 128 + dch * 8;
        for (int n0 = 0; n0 < 256; n0 += 8) {
            u32x4 kk[8]; f32x4 d0[8], d1[8];
#pragma unroll
            for (int j = 0; j < 8; ++j) {
                kk[j] = *(const u32x4*)(kv + base + (size_t)(n0 + j) * 32768);
                d0[j] = *(const f32x4*)(dbase + (size_t)(n0 + j) * 128);
                d1[j] = *(const f32x4*)(dbase + (size_t)(n0 + j) * 128 + 4);
            }
#pragma unroll
            for (int j = 0; j < 8; ++j) {
                const u32x4 o = u32x4{pk2(st[0], st[1]), pk2(st[2], st[3]), pk2(st[4], st[5]), pk2(st[6], st[7])};
                *(u32x4*)(kv + base + (size_t)(n0 + j) * 32768) = o;
                const float dd[8] = {d0[j].x, d0[j].y, d0[j].z, d0[j].w, d1[j].x, d1[j].y, d1[j].z, d1[j].w};
                const unsigned wv[4] = {kk[j].x, kk[j].y, kk[j].z, kk[j].w};
#pragma unroll
                for (int i = 0; i < 8; ++i) st[i] = dd[i] * st[i] + ((i & 1) ? bfhi(wv[i >> 1]) : bflo(wv[i >> 1]));
            }
        }
    }
}

DI void gla_pass3(const Params& p, char* smem, int bid, int nb) {
    const int tid = opaque_tid(p), wave = tid >> 6, lane = tid & 63, r = lane & 31, half = lane >> 5;
    float* cumL = (float*)smem; char* vT = smem; char* aM = smem + 18432; char* qd = smem + 36864; char* kq = smem + 54272; float* glrL = (float*)(smem + 36864);
    float* oL = (float*)smem;
    const u16* proj = (const u16*)(p.ws + WS_PROJ);
    const float scale = 0.08838834764831845f;
    for (int u = bid; u < 2048; u += nb) {
        const int bh = u >> 8, n = u & 255, b = bh >> 2, h = bh & 3;
        const int tok0 = b * SEQ + n * 64;
        const u16* st = (const u16*)(p.ws + WS_KV) + (size_t)u * 32768;
        __syncthreads();
        u32x4 qreg[4], kreg[4];
#pragma unroll
        for (int it = 0; it < 4; ++it) {
            const int id = tid + 256 * it, c = id >> 4, dch = id & 15;
            qreg[it] = *(const u32x4*)(proj + (size_t)(tok0 + c) * 3072 + h * 128 + dch * 8);
            kreg[it] = *(const u32x4*)(proj + (size_t)(tok0 + c) * 3072 + 512 + h * 128 + dch * 8);
        }
        gla_cum(p, tok0, h, cumL, glrL);
        u32x4 vreg[4], sreg[8];
#pragma unroll
        for (int it = 0; it < 4; ++it) {
            const int q = wave + 4 * it, wq = q >> 2, vv0 = (q & 3) * 8;
            vreg[it] = *(const u32x4*)(proj + (size_t)(tok0 + lane) * 3072 + 1024 + h * 256 + 64 * wq + vv0);
        }
#pragma unroll
        for (int ks = 0; ks < 8; ++ks) sreg[ks] = *(const u32x4*)(st + (size_t)(64 * wave + r) * 128 + ks * 16 + half * 8);
#pragma unroll
        for (int it = 0; it < 4; ++it) {
            const int id = tid + 256 * it, c = id >> 4, dch = id & 15;
            const unsigned qw[4] = {qreg[it].x, qreg[it].y, qreg[it].z, qreg[it].w}, kw[4] = {kreg[it].x, kreg[it].y, kreg[it].z, kreg[it].w};
            unsigned qo[4], ko[4];
#pragma unroll
            for (int i = 0; i < 4; ++i) {
                const int d = dch * 8 + 2 * i;
                const float e0 = cumL[c * CUM_LD + d] - cumL[31 * CUM_LD + d], e1 = cumL[c * CUM_LD + d + 1] - cumL[31 * CUM_LD + d + 1];
                qo[i] = pk2(bflo(qw[i]) * scale * __expf(e0), bfhi(qw[i]) * scale * __expf(e1));
                ko[i] = pk2(bflo(kw[i]) * __expf(-e0), bfhi(kw[i]) * __expf(-e1));
            }
            *(u32x4*)(qd + c * 272 + dch * 16) = u32x4{qo[0], qo[1], qo[2], qo[3]};
            *(u32x4*)(kq + c * 272 + dch * 16) = u32x4{ko[0], ko[1], ko[2], ko[3]};
        }
        __syncthreads();
        const int rb = wave >> 1, cb = wave & 1;
        f32x16 aacc = zero16();
        if (cb <= rb) {
#pragma unroll
            for (int ks = 0; ks < 8; ++ks) {
                const bf16x8 af = lds_frag(qd + (32 * rb + r) * 272 + ks * 32 + half * 16);
                const bf16x8 bf = lds_frag(kq + (32 * cb + r) * 272 + ks * 32 + half * 16);
                aacc = MFMA32(af, bf, aacc);
            }
        }
        __syncthreads();
#pragma unroll
        for (int it = 0; it < 4; ++it) {
            const int id = tid + 256 * it, c = id >> 4, dch = id & 15;
            const unsigned qw[4] = {qreg[it].x, qreg[it].y, qreg[it].z, qreg[it].w};
            unsigned qo[4];
#pragma unroll
            for (int i = 0; i < 4; ++i) {
                const int d = dch * 8 + 2 * i;
                qo[i] = pk2(bflo(qw[i]) * scale * __expf(cumL[c * CUM_LD + d]), bfhi(qw[i]) * scale * __expf(cumL[c * CUM_LD + d + 1]));
            }
            *(u32x4*)(kq + c * 272 + dch * 16) = u32x4{qo[0], qo[1], qo[2], qo[3]};
        }
        __syncthreads();
#pragma unroll
        for (int q = 0; q < 16; ++q) {
            const int c = 32 * rb + crow(q, half), j = 32 * cb + r;
            *(u16*)(aM + (c * 72 + j) * 2) = f2bf((j <= c) ? aacc[q] : 0.f);
        }
        f32x16 o[2][2];
#pragma unroll
        for (int i = 0; i < 2; ++i)
#pragma unroll
            for (int j = 0; j < 2; ++j) o[i][j] = zero16();
        u32x2 rreg[16];
#pragma unroll
        for (int ps = 0; ps < 2; ++ps) {
            if (ps == 1) __syncthreads();
#pragma unroll
            for (int it = 0; it < 4; ++it) {
                const int q = wave + 4 * it, wq = q >> 2, vv0 = (q & 3) * 8;
                const unsigned wv[4] = {vreg[it].x, vreg[it].y, vreg[it].z, vreg[it].w};
                char* dst = vT + ((wq * 32 + vv0) * 72 + lane) * 2;
#pragma unroll
                for (int i = 0; i < 8; ++i) *(u16*)(dst + i * 144) = (u16)((i & 1) ? (wv[i >> 1] >> 16) : (wv[i >> 1] & 0xffffu));
            }
            if (ps == 0) {
#pragma unroll
                for (int it = 0; it < 4; ++it) {
                    const int q = wave + 4 * it, wq = q >> 2, vv0 = (q & 3) * 8;
                    vreg[it] = *(const u32x4*)(proj + (size_t)(tok0 + lane) * 3072 + 1024 + h * 256 + 64 * wq + 32 + vv0);
                }
            } else {
                const u16* rrow = proj + (size_t)(tok0 + (tid >> 2)) * 3072 + 2048 + h * 256 + 4 * (tid & 3);
#pragma unroll
                for (int j = 0; j < 16; ++j) rreg[j] = *(const u32x2*)(rrow + 16 * j);
            }
            __syncthreads();
#pragma unroll
            for (int ks = 0; ks < 4; ++ks) {
                const bf16x8 bf = lds_frag(vT + (wave * 32 + r) * 144 + ks * 32 + half * 16);
#pragma unroll
                for (int i = 0; i < 2; ++i) {
                    const bf16x8 af = lds_frag(aM + (32 * i + r) * 144 + ks * 32 + half * 16);
                    o[ps][i] = MFMA32(af, bf, o[ps][i]);
                }
            }
#pragma unroll
            for (int ks = 0; ks < 8; ++ks) {
                const bf16x8 bf = __builtin_bit_cast(bf16x8, sreg[ks]);
#pragma unroll
                for (int i = 0; i < 2; ++i) {
                    const bf16x8 af = lds_frag(kq + (32 * i + r) * 272 + ks * 32 + half * 16);
                    o[ps][i] = MFMA32(af, bf, o[ps][i]);
                }
            }
            if (ps == 0) {
#pragma unroll
                for (int ks = 0; ks < 8; ++ks) sreg[ks] = *(const u32x4*)(st + (size_t)(64 * wave + 32 + r) * 128 + ks * 16 + half * 8);
            }
        }
        __syncthreads();
#pragma unroll
        for (int ps = 0; ps < 2; ++ps)
#pragma unroll
            for (int i = 0; i < 2; ++i)
#pragma unroll
                for (int q = 0; q < 16; ++q) oL[(32 * i + crow(q, half)) * 260 + 64 * wave + 32 * ps + r] = o[ps][i][q];
        __syncthreads();
        {
            const int c = tid >> 2, qq = tid & 3;
            f32x4 vals[16]; float ss = 0.f;
#pragma unroll
            for (int j = 0; j < 16; ++j) {
                vals[j] = *(const f32x4*)(oL + c * 260 + 16 * j + 4 * qq);
                ss += vals[j].x * vals[j].x + vals[j].y * vals[j].y + vals[j].z * vals[j].z + vals[j].w * vals[j].w;
            }
            ss += sxf<1>(ss, 0); ss += sxf<2>(ss, 0);
            const float rinv = rsqrtf(ss * (1.f / 256.f) + 1e-6f);
            const float* gn = p.gla_norm + h * 256;
            u16* orow = (u16*)(p.ws + WS_HN) + (size_t)(tok0 + c) * 1024 + h * 256;
#pragma unroll
            for (int j = 0; j < 16; ++j) {
                const int v0 = 16 * j + 4 * qq;
                const u32x2 rr = rreg[j];
                const f32x4 g4 = *(const f32x4*)(gn + v0);
                const float r0 = bflo(rr.x), r1 = bfhi(rr.x), r2 = bflo(rr.y), r3 = bfhi(rr.y);
                const float o0 = vals[j].x * rinv * g4.x * (r0 / (1.f + __expf(-r0)));
                const float o1 = vals[j].y * rinv * g4.y * (r1 / (1.f + __expf(-r1)));
                const float o2 = vals[j].z * rinv * g4.z * (r2 / (1.f + __expf(-r2)));
                const float o3 = vals[j].w * rinv * g4.w * (r3 / (1.f + __expf(-r3)));
                *(u32x2*)(orow + v0) = u32x2{pk2(o0, o1), pk2(o2, o3)};
            }
        }
    }
}
DI unsigned sortable(float v) { const unsigned u = __float_as_uint(v); return (u & 0x80000000u) ? ~u : (u | 0x80000000u); }
DI float unsortable(unsigned k) { const unsigned u = (k & 0x80000000u) ? (k & 0x7fffffffu) : ~k; return __uint_as_float(u); }
DI void ins16(unsigned (&L)[16], unsigned x) {
#pragma unroll
    for (int i = 0; i < 16; ++i) { const unsigned hi = max(L[i], x); x = min(L[i], x); L[i] = hi; }
}

DI void ce(unsigned& a, unsigned& b) { const unsigned hi = max(a, b), lo = min(a, b); a = hi; b = lo; }
template <int N> DI void bitonic_sort_desc(unsigned (&v)[N]) {
#pragma unroll
    for (int k = 2; k <= N; k <<= 1)
#pragma unroll
        for (int j = k >> 1; j > 0; j >>= 1)
#pragma unroll
            for (int i = 0; i < N; ++i) {
                const int l = i ^ j;
                if (l > i) { if ((i & k) == 0) ce(v[i], v[l]); else ce(v[l], v[i]); }
            }
}
DI void top16_merge(unsigned (&a)[16], const unsigned (&b)[16]) {
#pragma unroll
    for (int i = 0; i < 16; ++i) a[i] = max(a[i], b[15 - i]);
#pragma unroll
    for (int j = 8; j > 0; j >>= 1)
#pragma unroll
        for (int i = 0; i < 16; ++i) { const int l = i ^ j; if (l > i) ce(a[i], a[l]); }
}
constexpr int PQ_LDS_BYTES = G_LDS_BYTES;
DI void peer_query_phase(const Params& p, int layer, char* smem, int bid, int nb) {
    const int tid = opaque_tid(p), wave = tid >> 6, lane = tid & 63, r = lane & 31, half = lane >> 5;
    const u16* hn = (const u16*)(p.ws + WS_HN);
    const u16* wq = (const u16*)(p.ws + WS_WPQ) + (size_t)layer * 2048 * 1024;
    const u16* sk = (const u16*)(p.ws + WS_SK) + (size_t)layer * 8 * 2 * 128 * 128;
    char* Bk = smem;
    for (int j = 0; j * nb < 2048; ++j) {
        const int u = xcd_unit(j, bid, nb);
        if (u >= 2048) continue;
        const int tb = u >> 3, h = u & 7;
        unsigned Lp[2][16];
        __syncthreads();
        f32x16 acc[8][1];
#pragma unroll
        for (int i = 0; i < 8; ++i) acc[i][0] = zero16();
        gemm_mainloop<8, 1, 128, 256>(p, wq + (size_t)(h * 256) * 1024, 1024, hn + (size_t)(tb * 128) * 1024, 1024, 1024, smem, 0, 32 * wave, acc);
        bf16x8 bqa[2][8];
#pragma unroll
        for (int pp = 0; pp < 2; ++pp)
#pragma unroll
            for (int di = 0; di < 4; ++di) { bqa[pp][2 * di] = pack8(acc[4 * pp + di][0], 0); bqa[pp][2 * di + 1] = pack8(acc[4 * pp + di][0], 1); }
#pragma unroll
        for (int pp = 0; pp < 2; ++pp) {
            __syncthreads();
            const u16* skt = sk + (size_t)(h * 2 + pp) * 128 * 128;
            int tidl = tid; asm volatile("" : "+v"(tidl));
            {
                const int n0 = tidl >> 4, ch = tidl & 15;
                u32x4 tmp[8];
#pragma unroll
                for (int it = 0; it < 8; ++it) tmp[it] = *(const u32x4*)(skt + (n0 + 16 * it) * 128 + ch * 8);
#pragma unroll
                for (int it = 0; it < 8; ++it) *(u32x4*)(Bk + (n0 + 16 * it) * 272 + ch * 16) = tmp[it];
            }
            __syncthreads();
            f32x16 sc[4];
#pragma unroll
            for (int i = 0; i < 4; ++i) sc[i] = zero16();
#pragma unroll
            for (int di = 0; di < 4; ++di)
#pragma unroll
                for (int s = 0; s < 2; ++s) {
                    const bf16x8 bq = bqa[pp][2 * di + s];
#pragma unroll
                    for (int kb = 0; kb < 4; ++kb) {
                        const char* rowp = Bk + (32 * kb + r) * 272 + (32 * di + 16 * s + 4 * half) * 2;
                        const bf16x8 ak = lds_frag2(rowp, rowp + 16);
                        sc[kb] = MFMA32(ak, bq, sc[kb]);
                    }
                }
            unsigned L[16];
            {
                unsigned G[4][16];
                int hq4 = 4 * half; asm volatile("" : "+v"(hq4));
#pragma unroll
                for (int kb = 0; kb < 4; ++kb) {
#pragma unroll
                    for (int q = 0; q < 16; ++q) G[kb][q] = (sortable(sc[kb][q]) & 0xffffff80u) | (unsigned)(127 - 32 * kb - crow(q, 0) - hq4);
                    bitonic_sort_desc<16>(G[kb]);
                }
                top16_merge(G[0], G[1]); top16_merge(G[2], G[3]); top16_merge(G[0], G[2]);
#pragma unroll
                for (int i = 0; i < 16; ++i) L[i] = G[0][i];
            }
            {
                unsigned O[16];
#pragma unroll
                for (int i = 0; i < 16; ++i) O[i] = sxu<32>(L[i], half);
                top16_merge(L, O);
            }
#pragma unroll
            for (int i = 0; i < 16; ++i) Lp[pp][i] = L[i];
        }
        float s1[16], s2[16]; int i1[16], i2[16];
#pragma unroll
        for (int i = 0; i < 16; ++i) {
            s1[i] = unsortable(Lp[0][i] & 0xffffff80u); i1[i] = 127 - (int)(Lp[0][i] & 127u);
            s2[i] = unsortable(Lp[1][i] & 0xffffff80u); i2[i] = 127 - (int)(Lp[1][i] & 127u);
        }
        __syncthreads();
        int* tabL = (int*)(smem + wave * 8192);
        if (half == 0) {
#pragma unroll
            for (int i = 0; i < 16; ++i) { tabL[i * 32 + r] = i1[i]; tabL[(16 + i) * 32 + r] = i2[i]; tabL[(32 + i) * 32 + r] = __float_as_int(s1[i]); tabL[(48 + i) * 32 + r] = __float_as_int(s2[i]); }
        }
        unsigned C[16], D[16];
#pragma unroll
        for (int i = 0; i < 16; ++i) { C[i] = 0u; D[i] = 0u; }
#define CANDK(a0, b0, a1, b1) ((sortable(half ? (s1[a1] + s2[b1]) : (s1[a0] + s2[b0])) & 0xffffff00u) | (unsigned)(255 - (half ? (16 * a1 + b1) : (16 * a0 + b0))))
        C[0] = CANDK(0, 0, 0, 1);
        C[1] = CANDK(0, 2, 0, 3);
        C[2] = CANDK(0, 4, 0, 5);
        C[3] = CANDK(0, 6, 0, 7);
        C[4] = CANDK(0, 8, 0, 9);
        C[5] = CANDK(0, 10, 0, 11);
        C[6] = CANDK(0, 12, 0, 13);
        C[7] = CANDK(0, 14, 0, 15);
        C[8] = CANDK(1, 0, 1, 1);
        C[9] = CANDK(1, 2, 1, 3);
        C[10] = CANDK(1, 4, 1, 5);
        C[11] = CANDK(1, 6, 1, 7);
        C[12] = CANDK(2, 0, 2, 1);
        C[13] = CANDK(2, 2, 2, 3);
        C[14] = CANDK(2, 4, 3, 0);
        C[15] = CANDK(3, 1, 3, 2);
        D[0] = CANDK(3, 3, 4, 0);
        D[1] = CANDK(4, 1, 4, 2);
        D[2] = CANDK(5, 0, 5, 1);
        D[3] = CANDK(6, 0, 6, 1);
        D[4] = CANDK(7, 0, 7, 1);
        D[5] = CANDK(8, 0, 9, 0);
        D[6] = CANDK(10, 0, 11, 0);
        D[7] = CANDK(12, 0, 13, 0);
        D[8] = CANDK(14, 0, 15, 0);
#undef CANDK
        bitonic_sort_desc<16>(C); bitonic_sort_desc<16>(D);
        top16_merge(C, D);
        {
            unsigned O[16];
#pragma unroll
            for (int i = 0; i < 16; ++i) O[i] = sxu<32>(C[i], half);
            top16_merge(C, O);
        }
        float bs[16]; int bi[16];
#pragma unroll
        for (int i = 0; i < 16; ++i) {
            const int id = 255 - (int)(C[i] & 255u), a = id >> 4, b = id & 15;
            bi[i] = tabL[a * 32 + r] * 128 + tabL[(16 + b) * 32 + r];
            bs[i] = __int_as_float(tabL[(32 + a) * 32 + r]) + __int_as_float(tabL[(48 + b) * 32 + r]);
        }
        float den = 0.f, ex[16];
#pragma unroll
        for (int i = 0; i < 16; ++i) { ex[i] = __expf(bs[i] - bs[0]); den += ex[i]; }
        const float rden = 1.f / den;
        int rl = r; asm volatile("" : "+v"(rl));
        const int tok = tb * 128 + 32 * wave + rl;
        int* io = (int*)(p.ws + WS_IDX) + (size_t)tok * 128 + h * 16 + 8 * half;
        float* go = (float*)(p.ws + WS_GATE) + (size_t)tok * 128 + h * 16 + 8 * half;
        if (half == 0) {
            *(u32x4*)(io) = u32x4{(unsigned)bi[0], (unsigned)bi[1], (unsigned)bi[2], (unsigned)bi[3]};
            *(u32x4*)(io + 4) = u32x4{(unsigned)bi[4], (unsigned)bi[5], (unsigned)bi[6], (unsigned)bi[7]};
            *(f32x4*)(go) = f32x4{ex[0] * rden, ex[1] * rden, ex[2] * rden, ex[3] * rden};
            *(f32x4*)(go + 4) = f32x4{ex[4] * rden, ex[5] * rden, ex[6] * rden, ex[7] * rden};
        } else {
            *(u32x4*)(io) = u32x4{(unsigned)bi[8], (unsigned)bi[9], (unsigned)bi[10], (unsigned)bi[11]};
            *(u32x4*)(io + 4) = u32x4{(unsigned)bi[12], (unsigned)bi[13], (unsigned)bi[14], (unsigned)bi[15]};
            *(f32x4*)(go) = f32x4{ex[8] * rden, ex[9] * rden, ex[10] * rden, ex[11] * rden};
            *(f32x4*)(go + 4) = f32x4{ex[12] * rden, ex[13] * rden, ex[14] * rden, ex[15] * rden};
        }
    }
}

typedef __attribute__((ext_vector_type(2))) float f32x2;
DI float gelu_exact(float a) { return 0.5f * a * (1.f + erff(a * 0.7071067811865476f)); }
DI void unpack8_fp4(unsigned w, float (&f)[8]) {
    const f32x2 a = __builtin_amdgcn_cvt_scalef32_pk_f32_fp4(w, 1.0f, 0), b = __builtin_amdgcn_cvt_scalef32_pk_f32_fp4(w, 1.0f, 1);
    const f32x2 c = __builtin_amdgcn_cvt_scalef32_pk_f32_fp4(w, 1.0f, 2), d = __builtin_amdgcn_cvt_scalef32_pk_f32_fp4(w, 1.0f, 3);
    f[0] = a.x; f[1] = a.y; f[2] = b.x; f[3] = b.y; f[4] = c.x; f[5] = c.y; f[6] = d.x; f[7] = d.y;
}
constexpr float PG_SX = 21.6f;
constexpr int PG_RING_SLOTS = 16, PG_DEPTH = 14;
constexpr int PG_LDS_BYTES = 4 * PG_RING_SLOTS * 1024 + 4096;
DI void pg_dma(const unsigned char* tab, unsigned e, unsigned lane_off, char* slot) {
    __builtin_amdgcn_global_load_lds((const unsigned*)(tab + (e * 512u + lane_off)), (unsigned*)slot, 16, 0, 0);
}
DI void pg_dma4(const unsigned char* tab, const u32x4 e4, unsigned lane_off, char* ring, int g) {
    pg_dma(tab, e4.x, lane_off, ring + ((4 * g + 0) & 15) * 1024); pg_dma(tab, e4.y, lane_off, ring + ((4 * g + 1) & 15) * 1024);
    pg_dma(tab, e4.z, lane_off, ring + ((4 * g + 2) & 15) * 1024); pg_dma(tab, e4.w, lane_off, ring + ((4 * g + 3) & 15) * 1024);
}
#define PG_WAIT_GROUP(g) do { if ((g) + 3 < 16) asm volatile("s_waitcnt vmcnt(12)" ::: "memory"); else if ((g) == 13) asm volatile("s_waitcnt vmcnt(8)" ::: "memory"); \
                              else if ((g) == 14) asm volatile("s_waitcnt vmcnt(4)" ::: "memory"); else asm volatile("s_waitcnt vmcnt(0)" ::: "memory"); } while (0)
DI void peer_u_phase(const Params& p, int layer, char* smem, int bid, int nb) {
    const int tid = opaque_tid(p), wave = __builtin_amdgcn_readfirstlane(tid >> 6), lane = tid & 63, hh = lane >> 5, li = lane & 31;
    char* ring = smem + wave * (PG_RING_SLOTS * 1024);
    int* idxL = (int*)(smem + 4 * PG_RING_SLOTS * 1024 + wave * 1024); float* cL = (float*)(idxL + 128);
    const unsigned char* tu = (const unsigned char*)(p.ws + WS_TAB) + (size_t)layer * 16 * MB;
    const u16* hn = (const u16*)(p.ws + WS_HN);
    const char* myslot = ring + lane * 16;
    const unsigned lane_off = (unsigned)li * 16u;
    const int* idxH = idxL + hh * 64;
    for (int t = bid * 4 + wave; t < T_TOK; t += nb * 4) {
        const int* ig = (const int*)(p.ws + WS_IDX) + (size_t)t * 128;
        idxL[(lane & 1) * 64 + (lane >> 1)] = ig[lane]; idxL[(lane & 1) * 64 + 32 + (lane >> 1)] = ig[lane + 64];
        unsigned xh[4], xl[4];
        {
            const u16* xr = hn + (size_t)t * 1024 + 32 * li;
            const u32x4 xa = *(const u32x4*)(xr), xb = *(const u32x4*)(xr + 8), xc = *(const u32x4*)(xr + 16), xd = *(const u32x4*)(xr + 24);
            const unsigned xw[16] = {xa.x, xa.y, xa.z, xa.w, xb.x, xb.y, xb.z, xb.w, xc.x, xc.y, xc.z, xc.w, xd.x, xd.y, xd.z, xd.w};
#pragma unroll
            for (int d = 0; d < 4; ++d) {
                unsigned hw = 0, lw = 0;
#pragma unroll
                for (int j = 0; j < 8; ++j) {
                    const unsigned w = xw[4 * d + (j >> 1)];
                    const float xv = (j & 1) ? bfhi(w) : bflo(w);
                    const int q = (int)rintf(fminf(fmaxf(xv * PG_SX, -119.f), 119.f));
                    const int lo = ((q + 8) & 15) - 8, hi = (q - lo) >> 4;
                    hw |= ((unsigned)hi & 15u) << (4 * j); lw |= ((unsigned)lo & 15u) << (4 * j);
                }
                xh[d] = hw; xl[d] = lw;
            }
        }
        asm volatile("s_waitcnt vmcnt(0) lgkmcnt(0)" ::: "memory");
#pragma unroll
        for (int g = 0; g < 3; ++g) pg_dma4(tu, *(const u32x4*)(idxH + 4 * g), lane_off, ring, g);
#pragma unroll 1
        for (int bt = 0; bt < 4; ++bt) {
            float pr[16];
#pragma unroll
            for (int gg = 0; gg < 4; ++gg) {
                const int g = bt * 4 + gg;
                if (g + 3 < 16) pg_dma4(tu, *(const u32x4*)(idxH + 4 * (g + 3)), lane_off, ring, g + 3);
                PG_WAIT_GROUP(g);
                u32x4 w[4];
#pragma unroll
                for (int i = 0; i < 4; ++i) w[i] = *(const u32x4*)(myslot + ((4 * gg + i) & 15) * 1024);
#pragma unroll
                for (int i = 0; i < 4; ++i) {
                    const unsigned ww[4] = {w[i].x, w[i].y, w[i].z, w[i].w};
                    int ah = 0, al = 0;
#pragma unroll
                    for (int c = 0; c < 4; ++c) { ah = __builtin_amdgcn_sdot8((int)ww[c], (int)xh[c], ah, false); al = __builtin_amdgcn_sdot8((int)ww[c], (int)xl[c], al, false); }
                    pr[4 * gg + i] = (float)(16 * ah + al);
                }
            }
            float q8[8], q4[4], q2[2], q1;
            { const bool up = (lane & 1) != 0;
#pragma unroll
              for (int i = 0; i < 8; ++i) { const float send = up ? pr[i] : pr[i + 8]; const float keep = up ? pr[i + 8] : pr[i]; q8[i] = keep + sxf<1>(send, hh); } }
            { const bool up = (lane & 2) != 0;
#pragma unroll
              for (int i = 0; i < 4; ++i) { const float send = up ? q8[i] : q8[i + 4]; const float keep = up ? q8[i + 4] : q8[i]; q4[i] = keep + sxf<2>(send, hh); } }
            { const bool up = (lane & 4) != 0;
#pragma unroll
              for (int i = 0; i < 2; ++i) { const float send = up ? q4[i] : q4[i + 2]; const float keep = up ? q4[i + 2] : q4[i]; q2[i] = keep + sxf<4>(send, hh); } }
            { const bool up = (lane & 8) != 0; const float send = up ? q2[0] : q2[1]; const float keep = up ? q2[1] : q2[0]; q1 = keep + sxf<8>(send, hh); }
            q1 += sxf<16>(q1, hh);
            const int jj = 8 * (lane & 1) + 4 * ((lane >> 1) & 1) + 2 * ((lane >> 2) & 1) + ((lane >> 3) & 1);
            if ((lane & 16) == 0) cL[2 * (bt * 16 + jj) + hh] = q1;
        }
        float* dg = (float*)(p.ws + WS_DOT) + (size_t)t * 128;
        dg[lane] = cL[lane]; dg[lane + 64] = cL[lane + 64];
    }
}
typedef __attribute__((ext_vector_type(2))) _Float16 h2_t;
DI void pg_axpy(h2_t (&o2)[16], const u32x4 w, float cfs) {
    const _Float16 ch = (_Float16)cfs; const h2_t cf2 = {ch, ch};
    const unsigned ww[4] = {w.x, w.y, w.z, w.w};
#pragma unroll
    for (int c = 0; c < 4; ++c) {
        o2[4 * c + 0] = __builtin_amdgcn_cvt_scalef32_pk_f16_fp4(ww[c], 1.0f, 0) * cf2 + o2[4 * c + 0];
        o2[4 * c + 1] = __builtin_amdgcn_cvt_scalef32_pk_f16_fp4(ww[c], 1.0f, 1) * cf2 + o2[4 * c + 1];
        o2[4 * c + 2] = __builtin_amdgcn_cvt_scalef32_pk_f16_fp4(ww[c], 1.0f, 2) * cf2 + o2[4 * c + 2];
        o2[4 * c + 3] = __builtin_amdgcn_cvt_scalef32_pk_f16_fp4(ww[c], 1.0f, 3) * cf2 + o2[4 * c + 3];
    }
}
template <bool FINAL>
DI void peer_v_phase(const Params& p, int layer, const float* gnext, char* smem, int bid, int nb) {
    const int tid = opaque_tid(p), wave = __builtin_amdgcn_readfirstlane(tid >> 6), lane = tid & 63, hh = lane >> 5, li = lane & 31;
    char* ring = smem + wave * (PG_RING_SLOTS * 1024);
    int* idxL = (int*)(smem + 4 * PG_RING_SLOTS * 1024 + wave * 1024); float* cL = (float*)(idxL + 128);
    const unsigned char* tv = (const unsigned char*)(p.ws + WS_TAB) + (size_t)layer * 16 * MB + (size_t)16384 * 512;
    const char* myslot = ring + lane * 16;
    const unsigned lane_off = (unsigned)li * 16u;
    const int* idxH = idxL + hh * 64; const float* cH = cL + hh * 64;
    for (int t = bid * 4 + wave; t < T_TOK; t += nb * 4) {
        const int* ig = (const int*)(p.ws + WS_IDX) + (size_t)t * 128;
        const float* gg = (const float*)(p.ws + WS_GATE) + (size_t)t * 128;
        const float* dg = (const float*)(p.ws + WS_DOT) + (size_t)t * 128;
        const int s0 = (lane & 1) * 64 + (lane >> 1), s1 = s0 + 32;
        idxL[s0] = ig[lane]; idxL[s1] = ig[lane + 64];
        {
            const float d0 = dg[lane] * (1.f / (TAB_SCALE_UI * PG_SX)), d1 = dg[lane + 64] * (1.f / (TAB_SCALE_UI * PG_SX));
            cL[s0] = gg[lane] * gelu_exact(d0) * (1.f / TAB_SCALE_V); cL[s1] = gg[lane + 64] * gelu_exact(d1) * (1.f / TAB_SCALE_V);
        }
        asm volatile("s_waitcnt vmcnt(0) lgkmcnt(0)" ::: "memory");
#pragma unroll
        for (int g = 0; g < 3; ++g) pg_dma4(tv, *(const u32x4*)(idxH + 4 * g), lane_off, ring, g);
        h2_t o2[16];
#pragma unroll
        for (int i = 0; i < 16; ++i) o2[i] = h2_t{(_Float16)0.f, (_Float16)0.f};
#pragma unroll 1
        for (int bt = 0; bt < 4; ++bt) {
#pragma unroll
            for (int gg = 0; gg < 4; ++gg) {
                const int g = bt * 4 + gg;
                if (g + 3 < 16) pg_dma4(tv, *(const u32x4*)(idxH + 4 * (g + 3)), lane_off, ring, g + 3);
                const f32x4 c4 = *(const f32x4*)(cH + 4 * g);
                PG_WAIT_GROUP(g);
                u32x4 w[4];
#pragma unroll
                for (int i = 0; i < 4; ++i) w[i] = *(const u32x4*)(myslot + ((4 * gg + i) & 15) * 1024);
                pg_axpy(o2, w[0], c4.x); pg_axpy(o2, w[1], c4.y); pg_axpy(o2, w[2], c4.z); pg_axpy(o2, w[3], c4.w);
            }
        }
        float r[16];
#pragma unroll
        for (int i = 0; i < 8; ++i) {
            const h2_t send = hh ? o2[i] : o2[i + 8]; const h2_t keep = hh ? o2[i + 8] : o2[i];
            const h2_t got = __builtin_bit_cast(h2_t, sxu<32>(__builtin_bit_cast(unsigned, send), hh));
            r[2 * i] = (float)keep.x + (float)got.x; r[2 * i + 1] = (float)keep.y + (float)got.y;
        }
        float* hr = p.out + (size_t)t * 1024 + 32 * li + 16 * hh;
        f32x4 h0 = *(f32x4*)(hr), h1 = *(f32x4*)(hr + 4), h2 = *(f32x4*)(hr + 8), h3 = *(f32x4*)(hr + 12);
        h0 += f32x4{r[0], r[1], r[2], r[3]}; h1 += f32x4{r[4], r[5], r[6], r[7]};
        h2 += f32x4{r[8], r[9], r[10], r[11]}; h3 += f32x4{r[12], r[13], r[14], r[15]};
        float ss = h0.x * h0.x + h0.y * h0.y + h0.z * h0.z + h0.w * h0.w + h1.x * h1.x + h1.y * h1.y + h1.z * h1.z + h1.w * h1.w
                 + h2.x * h2.x + h2.y * h2.y + h2.z * h2.z + h2.w * h2.w + h3.x * h3.x + h3.y * h3.y + h3.z * h3.z + h3.w * h3.w;
        ss = wave_sum(ss, hh);
        const float rn = rsqrtf(ss * (1.f / 1024.f) + 1e-6f);
        const float* gp = gnext + 32 * li + 16 * hh;
        const f32x4 g0v = *(const f32x4*)(gp), g1v = *(const f32x4*)(gp + 4), g2v = *(const f32x4*)(gp + 8), g3v = *(const f32x4*)(gp + 12);
        if constexpr (FINAL) {
            *(f32x4*)(hr) = h0 * rn * g0v; *(f32x4*)(hr + 4) = h1 * rn * g1v; *(f32x4*)(hr + 8) = h2 * rn * g2v; *(f32x4*)(hr + 12) = h3 * rn * g3v;
        } else {
            *(f32x4*)(hr) = h0; *(f32x4*)(hr + 4) = h1; *(f32x4*)(hr + 8) = h2; *(f32x4*)(hr + 12) = h3;
            const f32x4 n0 = h0 * rn * g0v, n1 = h1 * rn * g1v, n2 = h2 * rn * g2v, n3 = h3 * rn * g3v;
            u16* hno = (u16*)(p.ws + WS_HN) + (size_t)t * 1024 + 32 * li + 16 * hh;
            *(u32x4*)(hno) = u32x4{pk2(n0.x, n0.y), pk2(n0.z, n0.w), pk2(n1.x, n1.y), pk2(n1.z, n1.w)};
            *(u32x4*)(hno + 8) = u32x4{pk2(n2.x, n2.y), pk2(n2.z, n2.w), pk2(n3.x, n3.y), pk2(n3.z, n3.w)};
        }
    }
}
constexpr int AT_LDS_BYTES = 65536;
constexpr float LAMBDA_INIT = 0.35550906759096927f;
constexpr float AT_THR = 8.f;


DI float max16(const f32x16& S) {
    float t0, t1, t2, t3, t4;
    asm volatile("s_nop 15\n\tv_max3_f32 %0, %5, %6, %7\n\tv_max3_f32 %1, %8, %9, %10\n\tv_max3_f32 %2, %11, %12, %13\n\tv_max3_f32 %3, %14, %15, %16\n\t"
                 "v_max3_f32 %4, %17, %18, %19\n\tv_max3_f32 %0, %0, %1, %20\n\tv_max3_f32 %2, %2, %3, %4\n\tv_max_f32 %0, %0, %2"
                 : "=&v"(t0), "=&v"(t1), "=&v"(t2), "=&v"(t3), "=&v"(t4)
                 : "v"(S[0]), "v"(S[1]), "v"(S[2]), "v"(S[3]), "v"(S[4]), "v"(S[5]), "v"(S[6]), "v"(S[7]), "v"(S[8]), "v"(S[9]), "v"(S[10]), "v"(S[11]),
                   "v"(S[12]), "v"(S[13]), "v"(S[14]), "v"(S[15]));
    return t0;
}
DI void attn_tile(const char* Kb, const char* Vb, const char* Qw, f32x16 (&O1)[4], f32x16 (&O2)[4], float& m1, float& l1, float& m2, float& l2,
                  bool diag, bool first, int k0, int qidx, int r, int half) {
    const int ksw = (r >> 1) & 7;
    const char* krow = Kb + r * 128;
    f32x16 S0, S1;
#pragma unroll
    for (int i = 0; i < 16; ++i) { S0[i] = -m1; S1[i] = -m2; }
    __builtin_amdgcn_s_setprio(1);
    {
        bf16x8 kf[4], qf[4];
#pragma unroll
        for (int ks = 0; ks < 4; ++ks) { kf[ks] = lds_frag(krow + (((2 * ks + half) ^ ksw) << 4)); qf[ks] = lds_frag(Qw + ks * 1024); }
#pragma unroll
        for (int ks = 0; ks < 4; ++ks) S0 = MFMA32(kf[ks], qf[ks], S0);
    }
    {
        bf16x8 kf[4], qf[4];
#pragma unroll
        for (int ks = 0; ks < 4; ++ks) { kf[ks] = lds_frag(krow + 4096 + (((2 * ks + half) ^ ksw) << 4)); qf[ks] = lds_frag(Qw + (4 + ks) * 1024); }
#pragma unroll
        for (int ks = 0; ks < 4; ++ks) S1 = MFMA32(kf[ks], qf[ks], S1);
    }
    __builtin_amdgcn_s_setprio(0);
    const int vsw = (r >> 2) & 3;
    const char* vrow = Vb + r * 64;
    const int vo0 = ((0 + half) ^ vsw) << 4, vo1 = ((2 + half) ^ vsw) << 4;
    __builtin_amdgcn_sched_barrier(0);
    if (diag) {
#pragma unroll
        for (int i = 0; i < 16; ++i) if (k0 + crow(i, half) > qidx) { S0[i] = -INFINITY; S1[i] = -INFINITY; }
    }
    float mx0 = max16(S0), mx1 = max16(S1);
    mx0 = fmaxf(mx0, sxf<32>(mx0, half)); mx1 = fmaxf(mx1, sxf<32>(mx1, half));
    if (first || !__all((mx0 <= AT_THR) && (mx1 <= AT_THR))) {
        const float d1 = fmaxf(mx0, 0.f), d2 = fmaxf(mx1, 0.f);
        const float e1 = first ? mx0 : d1, e2 = first ? mx1 : d2;
#pragma unroll
        for (int i = 0; i < 16; ++i) { S0[i] -= e1; S1[i] -= e2; }
        if (!first) {
            const float a1 = __builtin_amdgcn_exp2f(-d1), a2 = __builtin_amdgcn_exp2f(-d2);
#pragma unroll
            for (int d = 0; d < 4; ++d) { O1[d] *= a1; O2[d] *= a2; }
            l1 *= a1; l2 *= a2;
        }
        m1 += e1; m2 += e2;
    }
    __builtin_amdgcn_sched_barrier(0);
    bf16x8 vf[8];
#pragma unroll
    for (int d = 0; d < 4; ++d) { vf[2 * d] = lds_frag(vrow + d * 2048 + vo0); vf[2 * d + 1] = lds_frag(vrow + d * 2048 + vo1); }
    float ps0 = 0.f;
#pragma unroll
    for (int i = 0; i < 16; ++i) { const float pv = __builtin_amdgcn_exp2f(S0[i]); S0[i] = pv; ps0 += pv; }
    l1 += ps0;
    const bf16x8 P00 = pack8(S0, 0), P01 = pack8(S0, 1);
    __builtin_amdgcn_sched_barrier(0);
    __builtin_amdgcn_s_setprio(1);
#pragma unroll
    for (int d = 0; d < 4; ++d) { O1[d] = MFMA32(vf[2 * d], P00, O1[d]); O1[d] = MFMA32(vf[2 * d + 1], P01, O1[d]); }
    float ps1 = 0.f;
#pragma unroll
    for (int i = 0; i < 16; ++i) { const float pv = __builtin_amdgcn_exp2f(S1[i]); S1[i] = pv; ps1 += pv; }
    l2 += ps1;
    const bf16x8 P10 = pack8(S1, 0), P11 = pack8(S1, 1);
#pragma unroll
    for (int g = 0; g < 8; ++g) { __builtin_amdgcn_sched_group_barrier(0x8, 1, 0); __builtin_amdgcn_sched_group_barrier(0x2, 8, 0); }
    __builtin_amdgcn_sched_barrier(0);
#pragma unroll
    for (int d = 0; d < 4; ++d) { O2[d] = MFMA32(vf[2 * d], P10, O2[d]); O2[d] = MFMA32(vf[2 * d + 1], P11, O2[d]); }
    __builtin_amdgcn_s_setprio(0);
    __builtin_amdgcn_sched_barrier(0);
}

DI void attn_phase(const Params& p, char* smem, int bid, int nb) {
    const int tid = opaque_tid(p), wave = __builtin_amdgcn_readfirstlane(tid >> 6), lane = tid & 63, r = lane & 31, half = lane >> 5;
    char* Qs = smem; char* Kbuf = smem + 32768; char* Vbuf = smem + 49152;
    const u16* qk = (const u16*)(p.ws + WS_PROJ);
    const u16* vt = (const u16*)(p.ws + WS_VT);
    const float lam = __uint_as_float(__builtin_amdgcn_readfirstlane(__float_as_uint(
        __expf(wave_sum(p.lq1[lane] * p.lk1[lane], half)) - __expf(wave_sum(p.lq2[lane] * p.lk2[lane], half)) + LAMBDA_INIT)));
    const unsigned q_off = (unsigned)(lane & 31) * 4096u + (unsigned)(lane >> 5) * 16u;
    const unsigned kx = (unsigned)((lane & 7) ^ (lane >> 4));
    const unsigned k_off0 = (unsigned)(lane >> 3) * 4096u + (kx << 4), k_off1 = (unsigned)(lane >> 3) * 4096u + ((kx ^ 4u) << 4);
    const unsigned v_off = (unsigned)(lane >> 2) * (unsigned)(SEQ * 2) + (unsigned)(((lane & 3) ^ ((lane >> 4) & 3)) << 4);
    const int nrounds = (2048 + nb - 1) / nb;
    for (int j = 0; j < nrounds; ++j) {
        const int rank = j * nb + ((j & 1) ? (nb - 1 - bid) : bid);
        if (rank >= 2048) continue;
        const int qb = 127 - (rank >> 4), bh = rank & 15, b = bh >> 3, h = bh & 7;
        const int q0 = qb * 128, tokbase = b * SEQ, qlo = q0 + 32 * wave, qidx = qlo + r;
        const u16* kbase = qk + (size_t)tokbase * 2048 + 1024 + h * 128;
        const u16* vbase = vt + (size_t)(b * 8 + h) * 128 * SEQ;
        const int nkt = 4 * (qb + 1);
        __syncthreads();
        {
            const char* qsrc = (const char*)(qk + (size_t)(tokbase + q0 + wave * 32) * 2048 + h * 128);
#pragma unroll
            for (int i = 0; i < 8; ++i) dma16(qsrc + i * 32, q_off, Qs + (wave * 8 + i) * 1024);
        }
        const char* ksrc = (const char*)(kbase + (size_t)(16 * (wave & 1)) * 2048 + (wave >> 1) * 64);
        const char* vsrc = (const char*)(vbase + (size_t)(wave * 32) * SEQ);
        dma16(ksrc, k_off0, Kbuf + (wave * 2) * 1024);
        dma16(ksrc + 8 * 4096, k_off1, Kbuf + (wave * 2 + 1) * 1024);
        dma16(vsrc, v_off, Vbuf + (wave * 2) * 1024);
        dma16(vsrc + 16 * SEQ * 2, v_off, Vbuf + (wave * 2 + 1) * 1024);
        f32x16 O1[4], O2[4];
#pragma unroll
        for (int d = 0; d < 4; ++d) { O1[d] = zero16(); O2[d] = zero16(); }
        float m1 = 0.f, m2 = 0.f, l1 = 0.f, l2 = 0.f;
        const char* Qw = Qs + wave * 8192 + lane * 16;
        for (int kt = 0; kt < nkt; ++kt) {
            const int k0 = kt * 32, buf = kt & 1;
            asm volatile("s_waitcnt vmcnt(0)" ::: "memory");
            __syncthreads();
            if (kt + 1 < nkt) {
                const char* kn = ksrc + (size_t)(k0 + 32) * 4096; const char* vn = vsrc + (k0 + 32) * 2;
                char* kd = Kbuf + (buf ^ 1) * 8192 + (wave * 2) * 1024; char* vd = Vbuf + (buf ^ 1) * 8192 + (wave * 2) * 1024;
                dma16(kn, k_off0, kd);
                dma16(kn + 8 * 4096, k_off1, kd + 1024);
                dma16(vn, v_off, vd);
                dma16(vn + 16 * SEQ * 2, v_off, vd + 1024);
            }
            if (k0 <= qlo + 31) {
                const bool diag = (k0 + 31 > qlo);
                const char* Kb = Kbuf + buf * 8192; const char* Vb = Vbuf + buf * 8192;
                attn_tile(Kb, Vb, Qw, O1, O2, m1, l1, m2, l2, diag, kt == 0, k0, qidx, r, half);
            }
        }
        l1 += sxf<32>(l1, half); l2 += sxf<32>(l2, half);
        const float i1 = __builtin_amdgcn_rcpf(l1), i2 = lam * __builtin_amdgcn_rcpf(l2);
        float ss = 0.f;
#pragma unroll
        for (int d = 0; d < 4; ++d)
#pragma unroll
            for (int i = 0; i < 16; ++i) { const float v = O1[d][i] * i1 - O2[d][i] * i2; O1[d][i] = v; ss += v * v; }
        ss += sxf<32>(ss, half);
        const float rn = rsqrtf(ss * (1.f / 128.f) + 1e-6f) * (1.f - LAMBDA_INIT);
        u16* orow = (u16*)(p.ws + WS_HN) + (size_t)(tokbase + qidx) * 1024 + h * 128;
        const float* gn = p.diff_norm + h * 128;
        int half_e = half; asm volatile("" : "+v"(half_e));
#pragma unroll
        for (int d = 0; d < 4; ++d)
#pragma unroll
            for (int g = 0; g < 4; ++g) {
                const int c0 = 32 * d + 8 * g + 4 * half_e;
                const f32x4 gv = *(const f32x4*)(gn + c0);
                *(u32x2*)(orow + c0) = u32x2{pk2(O1[d][4 * g] * rn * gv.x, O1[d][4 * g + 1] * rn * gv.y), pk2(O1[d][4 * g + 2] * rn * gv.z, O1[d][4 * g + 3] * rn * gv.w)};
            }
    }
}
extern __shared__ __attribute__((aligned(16))) char dyn_smem[];
constexpr int MEGA_LDS_WORK = G_LDS_BYTES;
constexpr int MEGA_LDS_BYTES = MEGA_LDS_WORK + 16;

__global__ void __launch_bounds__(256, 2) mega_fwd(Params pk) {
    Params p = pk; p.wv = __builtin_amdgcn_readfirstlane((int)(threadIdx.x >> 6));
    volatile LAS unsigned* st = (volatile LAS unsigned*)(dyn_smem + MEGA_LDS_WORK);
    if (threadIdx.x == 0) { st[0] = 0u; st[1] = 0u; st[2] = 0u; st[3] = 0u; }
    __syncthreads();
    XcdBarrier bar = xcd_barrier_post((unsigned*)(p.ws + WS_BAR), st, threadIdx.x == 0);
#define XBAR() xcd_barrier(bar, opaque_tid(p) == 0)
    const int bid = blockIdx.x, nb = gridDim.x;
    const u16* hn = (const u16*)(p.ws + WS_HN);
    phase_prep_a(p, bid, nb);
    asm volatile("; PHASE_END 1");
    XBAR();
    gemm_phase<EPI_GLA_IN>(p, hn, (const u16*)(p.ws + WS_WGIN), GLA_NPAD, nullptr, dyn_smem, bid, nb);
    asm volatile("; PHASE_END 2");
    XBAR();
    gla_pass1(p, dyn_smem, bid, nb);
    asm volatile("; PHASE_END 3");
    XBAR();
    if (nb >= 256) { if (bid < 128) gla_scan(p, bid, 128); else { phase_prep_b(p, bid - 128, nb - 128); phase_tabconv(p, 0, bid - 128, nb - 128); phase_tabconv(p, 1, bid - 128, nb - 128); } }
    else { gla_scan(p, bid, nb); phase_prep_b(p, bid, nb); phase_tabconv(p, 0, bid, nb); phase_tabconv(p, 1, bid, nb); }
    asm volatile("; PHASE_END 4");
    XBAR();
    gla_pass3(p, dyn_smem, bid, nb);
    asm volatile("; PHASE_END 5");
    XBAR();
    gemm_phase<EPI_RESID>(p, hn, (const u16*)(p.ws + WS_WGOUT), 1024, p.x, dyn_smem, bid, nb);
    asm volatile("; PHASE_END 6");
    XBAR();
    phase_rmsnorm(p, p.norm_ffn, bid, nb);
    asm volatile("; PHASE_END 7");
    XBAR();
    peer_query_phase(p, 0, dyn_smem, bid, nb);
    asm volatile("; PHASE_END 8");
    XBAR();
    peer_u_phase(p, 0, dyn_smem, bid, nb);
    XBAR();
    peer_v_phase<false>(p, 0, p.norm_mix + 1024, dyn_smem, bid, nb);
    asm volatile("; PHASE_END 9");
    XBAR();
    gemm_phase<EPI_DIFF_IN>(p, hn, (const u16*)(p.ws + WS_WDIN), 3072, nullptr, dyn_smem, bid, nb);
    asm volatile("; PHASE_END 10");
    XBAR();
    attn_phase(p, dyn_smem, bid, nb);
    asm volatile("; PHASE_END 11");
    XBAR();
    gemm_phase<EPI_RESID>(p, hn, (const u16*)(p.ws + WS_WDOUT), 1024, p.out, dyn_smem, bid, nb);
    asm volatile("; PHASE_END 12");
    XBAR();
    phase_rmsnorm(p, p.norm_ffn + 1024, bid, nb);
    asm volatile("; PHASE_END 13");
    XBAR();
    peer_query_phase(p, 1, dyn_smem, bid, nb);
    asm volatile("; PHASE_END 14");
    XBAR();
    peer_u_phase(p, 1, dyn_smem, bid, nb);
    XBAR();
    peer_v_phase<true>(p, 1, p.norm_final, dyn_smem, bid, nb);
}

extern "C" void kernel_launch(void* const* d_in, const int* in_sizes, int n_in, void* d_out, int out_size, void* d_ws, size_t ws_size, hipStream_t stream) {
    Params p{};
    p.x = (const float*)d_in[0]; p.pos = (const int*)d_in[1]; p.norm_mix = (const float*)d_in[2]; p.norm_ffn = (const float*)d_in[3]; p.norm_final = (const float*)d_in[4];
    p.gla_w_in = (const float*)d_in[5]; p.gla_wgu = (const float*)d_in[6]; p.gla_bg = (const float*)d_in[7]; p.gla_norm = (const float*)d_in[8]; p.gla_w_out = (const float*)d_in[9];
    p.diff_w_in = (const float*)d_in[10]; p.lq1 = (const float*)d_in[11]; p.lk1 = (const float*)d_in[12]; p.lq2 = (const float*)d_in[13]; p.lk2 = (const float*)d_in[14];
    p.diff_norm = (const float*)d_in[15]; p.diff_w_out = (const float*)d_in[16];
    p.peer_wq = (const float*)d_in[17]; p.peer_sk = (const float*)d_in[18]; p.peer_u = (const float*)d_in[19]; p.peer_v = (const float*)d_in[20];
    p.out = (float*)d_out; p.ws = (char*)d_ws;
    static int grid = 0;
    if (grid == 0) {
        int dev = 0, cus = 0, per_cu = 0;
        hipGetDevice(&dev);
        hipDeviceGetAttribute(&cus, hipDeviceAttributeMultiprocessorCount, dev);
        hipFuncSetAttribute((const void*)mega_fwd, hipFuncAttributeMaxDynamicSharedMemorySize, MEGA_LDS_BYTES);
        hipOccupancyMaxActiveBlocksPerMultiprocessor(&per_cu, (const void*)mega_fwd, 256, MEGA_LDS_BYTES);
        (void)hipGetLastError();
        if (per_cu < 1) per_cu = 1;
        if (cus < 1) cus = 256;
        grid = cus * (per_cu < 2 ? per_cu : 2);
    }
    hipMemsetAsync((char*)d_ws + WS_BAR, 0, XCD_BAR_WORDS * sizeof(unsigned), stream);
    mega_fwd<<<grid, 256, MEGA_LDS_BYTES, stream>>>(p);
}
```

```cpp
#include <hip/hip_runtime.h>
#include <stdint.h>

#define DI __device__ __forceinline__
typedef unsigned short u16;
typedef __attribute__((ext_vector_type(8))) short bf16x8;
typedef __attribute__((ext_vector_type(16))) float f32x16;
typedef __attribute__((ext_vector_type(2))) __bf16 bf2_t;
typedef __attribute__((ext_vector_type(4))) unsigned u32x4;
typedef __attribute__((ext_vector_type(2))) unsigned u32x2;
typedef __attribute__((ext_vector_type(4))) float f32x4;
#define MFMA32(a, b, c) __builtin_amdgcn_mfma_f32_32x32x16_bf16((a), (b), (c), 0, 0, 0)

constexpr int T_TOK = 32768, SEQ = 16384, DM = 1024;
constexpr int GLA_NPAD = 3328;
constexpr int NTHR = 256;

constexpr size_t MB = 1024ull * 1024ull;
constexpr size_t WS_BAR    = 0;
constexpr size_t WS_ROPE   = 64 * 1024;
constexpr size_t WS_WGIN   = WS_ROPE + 2 * MB;
constexpr size_t WS_WGOUT  = WS_WGIN + (size_t)GLA_NPAD * 1024 * 2;
constexpr size_t WS_WDIN   = WS_WGOUT + 2 * MB;
constexpr size_t WS_WDOUT  = WS_WDIN + 6 * MB;
constexpr size_t WS_WPQ    = WS_WDOUT + 2 * MB;
constexpr size_t WS_SK     = WS_WPQ + 8 * MB;
constexpr size_t WS_GLR    = WS_SK + 1 * MB;
constexpr size_t WS_DEC    = WS_GLR + 2 * MB;
constexpr size_t WS_TAB    = WS_DEC + 1 * MB;
constexpr size_t WS_HN     = WS_TAB + 64 * MB;
constexpr size_t WS_PROJ   = WS_HN + 64 * MB;
constexpr size_t WS_KV     = WS_PROJ + 192 * MB;
constexpr size_t WS_END    = WS_KV + 128 * MB;
static_assert(WS_END <= 512 * MB, "workspace overflow");
constexpr size_t WS_VT     = WS_PROJ + 128 * MB;
constexpr size_t WS_IDX    = WS_KV;
constexpr size_t WS_GATE   = WS_KV + 16 * MB;
constexpr size_t WS_DOT    = WS_KV + 32 * MB;

struct Params {
    const float* x; const int* pos; const float* norm_mix; const float* norm_ffn; const float* norm_final;
    const float* gla_w_in; const float* gla_wgu; const float* gla_bg; const float* gla_norm; const float* gla_w_out;
    const float* diff_w_in; const float* lq1; const float* lk1; const float* lq2; const float* lk2;
    const float* diff_norm; const float* diff_w_out;
    const float* peer_wq; const float* peer_sk; const float* peer_u; const float* peer_v;
    float* out; char* ws;
    int wv; int pad_;
};

DI int opaque_tid(const Params& p) { int l; asm volatile("v_mbcnt_lo_u32_b32 %0, -1, 0\n\tv_mbcnt_hi_u32_b32 %0, -1, %0" : "=v"(l)); return (p.wv << 6) | l; }
DI unsigned pk2(float a, float b) { bf2_t v = {(__bf16)a, (__bf16)b}; return __builtin_bit_cast(unsigned, v); }
DI u16 f2bf(float a) { return (u16)(pk2(a, 0.f) & 0xffffu); }
DI float bflo(unsigned w) { return __uint_as_float(w << 16); }
DI float bfhi(unsigned w) { return __uint_as_float(w & 0xffff0000u); }
DI float bf2f(u16 h) { return __uint_as_float(((unsigned)h) << 16); }
DI int xcd_unit(int j, int bid, int nb) { return ((nb & 7) == 0) ? j * nb + (bid & 7) * (nb >> 3) + (bid >> 3) : j * nb + bid; }
DI int crow(int i, int half) { return (i & 3) + 8 * (i >> 2) + 4 * half; }
template <int MASK> DI unsigned sxu(unsigned v, int half) {
    if constexpr (MASK < 32) return (unsigned)__builtin_amdgcn_ds_swizzle((int)v, (MASK << 10) | 0x1f);
    else { auto r = __builtin_amdgcn_permlane32_swap(v, v, false, false); return half ? r[0] : r[1]; }
}
template <int MASK> DI float sxf(float v, int half) { return __uint_as_float(sxu<MASK>(__float_as_uint(v), half)); }
template <int MASK> DI int sxi(int v, int half) { return (int)sxu<MASK>((unsigned)v, half); }
DI float wave_sum(float v, int half) { v += sxf<32>(v, half); v += sxf<16>(v, half); v += sxf<8>(v, half); v += sxf<4>(v, half); v += sxf<2>(v, half); v += sxf<1>(v, half); return v; }
DI f32x16 zero16() { f32x16 z; for (int i = 0; i < 16; ++i) z[i] = 0.f; return z; }
DI bf16x8 lds_frag(const char* p) { return *(const bf16x8*)p; }
DI bf16x8 lds_frag2(const char* p0, const char* p1) {
    u32x2 a = *(const u32x2*)p0, b = *(const u32x2*)p1; u32x4 r = {a.x, a.y, b.x, b.y}; return __builtin_bit_cast(bf16x8, r);
}
DI bf16x8 pack8(const f32x16& x, int s) {
    u32x4 r = {pk2(x[8 * s], x[8 * s + 1]), pk2(x[8 * s + 2], x[8 * s + 3]), pk2(x[8 * s + 4], x[8 * s + 5]), pk2(x[8 * s + 6], x[8 * s + 7])};
    return __builtin_bit_cast(bf16x8, r);
}
#define XB_TMO      128
#define XB_XCNT(j)  (256  + 64 * (j))
#define XB_XSUB(j)  (1280 + 64 * (j))
#define XB_XGEN(j)  (2304 + 64 * (j))
#define XB_TOP      3328
#define XB_TOPGEN   3392
#define XCD_BAR_WORDS 3456
#define XB_SPIN_CAP (1u << 18)
#define LAS __attribute__((address_space(3)))

__device__ __forceinline__ unsigned xb_ld(unsigned* p)              { return __hip_atomic_load(p, __ATOMIC_RELAXED, __HIP_MEMORY_SCOPE_AGENT); }
__device__ __forceinline__ unsigned xb_add(unsigned* p, unsigned v) { return __hip_atomic_fetch_add(p, v, __ATOMIC_RELAXED, __HIP_MEMORY_SCOPE_AGENT); }
__device__ __forceinline__ unsigned xb_xcc_id() { return (unsigned)__builtin_amdgcn_s_getreg((3 << 11) | 20) & 0xFu; }
#define XB_SPIN(cond, bar) do { unsigned _sp = 0; while (cond) { __builtin_amdgcn_s_sleep(1); \
    if ((++_sp & 255u) == 0u) { if (xb_ld(&(bar)[XB_TMO])) break; if (_sp > XB_SPIN_CAP) { atomicAdd(&(bar)[XB_TMO], 1u); break; } } } } while (0)

struct XcdBarrier {
    unsigned* bar; unsigned x;
    volatile LAS unsigned* st;
};

__device__ __forceinline__ XcdBarrier xcd_barrier_post(unsigned* bar, volatile LAS unsigned* st, bool t0) {
    XcdBarrier b; b.bar = bar; b.x = xb_xcc_id(); b.st = st;
    if (t0) (void)xb_add(&bar[XB_XCNT(b.x)], 1u);
    return b;
}
__device__ __forceinline__ void xcd_barrier_complete(unsigned* bar, unsigned x, unsigned& nloc, unsigned& nx) {
    const unsigned G = gridDim.x * gridDim.y * gridDim.z;
    unsigned sum, cnt, mine, sp = 0u;
    for (;;) {
        sum = 0u; cnt = 0u; mine = 0u;
#pragma unroll
        for (unsigned j = 0; j < 16; ++j) { const unsigned c = xb_ld(&bar[XB_XCNT(j)]); sum += c; cnt += (c > 0u) ? 1u : 0u; mine = (j == x) ? c : mine; }
        if (sum == G) break;
        __builtin_amdgcn_s_sleep(1);
        if ((++sp & 255u) == 0u) { if (xb_ld(&bar[XB_TMO])) break; if (sp > XB_SPIN_CAP) { atomicAdd(&bar[XB_TMO], 1u); break; } }
    }
    nloc = mine > 0u ? mine : 1u; nx = cnt > 0u ? cnt : 1u;
}

__device__ __forceinline__ void xcd_barrier(const XcdBarrier& b, bool t0) {
    asm volatile("s_waitcnt vmcnt(0)" ::: "memory");
    __syncthreads();
    if (t0) {
        unsigned* bar = b.bar;
        __builtin_amdgcn_s_waitcnt(0);
        unsigned nloc = b.st[0], nx = b.st[1];
        if (nloc == 0u) { xcd_barrier_complete(bar, b.x, nloc, nx); b.st[0] = nloc; b.st[1] = nx; }
        const unsigned old = xb_add(&bar[XB_XSUB(b.x)], 1u);
        const unsigned gen = old / nloc;
        if (old + 1u == (gen + 1u) * nloc) {
            __builtin_amdgcn_fence(__ATOMIC_RELEASE, "agent");
            asm volatile("s_waitcnt vmcnt(0)" ::: "memory");
            const unsigned og = xb_add(&bar[XB_TOP], 1u);
            const unsigned tg = og / nx;
            if (og + 1u == (tg + 1u) * nx) xb_add(&bar[XB_TOPGEN], 1u);
            else XB_SPIN(xb_ld(&bar[XB_TOPGEN]) == tg, bar);
            __builtin_amdgcn_fence(__ATOMIC_ACQUIRE, "agent");
            xb_add(&bar[XB_XGEN(b.x)], 1u);
            asm volatile("s_waitcnt vmcnt(0)" ::: "memory");
        } else {
            XB_SPIN(xb_ld(&bar[XB_XGEN(b.x)]) == gen, bar);
            __builtin_amdgcn_fence(__ATOMIC_ACQUIRE, "agent");
            asm volatile("s_waitcnt vmcnt(0)" ::: "memory");
        }
    }
    __syncthreads();
}
DI void rmsnorm_row_bf16(const float* __restrict__ src, const float* __restrict__ g, u16* __restrict__ dst, int lane) {
    const f32x4* xr = (const f32x4*)src;
    f32x4 a0 = xr[lane * 2], a1 = xr[lane * 2 + 1], b0 = xr[128 + lane * 2], b1 = xr[128 + lane * 2 + 1];
    float ss = a0.x * a0.x + a0.y * a0.y + a0.z * a0.z + a0.w * a0.w + a1.x * a1.x + a1.y * a1.y + a1.z * a1.z + a1.w * a1.w
             + b0.x * b0.x + b0.y * b0.y + b0.z * b0.z + b0.w * b0.w + b1.x * b1.x + b1.y * b1.y + b1.z * b1.z + b1.w * b1.w;
    ss = wave_sum(ss, lane >> 5);
    const float r = rsqrtf(ss * (1.f / 1024.f) + 1e-6f);
    const f32x4* gr = (const f32x4*)g;
    f32x4 g0 = gr[lane * 2], g1 = gr[lane * 2 + 1], g2 = gr[128 + lane * 2], g3 = gr[128 + lane * 2 + 1];
    u32x4 o0 = u32x4{pk2(a0.x * r * g0.x, a0.y * r * g0.y), pk2(a0.z * r * g0.z, a0.w * r * g0.w), pk2(a1.x * r * g1.x, a1.y * r * g1.y), pk2(a1.z * r * g1.z, a1.w * r * g1.w)};
    u32x4 o1 = u32x4{pk2(b0.x * r * g2.x, b0.y * r * g2.y), pk2(b0.z * r * g2.z, b0.w * r * g2.w), pk2(b1.x * r * g3.x, b1.y * r * g3.y), pk2(b1.z * r * g3.z, b1.w * r * g3.w)};
    ((u32x4*)dst)[lane] = o0;
    ((u32x4*)dst)[64 + lane] = o1;
}

DI void tconv_item(const float* __restrict__ src, u16* __restrict__ dst, int K, int N, int item, int lane) {
    const int kgroups = K >> 3;
    const int ng = item / kgroups, kg = item - ng * kgroups;
    const int n = ng * 64 + lane, k0 = kg * 8;
    float v[8];
#pragma unroll
    for (int i = 0; i < 8; ++i) v[i] = (n < N) ? src[(size_t)(k0 + i) * N + n] : 0.f;
    u32x4 o = u32x4{pk2(v[0], v[1]), pk2(v[2], v[3]), pk2(v[4], v[5]), pk2(v[6], v[7])};
    *(u32x4*)(dst + (size_t)n * K + k0) = o;
}

DI void conv8(const float* __restrict__ src, u16* __restrict__ dst, size_t i8) {
    const f32x4* s = (const f32x4*)(src + i8 * 8);
    f32x4 a = s[0], b = s[1];
    *(u32x4*)(dst + i8 * 8) = u32x4{pk2(a.x, a.y), pk2(a.z, a.w), pk2(b.x, b.y), pk2(b.z, b.w)};
}

DI void phase_prep_a(const Params& p, int bid, int nb) {
    const int wave = opaque_tid(p) >> 6, lane = opaque_tid(p) & 63;
    const int gw = bid * 4 + wave, nw = nb * 4;
    char* ws = p.ws;
    for (int t = gw; t < T_TOK; t += nw) rmsnorm_row_bf16(p.x + (size_t)t * DM, p.norm_mix, (u16*)(ws + WS_HN) + (size_t)t * DM, lane);
    const int n0 = (GLA_NPAD / 64) * 128, n1 = n0 + 16 * 128;
    for (int it = gw; it < n1; it += nw) {
        if (it < n0) tconv_item(p.gla_w_in, (u16*)(ws + WS_WGIN), 1024, 3088, it, lane);
        else         tconv_item(p.gla_w_out, (u16*)(ws + WS_WGOUT), 1024, 1024, it - n0, lane);
    }
}
DI void phase_prep_b(const Params& p, int bid, int nb) {
    const int wave = opaque_tid(p) >> 6, lane = opaque_tid(p) & 63;
    const int gw = bid * 4 + wave, nw = nb * 4;
    char* ws = p.ws;
    {
        const int n2 = 48 * 128, n3 = n2 + 16 * 128, n4 = n3 + 32 * 128, n5 = n4 + 32 * 128;
        for (int it = gw; it < n5; it += nw) {
            if (it < n2)      tconv_item(p.diff_w_in, (u16*)(ws + WS_WDIN), 1024, 3072, it, lane);
            else if (it < n3) tconv_item(p.diff_w_out, (u16*)(ws + WS_WDOUT), 1024, 1024, it - n2, lane);
            else if (it < n4) tconv_item(p.peer_wq, (u16*)(ws + WS_WPQ), 1024, 2048, it - n3, lane);
            else              tconv_item(p.peer_wq + (size_t)1024 * 2048, (u16*)(ws + WS_WPQ) + (size_t)2048 * 1024, 1024, 2048, it - n4, lane);
        }
    }
    for (int i = gw * 64 + lane; i < 65536; i += nw * 64) conv8(p.peer_sk, (u16*)(ws + WS_SK), (size_t)i);
    for (int i = gw * 64 + lane; i < T_TOK * 8; i += nw * 64) {
        const int t = i >> 3, f = i & 7;
        const float inv = exp2f(-(float)f * (18.931568569324174f / 8.f));
        const float ang = (float)p.pos[t] * inv;
        float sn, cs; sincosf(ang, &sn, &cs);
        ((float2*)(ws + WS_ROPE))[i] = make_float2(cs, sn);
    }
}

constexpr float TAB_SCALE_U = 64.f, TAB_SCALE_V = 6.f;
DI float clamp6(float a) { return fminf(fmaxf(a, -6.f), 6.f); }
DI unsigned pk8_fp4(f32x4 a, f32x4 b, float s) {
    unsigned w = 0;
    w = __builtin_amdgcn_cvt_scalef32_pk_fp4_f32(w, clamp6(a.x * s), clamp6(a.y * s), 1.0f, 0);
    w = __builtin_amdgcn_cvt_scalef32_pk_fp4_f32(w, clamp6(a.z * s), clamp6(a.w * s), 1.0f, 1);
    w = __builtin_amdgcn_cvt_scalef32_pk_fp4_f32(w, clamp6(b.x * s), clamp6(b.y * s), 1.0f, 2);
    w = __builtin_amdgcn_cvt_scalef32_pk_fp4_f32(w, clamp6(b.z * s), clamp6(b.w * s), 1.0f, 3);
    return w;
}
constexpr float TAB_SCALE_UI = 90.f;
DI unsigned pk8_i4(f32x4 a, f32x4 b, float s) {
    const float f[8] = {a.x, a.y, a.z, a.w, b.x, b.y, b.z, b.w};
    unsigned w = 0;
#pragma unroll
    for (int j = 0; j < 8; ++j) { const int q = (int)rintf(fminf(fmaxf(f[j] * s, -7.f), 7.f)); w |= ((unsigned)q & 15u) << (4 * j); }
    return w;
}
DI void phase_tabconv(const Params& p, int layer, int bid, int nb) {
    const size_t n16 = (size_t)16384 * 1024 / 16;
    const float* su = p.peer_u + (size_t)layer * 16384 * 1024;
    const float* sv = p.peer_v + (size_t)layer * 16384 * 1024;
    unsigned char* du = (unsigned char*)(p.ws + WS_TAB) + (size_t)layer * 16 * MB; unsigned char* dv = du + (size_t)16384 * 512;
    for (size_t i = (size_t)bid * NTHR + opaque_tid(p); i < n16; i += (size_t)nb * NTHR) {
        const f32x4* a = (const f32x4*)(su + i * 16); const f32x4* b = (const f32x4*)(sv + i * 16);
        const f32x4 a0 = __builtin_nontemporal_load(a), a1 = __builtin_nontemporal_load(a + 1), a2 = __builtin_nontemporal_load(a + 2), a3 = __builtin_nontemporal_load(a + 3);
        const f32x4 b0 = __builtin_nontemporal_load(b), b1 = __builtin_nontemporal_load(b + 1), b2 = __builtin_nontemporal_load(b + 2), b3 = __builtin_nontemporal_load(b + 3);
        *(u32x2*)(du + i * 8) = u32x2{pk8_i4(a0, a1, TAB_SCALE_UI), pk8_i4(a2, a3, TAB_SCALE_UI)};
        *(u32x2*)(dv + i * 8) = u32x2{pk8_fp4(b0, b1, TAB_SCALE_V), pk8_fp4(b2, b3, TAB_SCALE_V)};
    }
}

DI void phase_rmsnorm(const Params& p, const float* g, int bid, int nb) {
    const int wave = opaque_tid(p) >> 6, lane = opaque_tid(p) & 63;
    for (int t = bid * 4 + wave; t < T_TOK; t += nb * 4) rmsnorm_row_bf16(p.out + (size_t)t * DM, g, (u16*)(p.ws + WS_HN) + (size_t)t * DM, lane);
}
constexpr int G_ROW = 64;
constexpr int G_SLOT = 384 * G_ROW;
constexpr int G_LDS_BYTES = 3 * G_SLOT;
DI const char* uni_ptr(const char* p) {
    const unsigned long long v = (unsigned long long)p;
    const unsigned lo = __builtin_amdgcn_readfirstlane((unsigned)v), hi = __builtin_amdgcn_readfirstlane((unsigned)(v >> 32));
    return (const char*)(((unsigned long long)hi << 32) | lo);
}
DI void dma16(const char* ubase, unsigned voff, char* lds_wave_base) { __builtin_amdgcn_global_load_lds((const unsigned*)(uni_ptr(ubase) + voff), (unsigned*)lds_wave_base, 16, 0, 0); }

template <int WM, int WN, int BROWS = 128, int AROWS = 128>
DI void gemm_mainloop(const Params& p, const u16* __restrict__ A, int ld, const u16* __restrict__ Bt, int  , int K, char* smem, int wm0, int wn0, f32x16 (&acc)[WM][WN]) {
    static_assert(AROWS + BROWS == 384 && (AROWS % 64) == 0, "slot shape");
    const int tid = opaque_tid(p), lane = tid & 63, r = lane & 31, half = lane >> 5;
    const int wave = p.wv;
    const unsigned voff = (unsigned)(lane >> 2) * (unsigned)(ld * 2) + (unsigned)(((lane & 3) ^ ((lane >> 4) & 3)) << 4);
    const char* ab = (const char*)A + (size_t)(wave * 16) * ld * 2;
    const char* bb = (const char*)Bt + (size_t)(wave * 16) * ld * 2;
    const size_t pstep = (size_t)64 * ld * 2;
    char* dbase = smem + wave * 1024;
    constexpr int NPA = AROWS / 64, NPB = BROWS / 64;
#define G_ISSUE(kt_, slot_) do { const size_t ko_ = (size_t)(kt_) * 64; char* d_ = dbase + (slot_) * G_SLOT; \
        _Pragma("unroll") for (int i_ = 0; i_ < NPA; ++i_) dma16(ab + i_ * pstep + ko_, voff, d_ + i_ * 4096); \
        _Pragma("unroll") for (int i_ = 0; i_ < NPB; ++i_) dma16(bb + i_ * pstep + ko_, voff, d_ + (NPA + i_) * 4096); } while (0)
    const int nk = K >> 5;
    asm volatile("s_waitcnt vmcnt(0)\n\ts_barrier" ::: "memory");
    G_ISSUE(0, 0); G_ISSUE(1, 1); G_ISSUE(2, 2);
    const int sw = (r >> 2) & 3;
    const int fo0 = r * G_ROW + ((half ^ sw) << 4), fo1 = r * G_ROW + (((2 + half) ^ sw) << 4);
    int slot = 0;
    for (int kt = 0; kt < nk; ++kt) {
        if (kt + 2 < nk)      asm volatile("s_waitcnt vmcnt(12)\n\ts_barrier" ::: "memory");
        else if (kt + 1 < nk) asm volatile("s_waitcnt vmcnt(6)\n\ts_barrier" ::: "memory");
        else                  asm volatile("s_waitcnt vmcnt(0)\n\ts_barrier" ::: "memory");
        const char* As = smem + slot * G_SLOT; const char* Bs = As + AROWS * G_ROW;
        bf16x8 af[2][WM], bfr[2][WN];
#pragma unroll
        for (int ks = 0; ks < 2; ++ks) {
            const int fo = ks ? fo1 : fo0;
#pragma unroll
            for (int i = 0; i < WM; ++i) af[ks][i] = lds_frag(As + (wm0 + 32 * i) * G_ROW + fo);
#pragma unroll
            for (int j = 0; j < WN; ++j) bfr[ks][j] = lds_frag(Bs + (wn0 + 32 * j) * G_ROW + fo);
        }
        asm volatile("s_waitcnt lgkmcnt(0)\n\ts_barrier" ::: "memory");
        if (kt + 3 < nk) G_ISSUE(kt + 3, slot);
#pragma unroll
        for (int ks = 0; ks < 2; ++ks)
#pragma unroll
            for (int i = 0; i < WM; ++i)
#pragma unroll
                for (int j = 0; j < WN; ++j) acc[i][j] = MFMA32(af[ks][i], bfr[ks][j], acc[i][j]);
        slot = (slot == 2) ? 0 : slot + 1;
    }
#undef G_ISSUE
}

enum { EPI_GLA_IN = 0, EPI_RESID = 1, EPI_DIFF_IN = 2 };

template <int EPI, int BN = 256>
DI void gemm_phase(const Params& p, const u16* A, const u16* Bt, int N, const float* resid, char* smem, int bid, int nb) {
    constexpr int TN = BN / 64;
    const int ntn = N / BN, ntm = T_TOK / 128;
    const int tid = opaque_tid(p), wave = tid >> 6, lane = tid & 63, r = lane & 31, half = lane >> 5;
    const int wm0 = (wave >> 1) * 64, wn0 = (wave & 1) * (BN / 2);
    for (int j = 0; j * nb < ntn * ntm; ++j) {
        const int u = xcd_unit(j, bid, nb);
        if (u >= ntn * ntm) continue;
        const int mt = u / ntn, nt = u - mt * ntn;
        const int m0 = mt * 128, n0 = nt * BN;
        f32x16 acc[2][TN];
#pragma unroll
        for (int i = 0; i < 2; ++i)
#pragma unroll
            for (int j = 0; j < TN; ++j) acc[i][j] = zero16();
        gemm_mainloop<2, TN, BN>(p, A + (size_t)m0 * 1024, 1024, Bt + (size_t)n0 * 1024, 1024, 1024, smem, wm0, wn0, acc);
        if constexpr (EPI == EPI_RESID) {
#pragma unroll
            for (int ti = 0; ti < 2; ++ti)
#pragma unroll
                for (int tj0 = 0; tj0 < TN; tj0 += 2) {
                    float rv[2][16];
#pragma unroll
                    for (int tt = 0; tt < 2; ++tt)
#pragma unroll
                        for (int i = 0; i < 16; ++i) rv[tt][i] = resid[(size_t)(m0 + wm0 + 32 * ti + crow(i, half)) * 1024 + n0 + wn0 + 32 * (tj0 + tt) + r];
#pragma unroll
                    for (int tt = 0; tt < 2; ++tt)
#pragma unroll
                        for (int i = 0; i < 16; ++i) p.out[(size_t)(m0 + wm0 + 32 * ti + crow(i, half)) * 1024 + n0 + wn0 + 32 * (tj0 + tt) + r] = rv[tt][i] + acc[ti][tj0 + tt][i];
                }
        } else
#pragma unroll
        for (int ti = 0; ti < 2; ++ti)
#pragma unroll
            for (int tj = 0; tj < TN; ++tj) {
                const int col = n0 + wn0 + 32 * tj + r;
                const int rowb = m0 + wm0 + 32 * ti;
                if constexpr (EPI == EPI_GLA_IN) {
                    if (col < 3072) {
                        u16* o = (u16*)(p.ws + WS_PROJ);
#pragma unroll
                        for (int i = 0; i < 16; ++i) o[(size_t)(rowb + crow(i, half)) * 3072 + col] = f2bf(acc[ti][tj][i]);
                    } else if (col < 3088) {
                        float* o = (float*)(p.ws + WS_GLR);
#pragma unroll
                        for (int i = 0; i < 16; ++i) o[(size_t)(rowb + crow(i, half)) * 16 + (col - 3072)] = acc[ti][tj][i];
                    }
                } else if constexpr (EPI == EPI_RESID) {
#pragma unroll
                    for (int i = 0; i < 16; ++i) {
                        const size_t off = (size_t)(rowb + crow(i, half)) * 1024 + col;
                        p.out[off] = resid[off] + acc[ti][tj][i];
                    }
                } else if constexpr (EPI == EPI_DIFF_IN) {
                    if (col < 2048) {
                        const int c64 = col & 63;
                        const float qs = (col < 1024) ? 0.125f * 1.4426950408889634f : 1.0f;
                        const float2* cst = (const float2*)(p.ws + WS_ROPE);
                        u16* o = (u16*)(p.ws + WS_PROJ);
                        const bool rot = ((32 * tj) & 63) == 0;
                        float2 csr[16];
                        if (rot) {
#pragma unroll
                            for (int i = 0; i < 16; ++i) csr[i] = cst[(size_t)(rowb + crow(i, half)) * 8 + (c64 & 7)];
                        }
#pragma unroll
                        for (int i = 0; i < 16; ++i) {
                            const int row = rowb + crow(i, half);
                            float v = acc[ti][tj][i];
                            if (rot) {
                                const float pv = sxf<8>(v, half);
                                const float2 cs = csr[i];
                                if (c64 < 16) v = (c64 < 8) ? (v * cs.x - pv * cs.y) : (v * cs.x + pv * cs.y);
                            }
                            o[(size_t)row * 2048 + col] = f2bf(v * qs);
                        }
                    } else {
                        const int hv = (col - 2048) >> 7, dv = (col - 2048) & 127;
                        const int b = rowb >> 14, s0 = rowb & (SEQ - 1);
                        u16* o = (u16*)(p.ws + WS_VT) + ((size_t)(b * 8 + hv) * 128 + dv) * SEQ + s0;
#pragma unroll
                        for (int g = 0; g < 4; ++g) {
                            u32x2 w = {pk2(acc[ti][tj][4 * g], acc[ti][tj][4 * g + 1]), pk2(acc[ti][tj][4 * g + 2], acc[ti][tj][4 * g + 3])};
                            *(u32x2*)(o + 16 * (g >> 1) + 8 * half + 4 * (g & 1)) = w;
                        }
                    }
                }
            }
    }
}
constexpr int CUM_LD = 129;

DI float log_sigmoid(float z) {
    const float e = __builtin_amdgcn_exp2f(-fabsf(z) * 1.4426950408889634f);
    return fminf(z, 0.f) - __builtin_amdgcn_logf(1.f + e) * 0.6931471805599453f;
}

DI void gla_cum(const Params& p, int tok0, int h, float* cumL, float* glrL) {
    const int tid = opaque_tid(p), d = tid & 127, part = tid >> 7;
    const float* glr = (const float*)(p.ws + WS_GLR) + (size_t)tok0 * 16;
    ((f32x4*)glrL)[tid] = ((const f32x4*)glr)[tid];
    float w[16];
#pragma unroll
    for (int q = 0; q < 16; ++q) w[q] = p.gla_wgu[q * 512 + h * 128 + d];
    const float bias = p.gla_bg[h * 128 + d];
    __syncthreads();
    float run = 0.f;
#pragma unroll 1
    for (int c0 = part * 32; c0 < part * 32 + 32; c0 += 8) {
        float gl[8];
#pragma unroll
        for (int j = 0; j < 8; ++j) {
            const f32x4* gr = (const f32x4*)(glrL + (c0 + j) * 16);
            const f32x4 g0 = gr[0], g1 = gr[1], g2 = gr[2], g3 = gr[3];
            const float p0 = g0.x * w[0] + g0.y * w[1] + g0.z * w[2] + g0.w * w[3];
            const float p1 = g1.x * w[4] + g1.y * w[5] + g1.z * w[6] + g1.w * w[7];
            const float p2 = g2.x * w[8] + g2.y * w[9] + g2.z * w[10] + g2.w * w[11];
            const float p3 = g3.x * w[12] + g3.y * w[13] + g3.z * w[14] + g3.w * w[15];
            gl[j] = log_sigmoid(bias + ((p0 + p1) + (p2 + p3))) * (1.f / 16.f);
        }
#pragma unroll
        for (int j = 0; j < 8; ++j) { run += gl[j]; cumL[(c0 + j) * CUM_LD + d] = run; }
    }
    __syncthreads();
    if (part == 1) {
        const float add = cumL[31 * CUM_LD + d];
#pragma unroll 8
        for (int c = 32; c < 64; ++c) cumL[c * CUM_LD + d] += add;
    }
    __syncthreads();
}

DI void gla_pass1(const Params& p, char* smem, int bid, int nb) {
    const int tid = opaque_tid(p), wave = tid >> 6, lane = tid & 63, r = lane & 31, half = lane >> 5;
    float* cumL = (float*)smem; char* vT = smem; char* kdT = smem + 36864; float* glrL = (float*)(smem + 36864);
    const u16* proj = (const u16*)(p.ws + WS_PROJ);
    for (int u = bid; u < 2048; u += nb) {
        const int bh = u >> 8, n = u & 255, b = bh >> 2, h = bh & 3;
        const int tok0 = b * SEQ + n * 64;
        __syncthreads();
        gla_cum(p, tok0, h, cumL, glrL);
        if (tid < 128) ((float*)(p.ws + WS_DEC))[(size_t)u * 128 + tid] = __expf(cumL[63 * CUM_LD + tid]);
#pragma unroll 1
        for (int it = 0; it < 4; ++it) {
            const int d0 = (wave + 4 * it) * 8;
            const u32x4 kreg = *(const u32x4*)(proj + (size_t)(tok0 + lane) * 3072 + 512 + h * 128 + d0);
            const unsigned wv[4] = {kreg.x, kreg.y, kreg.z, kreg.w};
            const float* cl = cumL + 63 * CUM_LD + d0; const float* cc = cumL + lane * CUM_LD + d0;
            char* dst = kdT + (d0 * 72 + lane) * 2;
#pragma unroll
            for (int i = 0; i < 8; ++i) {
                const float kv = (i & 1) ? bfhi(wv[i >> 1]) : bflo(wv[i >> 1]);
                const float e = __expf(cl[i] - cc[i]);
                *(u16*)(dst + i * 144) = f2bf(kv * e);
            }
        }
        __syncthreads();
#pragma unroll 1
        for (int it = 0; it < 8; ++it) {
            const int v0 = (wave + 4 * it) * 8;
            const u32x4 vr = *(const u32x4*)(proj + (size_t)(tok0 + lane) * 3072 + 1024 + h * 256 + v0);
            const unsigned wv[4] = {vr.x, vr.y, vr.z, vr.w};
            char* dst = vT + (v0 * 72 + lane) * 2;
#pragma unroll
            for (int i = 0; i < 8; ++i) *(u16*)(dst + i * 144) = (u16)((i & 1) ? (wv[i >> 1] >> 16) : (wv[i >> 1] & 0xffffu));
        }
        __syncthreads();
        u16* kvo = (u16*)(p.ws + WS_KV) + (size_t)u * 32768;
#pragma unroll 1
        for (int jh = 0; jh < 2; ++jh) {
            f32x16 acc[2][2];
#pragma unroll
            for (int i = 0; i < 2; ++i)
#pragma unroll
                for (int j = 0; j < 2; ++j) acc[i][j] = zero16();
#pragma unroll
            for (int ks = 0; ks < 4; ++ks) {
                bf16x8 af[2], bfr[2];
#pragma unroll
                for (int i = 0; i < 2; ++i) af[i] = lds_frag(vT + (64 * wave + 32 * i + r) * 144 + ks * 32 + half * 16);
#pragma unroll
                for (int j = 0; j < 2; ++j) bfr[j] = lds_frag(kdT + (64 * jh + 32 * j + r) * 144 + ks * 32 + half * 16);
#pragma unroll
                for (int i = 0; i < 2; ++i)
#pragma unroll
                    for (int j = 0; j < 2; ++j) acc[i][j] = MFMA32(af[i], bfr[j], acc[i][j]);
            }
#pragma unroll
            for (int i = 0; i < 2; ++i)
#pragma unroll
                for (int j = 0; j < 2; ++j)
#pragma unroll
                    for (int q = 0; q < 16; ++q) kvo[(64 * wave + 32 * i + crow(q, half)) * 128 + 64 * jh + 32 * j + r] = f2bf(acc[i][j][q]);
        }
    }
}

DI void gla_scan(const Params& p, int bid, int nb) {
    u16* kv = (u16*)(p.ws + WS_KV);
    const float* dec = (const float*)(p.ws + WS_DEC);
    for (int g = bid * NTHR + opaque_tid(p); g < 32768; g += nb * NTHR) {
        const int bh = g >> 12, rem = g & 4095;
        const int dch = rem & 15;
        float st[8];
#pragma unroll
        for (int i = 0; i < 8; ++i) st[i] = 0.f;
        const size_t base = (size_t)bh * 256 * 32768 + (size_t)rem * 8;
        const float* dbase = dec + (size_t)bh * 256 * 128 + dch * 8;
        for (int n0 = 0; n0 < 256; n0 += 8) {
            u32x4 kk[8]; f32x4 d0[8], d1[8];
#pragma unroll
            for (int j = 0; j < 8; ++j) {
                kk[j] = *(const u32x4*)(kv + base + (size_t)(n0 + j) * 32768);
                d0[j] = *(const f32x4*)(dbase + (size_t)(n0 + j) * 128);
                d1[j] = *(const f32x4*)(dbase + (size_t)(n0 + j) * 128 + 4);
            }
#pragma unroll
            for (int j = 0; j < 8; ++j) {
                const u32x4 o = u32x4{pk2(st[0], st[1]), pk2(st[2], st[3]), pk2(st[4], st[5]), pk2(st[6], st[7])};
                *(u32x4*)(kv + base + (size_t)(n0 + j) * 32768) = o;
                const float dd[8] = {d0[j].x, d0[j].y, d0[j].z, d0[j].w, d1[j].x, d1[j].y, d1[j].z, d1[j].w};
                const unsigned wv[4] = {kk[j].x, kk[j].y, kk[j].z, kk[j].w};
#pragma unroll
                for (int i = 0; i < 8; ++i) st[i] = dd[i] * st[i] + ((i & 1) ? bfhi(wv[i >> 1]) : bflo(wv[i >> 1]));
            }
        }
    }
}

DI void gla_pass3(const Params& p, char* smem, int bid, int nb) {
    const int tid = opaque_tid(p), wave = tid >> 6, lane = tid & 63, r = lane & 31, half = lane >> 5;
    float* cumL = (float*)smem; char* vT = smem; char* aM = smem + 18432; char* qd = smem + 36864; char* kq = smem + 54272; float* glrL = (float*)(smem + 36864);
    float* oL = (float*)smem;
    const u16* proj = (const u16*)(p.ws + WS_PROJ);
    const float scale = 0.08838834764831845f;
    for (int u = bid; u < 2048; u += nb) {
        const int bh = u >> 8, n = u & 255, b = bh >> 2, h = bh & 3;
        const int tok0 = b * SEQ + n * 64;
        const u16* st = (const u16*)(p.ws + WS_KV) + (size_t)u * 32768;
        __syncthreads();
        u32x4 qreg[4], kreg[4];
#pragma unroll
        for (int it = 0; it < 4; ++it) {
            const int id = tid + 256 * it, c = id >> 4, dch = id & 15;
            qreg[it] = *(const u32x4*)(proj + (size_t)(tok0 + c) * 3072 + h * 128 + dch * 8);
            kreg[it] = *(const u32x4*)(proj + (size_t)(tok0 + c) * 3072 + 512 + h * 128 + dch * 8);
        }
        gla_cum(p, tok0, h, cumL, glrL);
        u32x4 vreg[4], sreg[8];
#pragma unroll
        for (int it = 0; it < 4; ++it) {
            const int q = wave + 4 * it, wq = q >> 2, vv0 = (q & 3) * 8;
            vreg[it] = *(const u32x4*)(proj + (size_t)(tok0 + lane) * 3072 + 1024 + h * 256 + 64 * wq + vv0);
        }
#pragma unroll
        for (int ks = 0; ks < 8; ++ks) sreg[ks] = *(const u32x4*)(st + (size_t)(64 * wave + r) * 128 + ks * 16 + half * 8);
#pragma unroll
        for (int it = 0; it < 4; ++it) {
            const int id = tid + 256 * it, c = id >> 4, dch = id & 15;
            const unsigned qw[4] = {qreg[it].x, qreg[it].y, qreg[it].z, qreg[it].w}, kw[4] = {kreg[it].x, kreg[it].y, kreg[it].z, kreg[it].w};
            unsigned qo[4], ko[4];
#pragma unroll
            for (int i = 0; i < 4; ++i) {
                const int d = dch * 8 + 2 * i;
                const float e0 = cumL[c * CUM_LD + d] - cumL[31 * CUM_LD + d], e1 = cumL[c * CUM_LD + d + 1] - cumL[31 * CUM_LD + d + 1];
                qo[i] = pk2(bflo(qw[i]) * scale * __expf(e0), bfhi(qw[i]) * scale * __expf(e1));
                ko[i] = pk2(bflo(kw[i]) * __expf(-e0), bfhi(kw[i]) * __expf(-e1));
            }
            *(u32x4*)(qd + c * 272 + dch * 16) = u32x4{qo[0], qo[1], qo[2], qo[3]};
            *(u32x4*)(kq + c * 272 + dch * 16) = u32x4{ko[0], ko[1], ko[2], ko[3]};
        }
        __syncthreads();
        const int rb = wave >> 1, cb = wave & 1;
        f32x16 aacc = zero16();
        if (cb <= rb) {
#pragma unroll
            for (int ks = 0; ks < 8; ++ks) {
                const bf16x8 af = lds_frag(qd + (32 * rb + r) * 272 + ks * 32 + half * 16);
                const bf16x8 bf = lds_frag(kq + (32 * cb + r) * 272 + ks * 32 + half * 16);
                aacc = MFMA32(af, bf, aacc);
            }
        }
        __syncthreads();
#pragma unroll
        for (int it = 0; it < 4; ++it) {
            const int id = tid + 256 * it, c = id >> 4, dch = id & 15;
            const unsigned qw[4] = {qreg[it].x, qreg[it].y, qreg[it].z, qreg[it].w};
            unsigned qo[4];
#pragma unroll
            for (int i = 0; i < 4; ++i) {
                const int d = dch * 8 + 2 * i;
                qo[i] = pk2(bflo(qw[i]) * scale * __expf(cumL[c * CUM_LD + d]), bfhi(qw[i]) * scale * __expf(cumL[c * CUM_LD + d + 1]));
            }
            *(u32x4*)(kq + c * 272 + dch * 16) = u32x4{qo[0], qo[1], qo[2], qo[3]};
        }
        __syncthreads();
#pragma unroll
        for (int q = 0; q < 16; ++q) {
            const int c = 32 * rb + crow(q, half), j = 32 * cb + r;
            *(u16*)(aM + (c * 72 + j) * 2) = f2bf((j <= c) ? aacc[q] : 0.f);
        }
        f32x16 o[2][2];
#pragma unroll
        for (int i = 0; i < 2; ++i)
#pragma unroll
            for (int j = 0; j < 2; ++j) o[i][j] = zero16();
        u32x2 rreg[16];
#pragma unroll
        for (int ps = 0; ps < 2; ++ps) {
            if (ps == 1) __syncthreads();
#pragma unroll
            for (int it = 0; it < 4; ++it) {
                const int q = wave + 4 * it, wq = q >> 2, vv0 = (q & 3) * 8;
                const unsigned wv[4] = {vreg[it].x, vreg[it].y, vreg[it].z, vreg[it].w};
                char* dst = vT + ((wq * 32 + vv0) * 72 + lane) * 2;
#pragma unroll
                for (int i = 0; i < 8; ++i) *(u16*)(dst + i * 144) = (u16)((i & 1) ? (wv[i >> 1] >> 16) : (wv[i >> 1] & 0xffffu));
            }
            if (ps == 0) {
#pragma unroll
                for (int it = 0; it < 4; ++it) {
                    const int q = wave + 4 * it, wq = q >> 2, vv0 = (q & 3) * 8;
                    vreg[it] = *(const u32x4*)(proj + (size_t)(tok0 + lane) * 3072 + 1024 + h * 256 + 64 * wq + 32 + vv0);
                }
            } else {
                const u16* rrow = proj + (size_t)(tok0 + (tid >> 2)) * 3072 + 2048 + h * 256 + 4 * (tid & 3);
#pragma unroll
                for (int j = 0; j < 16; ++j) rreg[j] = *(const u32x2*)(rrow + 16 * j);
            }
            __syncthreads();
#pragma unroll
            for (int ks = 0; ks < 4; ++ks) {
                const bf16x8 bf = lds_frag(vT + (wave * 32 + r) * 144 + ks * 32 + half * 16);
#pragma unroll
                for (int i = 0; i < 2; ++i) {
                    const bf16x8 af = lds_frag(aM + (32 * i + r) * 144 + ks * 32 + half * 16);
                    o[ps][i] = MFMA32(af, bf, o[ps][i]);
                }
            }
#pragma unroll
            for (int ks = 0; ks < 8; ++ks) {
                const bf16x8 bf = __builtin_bit_cast(bf16x8, sreg[ks]);
#pragma unroll
                for (int i = 0; i < 2; ++i) {
                    const bf16x8 af = lds_frag(kq + (32 * i + r) * 272 + ks * 32 + half * 16);
                    o[ps][i] = MFMA32(af, bf, o[ps][i]);
                }
            }
            if (ps == 0) {
#pragma unroll
                for (int ks = 0; ks < 8; ++ks) sreg[ks] = *(const u32x4*)(st + (size_t)(64 * wave + 32 + r) * 128 + ks * 16 + half * 8);
            }
        }
        __syncthreads();
#pragma unroll
        for (int ps = 0; ps < 2; ++ps)
#pragma unroll
            for (int i = 0; i < 2; ++i)
#pragma unroll
                for (int q = 0; q < 16; ++q) oL[(32 * i + crow(q, half)) * 260 + 64 * wave + 32 * ps + r] = o[ps][i][q];
        __syncthreads();
        {
            const int c = tid >> 2, qq = tid & 3;
            f32x4 vals[16]; float ss = 0.f;
#pragma unroll
            for (int j = 0; j < 16; ++j) {
                vals[j] = *(const f32x4*)(oL + c * 260 + 16 * j + 4 * qq);
                ss += vals[j].x * vals[j].x + vals[j].y * vals[j].y + vals[j].z * vals[j].z + vals[j].w * vals[j].w;
            }
            ss += sxf<1>(ss, 0); ss += sxf<2>(ss, 0);
            const float rinv = rsqrtf(ss * (1.f / 256.f) + 1e-6f);
            const float* gn = p.gla_norm + h * 256;
            u16* orow = (u16*)(p.ws + WS_HN) + (size_t)(tok0 + c) * 1024 + h * 256;
#pragma unroll
            for (int j = 0; j < 16; ++j) {
                const int v0 = 16 * j + 4 * qq;
                const u32x2 rr = rreg[j];
                const f32x4 g4 = *(const f32x4*)(gn + v0);
                const float r0 = bflo(rr.x), r1 = bfhi(rr.x), r2 = bflo(rr.y), r3 = bfhi(rr.y);
                const float o0 = vals[j].x * rinv * g4.x * (r0 / (1.f + __expf(-r0)));
                const float o1 = vals[j].y * rinv * g4.y * (r1 / (1.f + __expf(-r1)));
                const float o2 = vals[j].z * rinv * g4.z * (r2 / (1.f + __expf(-r2)));
                const float o3 = vals[j].w * rinv * g4.w * (r3 / (1.f + __expf(-r3)));
                *(u32x2*)(orow + v0) = u32x2{pk2(o0, o1), pk2(o2, o3)};
            }
        }
    }
}
DI unsigned sortable(float v) { const unsigned u = __float_as_uint(v); return (u & 0x80000000u) ? ~u : (u | 0x80000000u); }
DI float unsortable(unsigned k) { const unsigned u = (k & 0x80000000u) ? (k & 0x7fffffffu) : ~k; return __uint_as_float(u); }
DI void ins16(unsigned (&L)[16], unsigned x) {
#pragma unroll
    for (int i = 0; i < 16; ++i) { const unsigned hi = max(L[i], x); x = min(L[i], x); L[i] = hi; }
}

DI void ce(unsigned& a, unsigned& b) { const unsigned hi = max(a, b), lo = min(a, b); a = hi; b = lo; }
template <int N> DI void bitonic_sort_desc(unsigned (&v)[N]) {
#pragma unroll
    for (int k = 2; k <= N; k <<= 1)
#pragma unroll
        for (int j = k >> 1; j > 0; j >>= 1)
#pragma unroll
            for (int i = 0; i < N; ++i) {
                const int l = i ^ j;
                if (l > i) { if ((i & k) == 0) ce(v[i], v[l]); else ce(v[l], v[i]); }
            }
}
DI void top16_merge(unsigned (&a)[16], const unsigned (&b)[16]) {
#pragma unroll
    for (int i = 0; i < 16; ++i) a[i] = max(a[i], b[15 - i]);
#pragma unroll
    for (int j = 8; j > 0; j >>= 1)
#pragma unroll
        for (int i = 0; i < 16; ++i) { const int l = i ^ j; if (l > i) ce(a[i], a[l]); }
}
constexpr int PQ_LDS_BYTES = G_LDS_BYTES;
DI void peer_query_phase(const Params& p, int layer, char* smem, int bid, int nb) {
    const int tid = opaque_tid(p), wave = tid >> 6, lane = tid & 63, r = lane & 31, half = lane >> 5;
    const u16* hn = (const u16*)(p.ws + WS_HN);
    const u16* wq = (const u16*)(p.ws + WS_WPQ) + (size_t)layer * 2048 * 1024;
    const u16* sk = (const u16*)(p.ws + WS_SK) + (size_t)layer * 8 * 2 * 128 * 128;
    char* Bk = smem;
    for (int j = 0; j * nb < 2048; ++j) {
        const int u = xcd_unit(j, bid, nb);
        if (u >= 2048) continue;
        const int tb = u >> 3, h = u & 7;
        unsigned Lp[2][16];
        __syncthreads();
        f32x16 acc[8][1];
#pragma unroll
        for (int i = 0; i < 8; ++i) acc[i][0] = zero16();
        gemm_mainloop<8, 1, 128, 256>(p, wq + (size_t)(h * 256) * 1024, 1024, hn + (size_t)(tb * 128) * 1024, 1024, 1024, smem, 0, 32 * wave, acc);
        bf16x8 bqa[2][8];
#pragma unroll
        for (int pp = 0; pp < 2; ++pp)
#pragma unroll
            for (int di = 0; di < 4; ++di) { bqa[pp][2 * di] = pack8(acc[4 * pp + di][0], 0); bqa[pp][2 * di + 1] = pack8(acc[4 * pp + di][0], 1); }
#pragma unroll
        for (int pp = 0; pp < 2; ++pp) {
            __syncthreads();
            const u16* skt = sk + (size_t)(h * 2 + pp) * 128 * 128;
            int tidl = tid; asm volatile("" : "+v"(tidl));
            {
                const int n0 = tidl >> 4, ch = tidl & 15;
                u32x4 tmp[8];
#pragma unroll
                for (int it = 0; it < 8; ++it) tmp[it] = *(const u32x4*)(skt + (n0 + 16 * it) * 128 + ch * 8);
#pragma unroll
                for (int it = 0; it < 8; ++it) *(u32x4*)(Bk + (n0 + 16 * it) * 272 + ch * 16) = tmp[it];
            }
            __syncthreads();
            f32x16 sc[4];
#pragma unroll
            for (int i = 0; i < 4; ++i) sc[i] = zero16();
#pragma unroll
            for (int di = 0; di < 4; ++di)
#pragma unroll
                for (int s = 0; s < 2; ++s) {
                    const bf16x8 bq = bqa[pp][2 * di + s];
#pragma unroll
                    for (int kb = 0; kb < 4; ++kb) {
                        const char* rowp = Bk + (32 * kb + r) * 272 + (32 * di + 16 * s + 4 * half) * 2;
                        const bf16x8 ak = lds_frag2(rowp, rowp + 16);
                        sc[kb] = MFMA32(ak, bq, sc[kb]);
                    }
                }
            unsigned L[16];
            {
                unsigned G[4][16];
                int hq4 = 4 * half; asm volatile("" : "+v"(hq4));
#pragma unroll
                for (int kb = 0; kb < 4; ++kb) {
#pragma unroll
                    for (int q = 0; q < 16; ++q) G[kb][q] = (sortable(sc[kb][q]) & 0xffffff80u) | (unsigned)(127 - 32 * kb - crow(q, 0) - hq4);
                    bitonic_sort_desc<16>(G[kb]);
                }
                top16_merge(G[0], G[1]); top16_merge(G[2], G[3]); top16_merge(G[0], G[2]);
#pragma unroll
                for (int i = 0; i < 16; ++i) L[i] = G[0][i];
            }
            {
                unsigned O[16];
#pragma unroll
                for (int i = 0; i < 16; ++i) O[i] = sxu<32>(L[i], half);
                top16_merge(L, O);
            }
#pragma unroll
            for (int i = 0; i < 16; ++i) Lp[pp][i] = L[i];
        }
        float s1[16], s2[16]; int i1[16], i2[16];
#pragma unroll
        for (int i = 0; i < 16; ++i) {
            s1[i] = unsortable(Lp[0][i] & 0xffffff80u); i1[i] = 127 - (int)(Lp[0][i] & 127u);
            s2[i] = unsortable(Lp[1][i] & 0xffffff80u); i2[i] = 127 - (int)(Lp[1][i] & 127u);
        }
        __syncthreads();
        int* tabL = (int*)(smem + wave * 8192);
        if (half == 0) {
#pragma unroll
            for (int i = 0; i < 16; ++i) { tabL[i * 32 + r] = i1[i]; tabL[(16 + i) * 32 + r] = i2[i]; tabL[(32 + i) * 32 + r] = __float_as_int(s1[i]); tabL[(48 + i) * 32 + r] = __float_as_int(s2[i]); }
        }
        unsigned C[16], D[16];
#pragma unroll
        for (int i = 0; i < 16; ++i) { C[i] = 0u; D[i] = 0u; }
#define CANDK(a0, b0, a1, b1) ((sortable(half ? (s1[a1] + s2[b1]) : (s1[a0] + s2[b0])) & 0xffffff00u) | (unsigned)(255 - (half ? (16 * a1 + b1) : (16 * a0 + b0))))
        C[0] = CANDK(0, 0, 0, 1);
        C[1] = CANDK(0, 2, 0, 3);
        C[2] = CANDK(0, 4, 0, 5);
        C[3] = CANDK(0, 6, 0, 7);
        C[4] = CANDK(0, 8, 0, 9);
        C[5] = CANDK(0, 10, 0, 11);
        C[6] = CANDK(0, 12, 0, 13);
        C[7] = CANDK(0, 14, 0, 15);
        C[8] = CANDK(1, 0, 1, 1);
        C[9] = CANDK(1, 2, 1, 3);
        C[10] = CANDK(1, 4, 1, 5);
        C[11] = CANDK(1, 6, 1, 7);
        C[12] = CANDK(2, 0, 2, 1);
        C[13] = CANDK(2, 2, 2, 3);
        C[14] = CANDK(2, 4, 3, 0);
        C[15] = CANDK(3, 1, 3, 2);
        D[0] = CANDK(3, 3, 4, 0);
        D[1] = CANDK(4, 1, 4, 2);
        D[2] = CANDK(5, 0, 5, 1);
        D[3] = CANDK(6, 0, 6, 1);
        D[4] = CANDK(7, 0, 7, 1);
        D[5] = CANDK(8, 0, 9, 0);
        D[6] = CANDK(10, 0, 11, 0);
        D[7] = CANDK(12, 0, 13, 0);
        D[8] = CANDK(14, 0, 15, 0);
#undef CANDK
        bitonic_sort_desc<16>(C); bitonic_sort_desc<16>(D);
        top16_merge(C, D);
        {
            unsigned O[16];
#pragma unroll
            for (int i = 0; i < 16; ++i) O[i] = sxu<32>(C[i], half);
            top16_merge(C, O);
        }
        float bs[16]; int bi[16];
#pragma unroll
        for (int i = 0; i < 16; ++i) {
            const int id = 255 - (int)(C[i] & 255u), a = id >> 4, b = id & 15;
            bi[i] = tabL[a * 32 + r] * 128 + tabL[(16 + b) * 32 + r];
            bs[i] = __int_as_float(tabL[(32 + a) * 32 + r]) + __int_as_float(tabL[(48 + b) * 32 + r]);
        }
        float den = 0.f, ex[16];
#pragma unroll
        for (int i = 0; i < 16; ++i) { ex[i] = __expf(bs[i] - bs[0]); den += ex[i]; }
        const float rden = 1.f / den;
        int rl = r; asm volatile("" : "+v"(rl));
        const int tok = tb * 128 + 32 * wave + rl;
        int* io = (int*)(p.ws + WS_IDX) + (size_t)tok * 128 + h * 16 + 8 * half;
        float* go = (float*)(p.ws + WS_GATE) + (size_t)tok * 128 + h * 16 + 8 * half;
        if (half == 0) {
            *(u32x4*)(io) = u32x4{(unsigned)bi[0], (unsigned)bi[1], (unsigned)bi[2], (unsigned)bi[3]};
            *(u32x4*)(io + 4) = u32x4{(unsigned)bi[4], (unsigned)bi[5], (unsigned)bi[6], (unsigned)bi[7]};
            *(f32x4*)(go) = f32x4{ex[0] * rden, ex[1] * rden, ex[2] * rden, ex[3] * rden};
            *(f32x4*)(go + 4) = f32x4{ex[4] * rden, ex[5] * rden, ex[6] * rden, ex[7] * rden};
        } else {
            *(u32x4*)(io) = u32x4{(unsigned)bi[8], (unsigned)bi[9], (unsigned)bi[10], (unsigned)bi[11]};
            *(u32x4*)(io + 4) = u32x4{(unsigned)bi[12], (unsigned)bi[13], (unsigned)bi[14], (unsigned)bi[15]};
            *(f32x4*)(go) = f32x4{ex[8] * rden, ex[9] * rden, ex[10] * rden, ex[11] * rden};
            *(f32x4*)(go + 4) = f32x4{ex[12] * rden, ex[13] * rden, ex[14] * rden, ex[15] * rden};
        }
    }
}

typedef __attribute__((ext_vector_type(2))) float f32x2;
DI float gelu_exact(float a) { return 0.5f * a * (1.f + erff(a * 0.7071067811865476f)); }
DI void unpack8_fp4(unsigned w, float (&f)[8]) {
    const f32x2 a = __builtin_amdgcn_cvt_scalef32_pk_f32_fp4(w, 1.0f, 0), b = __builtin_amdgcn_cvt_scalef32_pk_f32_fp4(w, 1.0f, 1);
    const f32x2 c = __builtin_amdgcn_cvt_scalef32_pk_f32_fp4(w, 1.0f, 2), d = __builtin_amdgcn_cvt_scalef32_pk_f32_fp4(w, 1.0f, 3);
    f[0] = a.x; f[1] = a.y; f[2] = b.x; f[3] = b.y; f[4] = c.x; f[5] = c.y; f[6] = d.x; f[7] = d.y;
}
constexpr float PG_SX = 21.6f;
constexpr int PG_RING_SLOTS = 16, PG_DEPTH = 14;
constexpr int PG_LDS_BYTES = 4 * PG_RING_SLOTS * 1024 + 4096;
DI void pg_dma(const unsigned char* tab, unsigned e, unsigned lane_off, char* slot) {
    __builtin_amdgcn_global_load_lds((const unsigned*)(tab + (e * 512u + lane_off)), (unsigned*)slot, 16, 0, 0);
}
DI void pg_dma4(const unsigned char* tab, const u32x4 e4, unsigned lane_off, char* ring, int g) {
    pg_dma(tab, e4.x, lane_off, ring + ((4 * g + 0) & 15) * 1024); pg_dma(tab, e4.y, lane_off, ring + ((4 * g + 1) & 15) * 1024);
    pg_dma(tab, e4.z, lane_off, ring + ((4 * g + 2) & 15) * 1024); pg_dma(tab, e4.w, lane_off, ring + ((4 * g + 3) & 15) * 1024);
}
#define PG_WAIT_GROUP(g) do { if ((g) + 3 < 16) asm volatile("s_waitcnt vmcnt(12)" ::: "memory"); else if ((g) == 13) asm volatile("s_waitcnt vmcnt(8)" ::: "memory"); \
                              else if ((g) == 14) asm volatile("s_waitcnt vmcnt(4)" ::: "memory"); else asm volatile("s_waitcnt vmcnt(0)" ::: "memory"); } while (0)
DI void peer_u_phase(const Params& p, int layer, char* smem, int bid, int nb) {
    const int tid = opaque_tid(p), wave = __builtin_amdgcn_readfirstlane(tid >> 6), lane = tid & 63, hh = lane >> 5, li = lane & 31;
    char* ring = smem + wave * (PG_RING_SLOTS * 1024);
    int* idxL = (int*)(smem + 4 * PG_RING_SLOTS * 1024 + wave * 1024); float* cL = (float*)(idxL + 128);
    const unsigned char* tu = (const unsigned char*)(p.ws + WS_TAB) + (size_t)layer * 16 * MB;
    const u16* hn = (const u16*)(p.ws + WS_HN);
    const char* myslot = ring + lane * 16;
    const unsigned lane_off = (unsigned)li * 16u;
    const int* idxH = idxL + hh * 64;
    for (int t = bid * 4 + wave; t < T_TOK; t += nb * 4) {
        const int* ig = (const int*)(p.ws + WS_IDX) + (size_t)t * 128;
        idxL[(lane & 1) * 64 + (lane >> 1)] = ig[lane]; idxL[(lane & 1) * 64 + 32 + (lane >> 1)] = ig[lane + 64];
        unsigned xh[4], xl[4];
        {
            const u16* xr = hn + (size_t)t * 1024 + 32 * li;
            const u32x4 xa = *(const u32x4*)(xr), xb = *(const u32x4*)(xr + 8), xc = *(const u32x4*)(xr + 16), xd = *(const u32x4*)(xr + 24);
            const unsigned xw[16] = {xa.x, xa.y, xa.z, xa.w, xb.x, xb.y, xb.z, xb.w, xc.x, xc.y, xc.z, xc.w, xd.x, xd.y, xd.z, xd.w};
#pragma unroll
            for (int d = 0; d < 4; ++d) {
                unsigned hw = 0, lw = 0;
#pragma unroll
                for (int j = 0; j < 8; ++j) {
                    const unsigned w = xw[4 * d + (j >> 1)];
                    const float xv = (j & 1) ? bfhi(w) : bflo(w);
                    const int q = (int)rintf(fminf(fmaxf(xv * PG_SX, -119.f), 119.f));
                    const int lo = ((q + 8) & 15) - 8, hi = (q - lo) >> 4;
                    hw |= ((unsigned)hi & 15u) << (4 * j); lw |= ((unsigned)lo & 15u) << (4 * j);
                }
                xh[d] = hw; xl[d] = lw;
            }
        }
        asm volatile("s_waitcnt vmcnt(0) lgkmcnt(0)" ::: "memory");
#pragma unroll
        for (int g = 0; g < 3; ++g) pg_dma4(tu, *(const u32x4*)(idxH + 4 * g), lane_off, ring, g);
#pragma unroll 1
        for (int bt = 0; bt < 4; ++bt) {
            float pr[16];
#pragma unroll
            for (int gg = 0; gg < 4; ++gg) {
                const int g = bt * 4 + gg;
                if (g + 3 < 16) pg_dma4(tu, *(const u32x4*)(idxH + 4 * (g + 3)), lane_off, ring, g + 3);
                PG_WAIT_GROUP(g);
                u32x4 w[4];
#pragma unroll
                for (int i = 0; i < 4; ++i) w[i] = *(const u32x4*)(myslot + ((4 * gg + i) & 15) * 1024);
#pragma unroll
                for (int i = 0; i < 4; ++i) {
                    const unsigned ww[4] = {w[i].x, w[i].y, w[i].z, w[i].w};
                    int ah = 0, al = 0;
#pragma unroll
                    for (int c = 0; c < 4; ++c) { ah = __builtin_amdgcn_sdot8((int)ww[c], (int)xh[c], ah, false); al = __builtin_amdgcn_sdot8((int)ww[c], (int)xl[c], al, false); }
                    pr[4 * gg + i] = (float)(16 * ah + al);
                }
            }
            float q8[8], q4[4], q2[2], q1;
            { const bool up = (lane & 1) != 0;
#pragma unroll
              for (int i = 0; i < 8; ++i) { const float send = up ? pr[i] : pr[i + 8]; const float keep = up ? pr[i + 8] : pr[i]; q8[i] = keep + sxf<1>(send, hh); } }
            { const bool up = (lane & 2) != 0;
#pragma unroll
              for (int i = 0; i < 4; ++i) { const float send = up ? q8[i] : q8[i + 4]; const float keep = up ? q8[i + 4] : q8[i]; q4[i] = keep + sxf<2>(send, hh); } }
            { const bool up = (lane & 4) != 0;
#pragma unroll
              for (int i = 0; i < 2; ++i) { const float send = up ? q4[i] : q4[i + 2]; const float keep = up ? q4[i + 2] : q4[i]; q2[i] = keep + sxf<4>(send, hh); } }
            { const bool up = (lane & 8) != 0; const float send = up ? q2[0] : q2[1]; const float keep = up ? q2[1] : q2[0]; q1 = keep + sxf<8>(send, hh); }
            q1 += sxf<16>(q1, hh);
            const int jj = 8 * (lane & 1) + 4 * ((lane >> 1) & 1) + 2 * ((lane >> 2) & 1) + ((lane >> 3) & 1);
            if ((lane & 16) == 0) cL[2 * (bt * 16 + jj) + hh] = q1;
        }
        float* dg = (float*)(p.ws + WS_DOT) + (size_t)t * 128;
        dg[lane] = cL[lane]; dg[lane + 64] = cL[lane + 64];
    }
}
typedef __attribute__((ext_vector_type(2))) _Float16 h2_t;
DI void pg_axpy(h2_t (&o2)[16], const u32x4 w, float cfs) {
    const _Float16 ch = (_Float16)cfs; const h2_t cf2 = {ch, ch};
    const unsigned ww[4] = {w.x, w.y, w.z, w.w};
#pragma unroll
    for (int c = 0; c < 4; ++c) {
        o2[4 * c + 0] = __builtin_amdgcn_cvt_scalef32_pk_f16_fp4(ww[c], 1.0f, 0) * cf2 + o2[4 * c + 0];
        o2[4 * c + 1] = __builtin_amdgcn_cvt_scalef32_pk_f16_fp4(ww[c], 1.0f, 1) * cf2 + o2[4 * c + 1];
        o2[4 * c + 2] = __builtin_amdgcn_cvt_scalef32_pk_f16_fp4(ww[c], 1.0f, 2) * cf2 + o2[4 * c + 2];
        o2[4 * c + 3] = __builtin_amdgcn_cvt_scalef32_pk_f16_fp4(ww[c], 1.0f, 3) * cf2 + o2[4 * c + 3];
    }
}
template <bool FINAL>
DI void peer_v_phase(const Params& p, int layer, const float* gnext, char* smem, int bid, int nb) {
    const int tid = opaque_tid(p), wave = __builtin_amdgcn_readfirstlane(tid >> 6), lane = tid & 63, hh = lane >> 5, li = lane & 31;
    char* ring = smem + wave * (PG_RING_SLOTS * 1024);
    int* idxL = (int*)(smem + 4 * PG_RING_SLOTS * 1024 + wave * 1024); float* cL = (float*)(idxL + 128);
    const unsigned char* tv = (const unsigned char*)(p.ws + WS_TAB) + (size_t)layer * 16 * MB + (size_t)16384 * 512;
    const char* myslot = ring + lane * 16;
    const unsigned lane_off = (unsigned)li * 16u;
    const int* idxH = idxL + hh * 64; const float* cH = cL + hh * 64;
    for (int t = bid * 4 + wave; t < T_TOK; t += nb * 4) {
        const int* ig = (const int*)(p.ws + WS_IDX) + (size_t)t * 128;
        const float* gg = (const float*)(p.ws + WS_GATE) + (size_t)t * 128;
        const float* dg = (const float*)(p.ws + WS_DOT) + (size_t)t * 128;
        const int s0 = (lane & 1) * 64 + (lane >> 1), s1 = s0 + 32;
        idxL[s0] = ig[lane]; idxL[s1] = ig[lane + 64];
        {
            const float d0 = dg[lane] * (1.f / (TAB_SCALE_UI * PG_SX)), d1 = dg[lane + 64] * (1.f / (TAB_SCALE_UI * PG_SX));
            cL[s0] = gg[lane] * gelu_exact(d0) * (1.f / TAB_SCALE_V); cL[s1] = gg[lane + 64] * gelu_exact(d1) * (1.f / TAB_SCALE_V);
        }
        asm volatile("s_waitcnt vmcnt(0) lgkmcnt(0)" ::: "memory");
#pragma unroll
        for (int g = 0; g < 3; ++g) pg_dma4(tv, *(const u32x4*)(idxH + 4 * g), lane_off, ring, g);
        h2_t o2[16];
#pragma unroll
        for (int i = 0; i < 16; ++i) o2[i] = h2_t{(_Float16)0.f, (_Float16)0.f};
#pragma unroll 1
        for (int bt = 0; bt < 4; ++bt) {
#pragma unroll
            for (int gg = 0; gg < 4; ++gg) {
                const int g = bt * 4 + gg;
                if (g + 3 < 16) pg_dma4(tv, *(const u32x4*)(idxH + 4 * (g + 3)), lane_off, ring, g + 3);
                const f32x4 c4 = *(const f32x4*)(cH + 4 * g);
                PG_WAIT_GROUP(g);
                u32x4 w[4];
#pragma unroll
                for (int i = 0; i < 4; ++i) w[i] = *(const u32x4*)(myslot + ((4 * gg + i) & 15) * 1024);
                pg_axpy(o2, w[0], c4.x); pg_axpy(o2, w[1], c4.y); pg_axpy(o2, w[2], c4.z); pg_axpy(o2, w[3], c4.w);
            }
        }
        float r[16];
#pragma unroll
        for (int i = 0; i < 8; ++i) {
            const h2_t send = hh ? o2[i] : o2[i + 8]; const h2_t keep = hh ? o2[i + 8] : o2[i];
            const h2_t got = __builtin_bit_cast(h2_t, sxu<32>(__builtin_bit_cast(unsigned, send), hh));
            r[2 * i] = (float)keep.x + (float)got.x; r[2 * i + 1] = (float)keep.y + (float)got.y;
        }
        float* hr = p.out + (size_t)t * 1024 + 32 * li + 16 * hh;
        f32x4 h0 = *(f32x4*)(hr), h1 = *(f32x4*)(hr + 4), h2 = *(f32x4*)(hr + 8), h3 = *(f32x4*)(hr + 12);
        h0 += f32x4{r[0], r[1], r[2], r[3]}; h1 += f32x4{r[4], r[5], r[6], r[7]};
        h2 += f32x4{r[8], r[9], r[10], r[11]}; h3 += f32x4{r[12], r[13], r[14], r[15]};
        float ss = h0.x * h0.x + h0.y * h0.y + h0.z * h0.z + h0.w * h0.w + h1.x * h1.x + h1.y * h1.y + h1.z * h1.z + h1.w * h1.w
                 + h2.x * h2.x + h2.y * h2.y + h2.z * h2.z + h2.w * h2.w + h3.x * h3.x + h3.y * h3.y + h3.z * h3.z + h3.w * h3.w;
        ss = wave_sum(ss, hh);
        const float rn = rsqrtf(ss * (1.f / 1024.f) + 1e-6f);
        const float* gp = gnext + 32 * li + 16 * hh;
        const f32x4 g0v = *(const f32x4*)(gp), g1v = *(const f32x4*)(gp + 4), g2v = *(const f32x4*)(gp + 8), g3v = *(const f32x4*)(gp + 12);
        if constexpr (FINAL) {
            *(f32x4*)(hr) = h0 * rn * g0v; *(f32x4*)(hr + 4) = h1 * rn * g1v; *(f32x4*)(hr + 8) = h2 * rn * g2v; *(f32x4*)(hr + 12) = h3 * rn * g3v;
        } else {
            *(f32x4*)(hr) = h0; *(f32x4*)(hr + 4) = h1; *(f32x4*)(hr + 8) = h2; *(f32x4*)(hr + 12) = h3;
            const f32x4 n0 = h0 * rn * g0v, n1 = h1 * rn * g1v, n2 = h2 * rn * g2v, n3 = h3 * rn * g3v;
            u16* hno = (u16*)(p.ws + WS_HN) + (size_t)t * 1024 + 32 * li + 16 * hh;
            *(u32x4*)(hno) = u32x4{pk2(n0.x, n0.y), pk2(n0.z, n0.w), pk2(n1.x, n1.y), pk2(n1.z, n1.w)};
            *(u32x4*)(hno + 8) = u32x4{pk2(n2.x, n2.y), pk2(n2.z, n2.w), pk2(n3.x, n3.y), pk2(n3.z, n3.w)};
        }
    }
}
constexpr int AT_LDS_BYTES = 65536;
constexpr float LAMBDA_INIT = 0.35550906759096927f;
constexpr float AT_THR = 8.f;


DI float max16(const f32x16& S) {
    float t0, t1, t2, t3, t4;
    asm volatile("s_nop 15\n\tv_max3_f32 %0, %5, %6, %7\n\tv_max3_f32 %1, %8, %9, %10\n\tv_max3_f32 %2, %11, %12, %13\n\tv_max3_f32 %3, %14, %15, %16\n\t"
                 "v_max3_f32 %4, %17, %18, %19\n\tv_max3_f32 %0, %0, %1, %20\n\tv_max3_f32 %2, %2, %3, %4\n\tv_max_f32 %0, %0, %2"
                 : "=&v"(t0), "=&v"(t1), "=&v"(t2), "=&v"(t3), "=&v"(t4)
                 : "v"(S[0]), "v"(S[1]), "v"(S[2]), "v"(S[3]), "v"(S[4]), "v"(S[5]), "v"(S[6]), "v"(S[7]), "v"(S[8]), "v"(S[9]), "v"(S[10]), "v"(S[11]),
                   "v"(S[12]), "v"(S[13]), "v"(S[14]), "v"(S[15]));
    return t0;
}
DI void attn_tile(const char* Kb, const char* Vb, const char* Qw, f32x16 (&O1)[4], f32x16 (&O2)[4], float& m1, float& l1, float& m2, float& l2,
                  bool diag, bool first, int k0, int qidx, int r, int half) {
    const int ksw = (r >> 1) & 7;
    const char* krow = Kb + r * 128;
    f32x16 S0, S1;
#pragma unroll
    for (int i = 0; i < 16; ++i) { S0[i] = -m1; S1[i] = -m2; }
    __builtin_amdgcn_s_setprio(1);
    {
        bf16x8 kf[4], qf[4];
#pragma unroll
        for (int ks = 0; ks < 4; ++ks) { kf[ks] = lds_frag(krow + (((2 * ks + half) ^ ksw) << 4)); qf[ks] = lds_frag(Qw + ks * 1024); }
#pragma unroll
        for (int ks = 0; ks < 4; ++ks) S0 = MFMA32(kf[ks], qf[ks], S0);
    }
    {
        bf16x8 kf[4], qf[4];
#pragma unroll
        for (int ks = 0; ks < 4; ++ks) { kf[ks] = lds_frag(krow + 4096 + (((2 * ks + half) ^ ksw) << 4)); qf[ks] = lds_frag(Qw + (4 + ks) * 1024); }
#pragma unroll
        for (int ks = 0; ks < 4; ++ks) S1 = MFMA32(kf[ks], qf[ks], S1);
    }
    __builtin_amdgcn_s_setprio(0);
    const int vsw = (r >> 2) & 3;
    const char* vrow = Vb + r * 64;
    const int vo0 = ((0 + half) ^ vsw) << 4, vo1 = ((2 + half) ^ vsw) << 4;
    __builtin_amdgcn_sched_barrier(0);
    if (diag) {
#pragma unroll
        for (int i = 0; i < 16; ++i) if (k0 + crow(i, half) > qidx) { S0[i] = -INFINITY; S1[i] = -INFINITY; }
    }
    float mx0 = max16(S0), mx1 = max16(S1);
    mx0 = fmaxf(mx0, sxf<32>(mx0, half)); mx1 = fmaxf(mx1, sxf<32>(mx1, half));
    if (first || !__all((mx0 <= AT_THR) && (mx1 <= AT_THR))) {
        const float d1 = fmaxf(mx0, 0.f), d2 = fmaxf(mx1, 0.f);
        const float e1 = first ? mx0 : d1, e2 = first ? mx1 : d2;
#pragma unroll
        for (int i = 0; i < 16; ++i) { S0[i] -= e1; S1[i] -= e2; }
        if (!first) {
            const float a1 = __builtin_amdgcn_exp2f(-d1), a2 = __builtin_amdgcn_exp2f(-d2);
#pragma unroll
            for (int d = 0; d < 4; ++d) { O1[d] *= a1; O2[d] *= a2; }
            l1 *= a1; l2 *= a2;
        }
        m1 += e1; m2 += e2;
    }
    __builtin_amdgcn_sched_barrier(0);
    bf16x8 vf[8];
#pragma unroll
    for (int d = 0; d < 4; ++d) { vf[2 * d] = lds_frag(vrow + d * 2048 + vo0); vf[2 * d + 1] = lds_frag(vrow + d * 2048 + vo1); }
    float ps0 = 0.f;
#pragma unroll
    for (int i = 0; i < 16; ++i) { const float pv = __builtin_amdgcn_exp2f(S0[i]); S0[i] = pv; ps0 += pv; }
    l1 += ps0;
    const bf16x8 P00 = pack8(S0, 0), P01 = pack8(S0, 1);
    __builtin_amdgcn_sched_barrier(0);
    __builtin_amdgcn_s_setprio(1);
#pragma unroll
    for (int d = 0; d < 4; ++d) { O1[d] = MFMA32(vf[2 * d], P00, O1[d]); O1[d] = MFMA32(vf[2 * d + 1], P01, O1[d]); }
    float ps1 = 0.f;
#pragma unroll
    for (int i = 0; i < 16; ++i) { const float pv = __builtin_amdgcn_exp2f(S1[i]); S1[i] = pv; ps1 += pv; }
    l2 += ps1;
    const bf16x8 P10 = pack8(S1, 0), P11 = pack8(S1, 1);
#pragma unroll
    for (int g = 0; g < 8; ++g) { __builtin_amdgcn_sched_group_barrier(0x8, 1, 0); __builtin_amdgcn_sched_group_barrier(0x2, 8, 0); }
    __builtin_amdgcn_sched_barrier(0);
#pragma unroll
    for (int d = 0; d < 4; ++d) { O2[d] = MFMA32(vf[2 * d], P10, O2[d]); O2[d] = MFMA32(vf[2 * d + 1], P11, O2[d]); }
    __builtin_amdgcn_s_setprio(0);
    __builtin_amdgcn_sched_barrier(0);
}

DI void attn_phase(const Params& p, char* smem, int bid, int nb) {
    const int tid = opaque_tid(p), wave = __builtin_amdgcn_readfirstlane(tid >> 6), lane = tid & 63, r = lane & 31, half = lane >> 5;
    char* Qs = smem; char* Kbuf = smem + 32768; char* Vbuf = smem + 49152;
    const u16* qk = (const u16*)(p.ws + WS_PROJ);
    const u16* vt = (const u16*)(p.ws + WS_VT);
    const float lam = __uint_as_float(__builtin_amdgcn_readfirstlane(__float_as_uint(
        __expf(wave_sum(p.lq1[lane] * p.lk1[lane], half)) - __expf(wave_sum(p.lq2[lane] * p.lk2[lane], half)) + LAMBDA_INIT)));
    const unsigned q_off = (unsigned)(lane & 31) * 4096u + (unsigned)(lane >> 5) * 16u;
    const unsigned kx = (unsigned)((lane & 7) ^ (lane >> 4));
    const unsigned k_off0 = (unsigned)(lane >> 3) * 4096u + (kx << 4), k_off1 = (unsigned)(lane >> 3) * 4096u + ((kx ^ 4u) << 4);
    const unsigned v_off = (unsigned)(lane >> 2) * (unsigned)(SEQ * 2) + (unsigned)(((lane & 3) ^ ((lane >> 4) & 3)) << 4);
    const int nrounds = (2048 + nb - 1) / nb;
    for (int j = 0; j < nrounds; ++j) {
        const int rank = j * nb + ((j & 1) ? (nb - 1 - bid) : bid);
        if (rank >= 2048) continue;
        const int qb = 127 - (rank >> 4), bh = rank & 15, b = bh >> 3, h = bh & 7;
        const int q0 = qb * 128, tokbase = b * SEQ, qlo = q0 + 32 * wave, qidx = qlo + r;
        const u16* kbase = qk + (size_t)tokbase * 2048 + 1024 + h * 128;
        const u16* vbase = vt + (size_t)(b * 8 + h) * 128 * SEQ;
        const int nkt = 4 * (qb + 1);
        __syncthreads();
        {
            const char* qsrc = (const char*)(qk + (size_t)(tokbase + q0 + wave * 32) * 2048 + h * 128);
#pragma unroll
            for (int i = 0; i < 8; ++i) dma16(qsrc + i * 32, q_off, Qs + (wave * 8 + i) * 1024);
        }
        const char* ksrc = (const char*)(kbase + (size_t)(16 * (wave & 1)) * 2048 + (wave >> 1) * 64);
        const char* vsrc = (const char*)(vbase + (size_t)(wave * 32) * SEQ);
        dma16(ksrc, k_off0, Kbuf + (wave * 2) * 1024);
        dma16(ksrc + 8 * 4096, k_off1, Kbuf + (wave * 2 + 1) * 1024);
        dma16(vsrc, v_off, Vbuf + (wave * 2) * 1024);
        dma16(vsrc + 16 * SEQ * 2, v_off, Vbuf + (wave * 2 + 1) * 1024);
        f32x16 O1[4], O2[4];
#pragma unroll
        for (int d = 0; d < 4; ++d) { O1[d] = zero16(); O2[d] = zero16(); }
        float m1 = 0.f, m2 = 0.f, l1 = 0.f, l2 = 0.f;
        const char* Qw = Qs + wave * 8192 + lane * 16;
        for (int kt = 0; kt < nkt; ++kt) {
            const int k0 = kt * 32, buf = kt & 1;
            asm volatile("s_waitcnt vmcnt(0)" ::: "memory");
            __syncthreads();
            if (kt + 1 < nkt) {
                const char* kn = ksrc + (size_t)(k0 + 32) * 4096; const char* vn = vsrc + (k0 + 32) * 2;
                char* kd = Kbuf + (buf ^ 1) * 8192 + (wave * 2) * 1024; char* vd = Vbuf + (buf ^ 1) * 8192 + (wave * 2) * 1024;
                dma16(kn, k_off0, kd);
                dma16(kn + 8 * 4096, k_off1, kd + 1024);
                dma16(vn, v_off, vd);
                dma16(vn + 16 * SEQ * 2, v_off, vd + 1024);
            }
            if (k0 <= qlo + 31) {
                const bool diag = (k0 + 31 > qlo);
                const char* Kb = Kbuf + buf * 8192; const char* Vb = Vbuf + buf * 8192;
                attn_tile(Kb, Vb, Qw, O1, O2, m1, l1, m2, l2, diag, kt == 0, k0, qidx, r, half);
            }
        }
        l1 += sxf<32>(l1, half); l2 += sxf<32>(l2, half);
        const float i1 = __builtin_amdgcn_rcpf(l1), i2 = lam * __builtin_amdgcn_rcpf(l2);
        float ss = 0.f;
#pragma unroll
        for (int d = 0; d < 4; ++d)
#pragma unroll
            for (int i = 0; i < 16; ++i) { const float v = O1[d][i] * i1 - O2[d][i] * i2; O1[d][i] = v; ss += v * v; }
        ss += sxf<32>(ss, half);
        const float rn = rsqrtf(ss * (1.f / 128.f) + 1e-6f) * (1.f - LAMBDA_INIT);
        u16* orow = (u16*)(p.ws + WS_HN) + (size_t)(tokbase + qidx) * 1024 + h * 128;
        const float* gn = p.diff_norm + h * 128;
        int half_e = half; asm volatile("" : "+v"(half_e));
        f32x4 gv[16];
#pragma unroll
        for (int i = 0; i < 16; ++i) gv[i] = *(const f32x4*)(gn + 32 * (i >> 2) + 8 * (i & 3) + 4 * half_e);
#pragma unroll
        for (int d = 0; d < 4; ++d)
#pragma unroll
            for (int g = 0; g < 4; ++g) {
                const int c0 = 32 * d + 8 * g + 4 * half_e;
                const f32x4 gq = gv[4 * d + g];
                *(u32x2*)(orow + c0) = u32x2{pk2(O1[d][4 * g] * rn * gq.x, O1[d][4 * g + 1] * rn * gq.y), pk2(O1[d][4 * g + 2] * rn * gq.z, O1[d][4 * g + 3] * rn * gq.w)};
            }
    }
}
extern __shared__ __attribute__((aligned(16))) char dyn_smem[];
constexpr int MEGA_LDS_WORK = G_LDS_BYTES;
constexpr int MEGA_LDS_BYTES = MEGA_LDS_WORK + 16;

__global__ void __launch_bounds__(256, 2) mega_fwd(Params pk) {
    Params p = pk; p.wv = __builtin_amdgcn_readfirstlane((int)(threadIdx.x >> 6));
    volatile LAS unsigned* st = (volatile LAS unsigned*)(dyn_smem + MEGA_LDS_WORK);
    if (threadIdx.x == 0) { st[0] = 0u; st[1] = 0u; st[2] = 0u; st[3] = 0u; }
    __syncthreads();
    XcdBarrier bar = xcd_barrier_post((unsigned*)(p.ws + WS_BAR), st, threadIdx.x == 0);
#define XBAR() xcd_barrier(bar, opaque_tid(p) == 0)
    const int bid = blockIdx.x, nb = gridDim.x;
    const u16* hn = (const u16*)(p.ws + WS_HN);
    phase_prep_a(p, bid, nb);
    asm volatile("; PHASE_END 1");
    XBAR();
    gemm_phase<EPI_GLA_IN>(p, hn, (const u16*)(p.ws + WS_WGIN), GLA_NPAD, nullptr, dyn_smem, bid, nb);
    asm volatile("; PHASE_END 2");
    XBAR();
    gla_pass1(p, dyn_smem, bid, nb);
    asm volatile("; PHASE_END 3");
    XBAR();
    if (nb >= 256) { if (bid < 128) gla_scan(p, bid, 128); else { phase_prep_b(p, bid - 128, nb - 128); phase_tabconv(p, 0, bid - 128, nb - 128); phase_tabconv(p, 1, bid - 128, nb - 128); } }
    else { gla_scan(p, bid, nb); phase_prep_b(p, bid, nb); phase_tabconv(p, 0, bid, nb); phase_tabconv(p, 1, bid, nb); }
    asm volatile("; PHASE_END 4");
    XBAR();
    gla_pass3(p, dyn_smem, bid, nb);
    asm volatile("; PHASE_END 5");
    XBAR();
    gemm_phase<EPI_RESID>(p, hn, (const u16*)(p.ws + WS_WGOUT), 1024, p.x, dyn_smem, bid, nb);
    asm volatile("; PHASE_END 6");
    XBAR();
    phase_rmsnorm(p, p.norm_ffn, bid, nb);
    asm volatile("; PHASE_END 7");
    XBAR();
    peer_query_phase(p, 0, dyn_smem, bid, nb);
    asm volatile("; PHASE_END 8");
    XBAR();
    peer_u_phase(p, 0, dyn_smem, bid, nb);
    XBAR();
    peer_v_phase<false>(p, 0, p.norm_mix + 1024, dyn_smem, bid, nb);
    asm volatile("; PHASE_END 9");
    XBAR();
    gemm_phase<EPI_DIFF_IN>(p, hn, (const u16*)(p.ws + WS_WDIN), 3072, nullptr, dyn_smem, bid, nb);
    asm volatile("; PHASE_END 10");
    XBAR();
    attn_phase(p, dyn_smem, bid, nb);
    asm volatile("; PHASE_END 11");
    XBAR();
    gemm_phase<EPI_RESID>(p, hn, (const u16*)(p.ws + WS_WDOUT), 1024, p.out, dyn_smem, bid, nb);
    asm volatile("; PHASE_END 12");
    XBAR();
    phase_rmsnorm(p, p.norm_ffn + 1024, bid, nb);
    asm volatile("; PHASE_END 13");
    XBAR();
    peer_query_phase(p, 1, dyn_smem, bid, nb);
    asm volatile("; PHASE_END 14");
    XBAR();
    peer_u_phase(p, 1, dyn_smem, bid, nb);
    XBAR();
    peer_v_phase<true>(p, 1, p.norm_final, dyn_smem, bid, nb);
}

extern "C" void kernel_launch(void* const* d_in, const int* in_sizes, int n_in, void* d_out, int out_size, void* d_ws, size_t ws_size, hipStream_t stream) {
    Params p{};
    p.x = (const float*)d_in[0]; p.pos = (const int*)d_in[1]; p.norm_mix = (const float*)d_in[2]; p.norm_ffn = (const float*)d_in[3]; p.norm_final = (const float*)d_in[4];
    p.gla_w_in = (const float*)d_in[5]; p.gla_wgu = (const float*)d_in[6]; p.gla_bg = (const float*)d_in[7]; p.gla_norm = (const float*)d_in[8]; p.gla_w_out = (const float*)d_in[9];
    p.diff_w_in = (const float*)d_in[10]; p.lq1 = (const float*)d_in[11]; p.lk1 = (const float*)d_in[12]; p.lq2 = (const float*)d_in[13]; p.lk2 = (const float*)d_in[14];
    p.diff_norm = (const float*)d_in[15]; p.diff_w_out = (const float*)d_in[16];
    p.peer_wq = (const float*)d_in[17]; p.peer_sk = (const float*)d_in[18]; p.peer_u = (const float*)d_in[19]; p.peer_v = (const float*)d_in[20];
    p.out = (float*)d_out; p.ws = (char*)d_ws;
    static int grid = 0;
    if (grid == 0) {
        int dev = 0, cus = 0, per_cu = 0;
        hipGetDevice(&dev);
        hipDeviceGetAttribute(&cus, hipDeviceAttributeMultiprocessorCount, dev);
        hipFuncSetAttribute((const void*)mega_fwd, hipFuncAttributeMaxDynamicSharedMemorySize, MEGA_LDS_BYTES);
        hipOccupancyMaxActiveBlocksPerMultiprocessor(&per_cu, (const void*)mega_fwd, 256, MEGA_LDS_BYTES);
        (void)hipGetLastError();
        if (per_cu < 1) per_cu = 1;
        if (cus < 1) cus = 256;
        grid = cus * (per_cu < 2 ? per_cu : 2);
    }
    hipMemsetAsync((char*)d_ws + WS_BAR, 0, XCD_BAR_WORDS * sizeof(unsigned), stream);
    mega_fwd<<<grid, 256, MEGA_LDS_BYTES, stream>>>(p);
}
```

```cpp
#include <hip/hip_runtime.h>
#include <stdint.h>

#define DI __device__ __forceinline__
typedef unsigned short u16;
typedef __attribute__((ext_vector_type(8))) short bf16x8;
typedef __attribute__((ext_vector_type(16))) float f32x16;
typedef __attribute__((ext_vector_type(2))) __bf16 bf2_t;
typedef __attribute__((ext_vector_type(4))) unsigned u32x4;
typedef __attribute__((ext_vector_type(2))) unsigned u32x2;
typedef __attribute__((ext_vector_type(4))) float f32x4;
#define MFMA32(a, b, c) __builtin_amdgcn_mfma_f32_32x32x16_bf16((a), (b), (c), 0, 0, 0)

constexpr int T_TOK = 32768, SEQ = 16384, DM = 1024;
constexpr int GLA_NPAD = 3328;
constexpr int NTHR = 256;

constexpr size_t MB = 1024ull * 1024ull;
constexpr size_t WS_BAR    = 0;
constexpr size_t WS_ROPE   = 64 * 1024;
constexpr size_t WS_WGIN   = WS_ROPE + 2 * MB;
constexpr size_t WS_WGOUT  = WS_WGIN + (size_t)GLA_NPAD * 1024 * 2;
constexpr size_t WS_WDIN   = WS_WGOUT + 2 * MB;
constexpr size_t WS_WDOUT  = WS_WDIN + 6 * MB;
constexpr size_t WS_WPQ    = WS_WDOUT + 2 * MB;
constexpr size_t WS_SK     = WS_WPQ + 8 * MB;
constexpr size_t WS_GLR    = WS_SK + 1 * MB;
constexpr size_t WS_DEC    = WS_GLR + 2 * MB;
constexpr size_t WS_TAB    = WS_DEC + 1 * MB;
constexpr size_t WS_HN     = WS_TAB + 64 * MB;
constexpr size_t WS_PROJ   = WS_HN + 64 * MB;
constexpr size_t WS_KV     = WS_PROJ + 192 * MB;
constexpr size_t WS_END    = WS_KV + 128 * MB;
static_assert(WS_END <= 512 * MB, "workspace overflow");
constexpr size_t WS_VT     = WS_PROJ + 128 * MB;
constexpr size_t WS_IDX    = WS_KV;
constexpr size_t WS_GATE   = WS_KV + 16 * MB;
constexpr size_t WS_DOT    = WS_KV + 32 * MB;

struct Params {
    const float* x; const int* pos; const float* norm_mix; const float* norm_ffn; const float* norm_final;
    const float* gla_w_in; const float* gla_wgu; const float* gla_bg; const float* gla_norm; const float* gla_w_out;
    const float* diff_w_in; const float* lq1; const float* lk1; const float* lq2; const float* lk2;
    const float* diff_norm; const float* diff_w_out;
    const float* peer_wq; const float* peer_sk; const float* peer_u; const float* peer_v;
    float* out; char* ws;
    int wv; int pad_;
};

DI int opaque_tid(const Params& p) { int l; asm volatile("v_mbcnt_lo_u32_b32 %0, -1, 0\n\tv_mbcnt_hi_u32_b32 %0, -1, %0" : "=v"(l)); return (p.wv << 6) | l; }
DI unsigned pk2(float a, float b) { bf2_t v = {(__bf16)a, (__bf16)b}; return __builtin_bit_cast(unsigned, v); }
DI u16 f2bf(float a) { return (u16)(pk2(a, 0.f) & 0xffffu); }
DI float bflo(unsigned w) { return __uint_as_float(w << 16); }
DI float bfhi(unsigned w) { return __uint_as_float(w & 0xffff0000u); }
DI float bf2f(u16 h) { return __uint_as_float(((unsigned)h) << 16); }
DI int xcd_unit(int j, int bid, int nb) { return ((nb & 7) == 0) ? j * nb + (bid & 7) * (nb >> 3) + (bid >> 3) : j * nb + bid; }
DI int crow(int i, int half) { return (i & 3) + 8 * (i >> 2) + 4 * half; }
template <int MASK> DI unsigned sxu(unsigned v, int half) {
    if constexpr (MASK < 32) return (unsigned)__builtin_amdgcn_ds_swizzle((int)v, (MASK << 10) | 0x1f);
    else { auto r = __builtin_amdgcn_permlane32_swap(v, v, false, false); return half ? r[0] : r[1]; }
}
template <int MASK> DI float sxf(float v, int half) { return __uint_as_float(sxu<MASK>(__float_as_uint(v), half)); }
template <int MASK> DI int sxi(int v, int half) { return (int)sxu<MASK>((unsigned)v, half); }
DI float wave_sum(float v, int half) { v += sxf<32>(v, half); v += sxf<16>(v, half); v += sxf<8>(v, half); v += sxf<4>(v, half); v += sxf<2>(v, half); v += sxf<1>(v, half); return v; }
DI f32x16 zero16() { f32x16 z; for (int i = 0; i < 16; ++i) z[i] = 0.f; return z; }
DI bf16x8 lds_frag(const char* p) { return *(const bf16x8*)p; }
DI bf16x8 lds_frag2(const char* p0, const char* p1) {
    u32x2 a = *(const u32x2*)p0, b = *(const u32x2*)p1; u32x4 r = {a.x, a.y, b.x, b.y}; return __builtin_bit_cast(bf16x8, r);
}
DI bf16x8 pack8(const f32x16& x, int s) {
    u32x4 r = {pk2(x[8 * s], x[8 * s + 1]), pk2(x[8 * s + 2], x[8 * s + 3]), pk2(x[8 * s + 4], x[8 * s + 5]), pk2(x[8 * s + 6], x[8 * s + 7])};
    return __builtin_bit_cast(bf16x8, r);
}
#define XB_TMO      128
#define XB_XCNT(j)  (256  + 64 * (j))
#define XB_XSUB(j)  (1280 + 64 * (j))
#define XB_XGEN(j)  (2304 + 64 * (j))
#define XB_TOP      3328
#define XB_TOPGEN   3392
#define XCD_BAR_WORDS 3456
#define XB_SPIN_CAP (1u << 18)
#define LAS __attribute__((address_space(3)))

__device__ __forceinline__ unsigned xb_ld(unsigned* p)              { return __hip_atomic_load(p, __ATOMIC_RELAXED, __HIP_MEMORY_SCOPE_AGENT); }
__device__ __forceinline__ unsigned xb_add(unsigned* p, unsigned v) { return __hip_atomic_fetch_add(p, v, __ATOMIC_RELAXED, __HIP_MEMORY_SCOPE_AGENT); }
__device__ __forceinline__ unsigned xb_xcc_id() { return (unsigned)__builtin_amdgcn_s_getreg((3 << 11) | 20) & 0xFu; }
#define XB_SPIN(cond, bar) do { unsigned _sp = 0; while (cond) { __builtin_amdgcn_s_sleep(1); \
    if ((++_sp & 255u) == 0u) { if (xb_ld(&(bar)[XB_TMO])) break; if (_sp > XB_SPIN_CAP) { atomicAdd(&(bar)[XB_TMO], 1u); break; } } } } while (0)

struct XcdBarrier {
    unsigned* bar; unsigned x;
    volatile LAS unsigned* st;
};

__device__ __forceinline__ XcdBarrier xcd_barrier_post(unsigned* bar, volatile LAS unsigned* st, bool t0) {
    XcdBarrier b; b.bar = bar; b.x = xb_xcc_id(); b.st = st;
    if (t0) (void)xb_add(&bar[XB_XCNT(b.x)], 1u);
    return b;
}
__device__ __forceinline__ void xcd_barrier_complete(unsigned* bar, unsigned x, unsigned& nloc, unsigned& nx) {
    const unsigned G = gridDim.x * gridDim.y * gridDim.z;
    unsigned sum, cnt, mine, sp = 0u;
    for (;;) {
        sum = 0u; cnt = 0u; mine = 0u;
#pragma unroll
        for (unsigned j = 0; j < 16; ++j) { const unsigned c = xb_ld(&bar[XB_XCNT(j)]); sum += c; cnt += (c > 0u) ? 1u : 0u; mine = (j == x) ? c : mine; }
        if (sum == G) break;
        __builtin_amdgcn_s_sleep(1);
        if ((++sp & 255u) == 0u) { if (xb_ld(&bar[XB_TMO])) break; if (sp > XB_SPIN_CAP) { atomicAdd(&bar[XB_TMO], 1u); break; } }
    }
    nloc = mine > 0u ? mine : 1u; nx = cnt > 0u ? cnt : 1u;
}

__device__ __forceinline__ void xcd_barrier(const XcdBarrier& b, bool t0) {
    asm volatile("s_waitcnt vmcnt(0)" ::: "memory");
    __syncthreads();
    if (t0) {
        unsigned* bar = b.bar;
        __builtin_amdgcn_s_waitcnt(0);
        unsigned nloc = b.st[0], nx = b.st[1];
        if (nloc == 0u) { xcd_barrier_complete(bar, b.x, nloc, nx); b.st[0] = nloc; b.st[1] = nx; }
        const unsigned old = xb_add(&bar[XB_XSUB(b.x)], 1u);
        const unsigned gen = old / nloc;
        if (old + 1u == (gen + 1u) * nloc) {
            __builtin_amdgcn_fence(__ATOMIC_RELEASE, "agent");
            asm volatile("s_waitcnt vmcnt(0)" ::: "memory");
            const unsigned og = xb_add(&bar[XB_TOP], 1u);
            const unsigned tg = og / nx;
            if (og + 1u == (tg + 1u) * nx) xb_add(&bar[XB_TOPGEN], 1u);
            else XB_SPIN(xb_ld(&bar[XB_TOPGEN]) == tg, bar);
            __builtin_amdgcn_fence(__ATOMIC_ACQUIRE, "agent");
            xb_add(&bar[XB_XGEN(b.x)], 1u);
            asm volatile("s_waitcnt vmcnt(0)" ::: "memory");
        } else {
            XB_SPIN(xb_ld(&bar[XB_XGEN(b.x)]) == gen, bar);
            __builtin_amdgcn_fence(__ATOMIC_ACQUIRE, "agent");
            asm volatile("s_waitcnt vmcnt(0)" ::: "memory");
        }
    }
    __syncthreads();
}
DI void rmsnorm_row_bf16(const float* __restrict__ src, const float* __restrict__ g, u16* __restrict__ dst, int lane) {
    const f32x4* xr = (const f32x4*)src;
    f32x4 a0 = xr[lane * 2], a1 = xr[lane * 2 + 1], b0 = xr[128 + lane * 2], b1 = xr[128 + lane * 2 + 1];
    float ss = a0.x * a0.x + a0.y * a0.y + a0.z * a0.z + a0.w * a0.w + a1.x * a1.x + a1.y * a1.y + a1.z * a1.z + a1.w * a1.w
             + b0.x * b0.x + b0.y * b0.y + b0.z * b0.z + b0.w * b0.w + b1.x * b1.x + b1.y * b1.y + b1.z * b1.z + b1.w * b1.w;
    ss = wave_sum(ss, lane >> 5);
    const float r = rsqrtf(ss * (1.f / 1024.f) + 1e-6f);
    const f32x4* gr = (const f32x4*)g;
    f32x4 g0 = gr[lane * 2], g1 = gr[lane * 2 + 1], g2 = gr[128 + lane * 2], g3 = gr[128 + lane * 2 + 1];
    u32x4 o0 = u32x4{pk2(a0.x * r * g0.x, a0.y * r * g0.y), pk2(a0.z * r * g0.z, a0.w * r * g0.w), pk2(a1.x * r * g1.x, a1.y * r * g1.y), pk2(a1.z * r * g1.z, a1.w * r * g1.w)};
    u32x4 o1 = u32x4{pk2(b0.x * r * g2.x, b0.y * r * g2.y), pk2(b0.z * r * g2.z, b0.w * r * g2.w), pk2(b1.x * r * g3.x, b1.y * r * g3.y), pk2(b1.z * r * g3.z, b1.w * r * g3.w)};
    ((u32x4*)dst)[lane] = o0;
    ((u32x4*)dst)[64 + lane] = o1;
}

DI void tconv_item(const float* __restrict__ src, u16* __restrict__ dst, int K, int N, int item, int lane) {
    const int kgroups = K >> 3;
    const int ng = item / kgroups, kg = item - ng * kgroups;
    const int n = ng * 64 + lane, k0 = kg * 8;
    float v[8];
#pragma unroll
    for (int i = 0; i < 8; ++i) v[i] = (n < N) ? src[(size_t)(k0 + i) * N + n] : 0.f;
    u32x4 o = u32x4{pk2(v[0], v[1]), pk2(v[2], v[3]), pk2(v[4], v[5]), pk2(v[6], v[7])};
    *(u32x4*)(dst + (size_t)n * K + k0) = o;
}

DI void conv8(const float* __restrict__ src, u16* __restrict__ dst, size_t i8) {
    const f32x4* s = (const f32x4*)(src + i8 * 8);
    f32x4 a = s[0], b = s[1];
    *(u32x4*)(dst + i8 * 8) = u32x4{pk2(a.x, a.y), pk2(a.z, a.w), pk2(b.x, b.y), pk2(b.z, b.w)};
}

DI void phase_prep_a(const Params& p, int bid, int nb) {
    const int wave = opaque_tid(p) >> 6, lane = opaque_tid(p) & 63;
    const int gw = bid * 4 + wave, nw = nb * 4;
    char* ws = p.ws;
    for (int t = gw; t < T_TOK; t += nw) rmsnorm_row_bf16(p.x + (size_t)t * DM, p.norm_mix, (u16*)(ws + WS_HN) + (size_t)t * DM, lane);
    const int n0 = (GLA_NPAD / 64) * 128, n1 = n0 + 16 * 128;
    for (int it = gw; it < n1; it += nw) {
        if (it < n0) tconv_item(p.gla_w_in, (u16*)(ws + WS_WGIN), 1024, 3088, it, lane);
        else         tconv_item(p.gla_w_out, (u16*)(ws + WS_WGOUT), 1024, 1024, it - n0, lane);
    }
}
DI void phase_prep_b(const Params& p, int bid, int nb) {
    const int wave = opaque_tid(p) >> 6, lane = opaque_tid(p) & 63;
    const int gw = bid * 4 + wave, nw = nb * 4;
    char* ws = p.ws;
    {
        const int n2 = 48 * 128, n3 = n2 + 16 * 128, n4 = n3 + 32 * 128, n5 = n4 + 32 * 128;
        for (int it = gw; it < n5; it += nw) {
            if (it < n2)      tconv_item(p.diff_w_in, (u16*)(ws + WS_WDIN), 1024, 3072, it, lane);
            else if (it < n3) tconv_item(p.diff_w_out, (u16*)(ws + WS_WDOUT), 1024, 1024, it - n2, lane);
            else if (it < n4) tconv_item(p.peer_wq, (u16*)(ws + WS_WPQ), 1024, 2048, it - n3, lane);
            else              tconv_item(p.peer_wq + (size_t)1024 * 2048, (u16*)(ws + WS_WPQ) + (size_t)2048 * 1024, 1024, 2048, it - n4, lane);
        }
    }
    for (int i = gw * 64 + lane; i < 65536; i += nw * 64) conv8(p.peer_sk, (u16*)(ws + WS_SK), (size_t)i);
    for (int i = gw * 64 + lane; i < T_TOK * 8; i += nw * 64) {
        const int t = i >> 3, f = i & 7;
        const float inv = exp2f(-(float)f * (18.931568569324174f / 8.f));
        const float ang = (float)p.pos[t] * inv;
        float sn, cs; sincosf(ang, &sn, &cs);
        ((float2*)(ws + WS_ROPE))[i] = make_float2(cs, sn);
    }
}

constexpr float TAB_SCALE_U = 64.f, TAB_SCALE_V = 6.f;
DI float clamp6(float a) { return fminf(fmaxf(a, -6.f), 6.f); }
DI unsigned pk8_fp4(f32x4 a, f32x4 b, float s) {
    unsigned w = 0;
    w = __builtin_amdgcn_cvt_scalef32_pk_fp4_f32(w, clamp6(a.x * s), clamp6(a.y * s), 1.0f, 0);
    w = __builtin_amdgcn_cvt_scalef32_pk_fp4_f32(w, clamp6(a.z * s), clamp6(a.w * s), 1.0f, 1);
    w = __builtin_amdgcn_cvt_scalef32_pk_fp4_f32(w, clamp6(b.x * s), clamp6(b.y * s), 1.0f, 2);
    w = __builtin_amdgcn_cvt_scalef32_pk_fp4_f32(w, clamp6(b.z * s), clamp6(b.w * s), 1.0f, 3);
    return w;
}
constexpr float TAB_SCALE_UI = 90.f;
DI unsigned pk8_i4(f32x4 a, f32x4 b, float s) {
    const float f[8] = {a.x, a.y, a.z, a.w, b.x, b.y, b.z, b.w};
    unsigned w = 0;
#pragma unroll
    for (int j = 0; j < 8; ++j) { const int q = (int)rintf(fminf(fmaxf(f[j] * s, -7.f), 7.f)); w |= ((unsigned)q & 15u) << (4 * j); }
    return w;
}
DI void phase_tabconv(const Params& p, int layer, int bid, int nb) {
    const size_t n16 = (size_t)16384 * 1024 / 16;
    const float* su = p.peer_u + (size_t)layer * 16384 * 1024;
    const float* sv = p.peer_v + (size_t)layer * 16384 * 1024;
    unsigned char* du = (unsigned char*)(p.ws + WS_TAB) + (size_t)layer * 16 * MB; unsigned char* dv = du + (size_t)16384 * 512;
    for (size_t i = (size_t)bid * NTHR + opaque_tid(p); i < n16; i += (size_t)nb * NTHR) {
        const f32x4* a = (const f32x4*)(su + i * 16); const f32x4* b = (const f32x4*)(sv + i * 16);
        const f32x4 a0 = __builtin_nontemporal_load(a), a1 = __builtin_nontemporal_load(a + 1), a2 = __builtin_nontemporal_load(a + 2), a3 = __builtin_nontemporal_load(a + 3);
        const f32x4 b0 = __builtin_nontemporal_load(b), b1 = __builtin_nontemporal_load(b + 1), b2 = __builtin_nontemporal_load(b + 2), b3 = __builtin_nontemporal_load(b + 3);
        *(u32x2*)(du + i * 8) = u32x2{pk8_i4(a0, a1, TAB_SCALE_UI), pk8_i4(a2, a3, TAB_SCALE_UI)};
        *(u32x2*)(dv + i * 8) = u32x2{pk8_fp4(b0, b1, TAB_SCALE_V), pk8_fp4(b2, b3, TAB_SCALE_V)};
    }
}

DI void phase_rmsnorm(const Params& p, const float* g, int bid, int nb) {
    const int wave = opaque_tid(p) >> 6, lane = opaque_tid(p) & 63;
    for (int t = bid * 4 + wave; t < T_TOK; t += nb * 4) rmsnorm_row_bf16(p.out + (size_t)t * DM, g, (u16*)(p.ws + WS_HN) + (size_t)t * DM, lane);
}
constexpr int G_ROW = 64;
constexpr int G_SLOT = 384 * G_ROW;
constexpr int G_LDS_BYTES = 3 * G_SLOT;
DI const char* uni_ptr(const char* p) {
    const unsigned long long v = (unsigned long long)p;
    const unsigned lo = __builtin_amdgcn_readfirstlane((unsigned)v), hi = __builtin_amdgcn_readfirstlane((unsigned)(v >> 32));
    return (const char*)(((unsigned long long)hi << 32) | lo);
}
DI void dma16(const char* ubase, unsigned voff, char* lds_wave_base) { __builtin_amdgcn_global_load_lds((const unsigned*)(uni_ptr(ubase) + voff), (unsigned*)lds_wave_base, 16, 0, 0); }

template <int WM, int WN, int BROWS = 128, int AROWS = 128>
DI void gemm_mainloop(const Params& p, const u16* __restrict__ A, int ld, const u16* __restrict__ Bt, int  , int K, char* smem, int wm0, int wn0, f32x16 (&acc)[WM][WN]) {
    static_assert((AROWS % 64) == 0 && (BROWS % 64) == 0 && ((AROWS + BROWS) == 384 || (AROWS + BROWS) == 192), "slot shape");
    constexpr int SLOT = (AROWS + BROWS) * G_ROW, NP = (AROWS + BROWS) / 64;
    const int tid = opaque_tid(p), lane = tid & 63, r = lane & 31, half = lane >> 5;
    const int wave = p.wv;
    const unsigned voff = (unsigned)(lane >> 2) * (unsigned)(ld * 2) + (unsigned)(((lane & 3) ^ ((lane >> 4) & 3)) << 4);
    const char* ab = (const char*)A + (size_t)(wave * 16) * ld * 2;
    const char* bb = (const char*)Bt + (size_t)(wave * 16) * ld * 2;
    const size_t pstep = (size_t)64 * ld * 2;
    char* dbase = smem + wave * 1024;
    constexpr int NPA = AROWS / 64, NPB = BROWS / 64;
#define G_ISSUE(kt_, slot_) do { const size_t ko_ = (size_t)(kt_) * 64; char* d_ = dbase + (slot_) * SLOT; \
        _Pragma("unroll") for (int i_ = 0; i_ < NPA; ++i_) dma16(ab + i_ * pstep + ko_, voff, d_ + i_ * 4096); \
        _Pragma("unroll") for (int i_ = 0; i_ < NPB; ++i_) dma16(bb + i_ * pstep + ko_, voff, d_ + (NPA + i_) * 4096); } while (0)
    const int nk = K >> 5;
    asm volatile("s_waitcnt vmcnt(0)\n\ts_barrier" ::: "memory");
    G_ISSUE(0, 0); G_ISSUE(1, 1); G_ISSUE(2, 2);
    const int sw = (r >> 2) & 3;
    const int fo0 = r * G_ROW + ((half ^ sw) << 4), fo1 = r * G_ROW + (((2 + half) ^ sw) << 4);
    int slot = 0;
    for (int kt = 0; kt < nk; ++kt) {
        if constexpr (NP == 6) {
            if (kt + 2 < nk)      asm volatile("s_waitcnt vmcnt(12)\n\ts_barrier" ::: "memory");
            else if (kt + 1 < nk) asm volatile("s_waitcnt vmcnt(6)\n\ts_barrier" ::: "memory");
            else                  asm volatile("s_waitcnt vmcnt(0)\n\ts_barrier" ::: "memory");
        } else {
            if (kt + 2 < nk)      asm volatile("s_waitcnt vmcnt(6)\n\ts_barrier" ::: "memory");
            else if (kt + 1 < nk) asm volatile("s_waitcnt vmcnt(3)\n\ts_barrier" ::: "memory");
            else                  asm volatile("s_waitcnt vmcnt(0)\n\ts_barrier" ::: "memory");
        }
        const char* As = smem + slot * SLOT; const char* Bs = As + AROWS * G_ROW;
        bf16x8 af[2][WM], bfr[2][WN];
#pragma unroll
        for (int ks = 0; ks < 2; ++ks) {
            const int fo = ks ? fo1 : fo0;
#pragma unroll
            for (int i = 0; i < WM; ++i) af[ks][i] = lds_frag(As + (wm0 + 32 * i) * G_ROW + fo);
#pragma unroll
            for (int j = 0; j < WN; ++j) bfr[ks][j] = lds_frag(Bs + (wn0 + 32 * j) * G_ROW + fo);
        }
        asm volatile("s_waitcnt lgkmcnt(0)\n\ts_barrier" ::: "memory");
        if (kt + 3 < nk) G_ISSUE(kt + 3, slot);
#pragma unroll
        for (int ks = 0; ks < 2; ++ks)
#pragma unroll
            for (int i = 0; i < WM; ++i)
#pragma unroll
                for (int j = 0; j < WN; ++j) acc[i][j] = MFMA32(af[ks][i], bfr[ks][j], acc[i][j]);
        slot = (slot == 2) ? 0 : slot + 1;
    }
#undef G_ISSUE
}

enum { EPI_GLA_IN = 0, EPI_RESID = 1, EPI_DIFF_IN = 2 };

template <int EPI, int BN = 256>
DI void gemm_phase(const Params& p, const u16* A, const u16* Bt, int N, const float* resid, char* smem, int bid, int nb) {
    constexpr int TN = BN / 64;
    const int ntn = N / BN, ntm = T_TOK / 128;
    const int tid = opaque_tid(p), wave = tid >> 6, lane = tid & 63, r = lane & 31, half = lane >> 5;
    const int wm0 = (wave >> 1) * 64, wn0 = (wave & 1) * (BN / 2);
    for (int j = 0; j * nb < ntn * ntm; ++j) {
        const int u = xcd_unit(j, bid, nb);
        if (u >= ntn * ntm) continue;
        const int mt = u / ntn, nt = u - mt * ntn;
        const int m0 = mt * 128, n0 = nt * BN;
        f32x16 acc[2][TN];
#pragma unroll
        for (int i = 0; i < 2; ++i)
#pragma unroll
            for (int j = 0; j < TN; ++j) acc[i][j] = zero16();
        gemm_mainloop<2, TN, BN>(p, A + (size_t)m0 * 1024, 1024, Bt + (size_t)n0 * 1024, 1024, 1024, smem, wm0, wn0, acc);
        if constexpr (EPI == EPI_RESID) {
#pragma unroll
            for (int ti = 0; ti < 2; ++ti)
#pragma unroll
                for (int tj0 = 0; tj0 < TN; tj0 += 2) {
                    float rv[2][16];
#pragma unroll
                    for (int tt = 0; tt < 2; ++tt)
#pragma unroll
                        for (int i = 0; i < 16; ++i) rv[tt][i] = resid[(size_t)(m0 + wm0 + 32 * ti + crow(i, half)) * 1024 + n0 + wn0 + 32 * (tj0 + tt) + r];
#pragma unroll
                    for (int tt = 0; tt < 2; ++tt)
#pragma unroll
                        for (int i = 0; i < 16; ++i) p.out[(size_t)(m0 + wm0 + 32 * ti + crow(i, half)) * 1024 + n0 + wn0 + 32 * (tj0 + tt) + r] = rv[tt][i] + acc[ti][tj0 + tt][i];
                }
        } else
#pragma unroll
        for (int ti = 0; ti < 2; ++ti)
#pragma unroll
            for (int tj = 0; tj < TN; ++tj) {
                const int col = n0 + wn0 + 32 * tj + r;
                const int rowb = m0 + wm0 + 32 * ti;
                if constexpr (EPI == EPI_GLA_IN) {
                    u16* o = (u16*)(p.ws + WS_PROJ);
#pragma unroll
                    for (int i = 0; i < 16; ++i) o[(size_t)(rowb + crow(i, half)) * 3072 + col] = f2bf(acc[ti][tj][i]);
                } else if constexpr (EPI == EPI_RESID) {
#pragma unroll
                    for (int i = 0; i < 16; ++i) {
                        const size_t off = (size_t)(rowb + crow(i, half)) * 1024 + col;
                        p.out[off] = resid[off] + acc[ti][tj][i];
                    }
                } else if constexpr (EPI == EPI_DIFF_IN) {
                    if (col < 2048) {
                        const int c64 = col & 63;
                        const float qs = (col < 1024) ? 0.125f * 1.4426950408889634f : 1.0f;
                        const float2* cst = (const float2*)(p.ws + WS_ROPE);
                        u16* o = (u16*)(p.ws + WS_PROJ);
                        const bool rot = ((32 * tj) & 63) == 0;
                        float2 csr[16];
                        if (rot) {
#pragma unroll
                            for (int i = 0; i < 16; ++i) csr[i] = cst[(size_t)(rowb + crow(i, half)) * 8 + (c64 & 7)];
                        }
#pragma unroll
                        for (int i = 0; i < 16; ++i) {
                            const int row = rowb + crow(i, half);
                            float v = acc[ti][tj][i];
                            if (rot) {
                                const float pv = sxf<8>(v, half);
                                const float2 cs = csr[i];
                                if (c64 < 16) v = (c64 < 8) ? (v * cs.x - pv * cs.y) : (v * cs.x + pv * cs.y);
                            }
                            o[(size_t)row * 2048 + col] = f2bf(v * qs);
                        }
                    } else {
                        const int hv = (col - 2048) >> 7, dv = (col - 2048) & 127;
                        const int b = rowb >> 14, s0 = rowb & (SEQ - 1);
                        u16* o = (u16*)(p.ws + WS_VT) + ((size_t)(b * 8 + hv) * 128 + dv) * SEQ + s0;
#pragma unroll
                        for (int g = 0; g < 4; ++g) {
                            u32x2 w = {pk2(acc[ti][tj][4 * g], acc[ti][tj][4 * g + 1]), pk2(acc[ti][tj][4 * g + 2], acc[ti][tj][4 * g + 3])};
                            *(u32x2*)(o + 16 * (g >> 1) + 8 * half + 4 * (g & 1)) = w;
                        }
                    }
                }
            }
    }
}
DI void gla_glr_phase(const Params& p, char* smem, int bid, int nb) {
    const int tid = opaque_tid(p), wave = tid >> 6, lane = tid & 63, r = lane & 31, half = lane >> 5;
    const u16* hn = (const u16*)(p.ws + WS_HN);
    const u16* wg = (const u16*)(p.ws + WS_WGIN) + (size_t)3072 * 1024;
    for (int u = bid; u < T_TOK / 128; u += nb) {
        const int m0 = u * 128;
        f32x16 acc[1][2];
        acc[0][0] = zero16(); acc[0][1] = zero16();
        gemm_mainloop<1, 2, 64, 128>(p, hn + (size_t)m0 * 1024, 1024, wg, 1024, 1024, smem, 32 * wave, 0, acc);
        if (r < 16) {
            float* o = (float*)(p.ws + WS_GLR);
#pragma unroll
            for (int i = 0; i < 16; ++i) o[(size_t)(m0 + 32 * wave + crow(i, half)) * 16 + r] = acc[0][0][i];
        }
    }
}
constexpr int CUM_LD = 129;

DI float log_sigmoid(float z) {
    const float e = __builtin_amdgcn_exp2f(-fabsf(z) * 1.4426950408889634f);
    return fminf(z, 0.f) - __builtin_amdgcn_logf(1.f + e) * 0.6931471805599453f;
}

DI void gla_cum(const Params& p, int tok0, int h, float* cumL, float* glrL) {
    const int tid = opaque_tid(p), d = tid & 127, part = tid >> 7;
    const float* glr = (const float*)(p.ws + WS_GLR) + (size_t)tok0 * 16;
    ((f32x4*)glrL)[tid] = ((const f32x4*)glr)[tid];
    float w[16];
#pragma unroll
    for (int q = 0; q < 16; ++q) w[q] = p.gla_wgu[q * 512 + h * 128 + d];
    const float bias = p.gla_bg[h * 128 + d];
    __syncthreads();
    float run = 0.f;
#pragma unroll 1
    for (int c0 = part * 32; c0 < part * 32 + 32; c0 += 8) {
        float gl[8];
#pragma unroll
        for (int j = 0; j < 8; ++j) {
            const f32x4* gr = (const f32x4*)(glrL + (c0 + j) * 16);
            const f32x4 g0 = gr[0], g1 = gr[1], g2 = gr[2], g3 = gr[3];
            const float p0 = g0.x * w[0] + g0.y * w[1] + g0.z * w[2] + g0.w * w[3];
            const float p1 = g1.x * w[4] + g1.y * w[5] + g1.z * w[6] + g1.w * w[7];
            const float p2 = g2.x * w[8] + g2.y * w[9] + g2.z * w[10] + g2.w * w[11];
            const float p3 = g3.x * w[12] + g3.y * w[13] + g3.z * w[14] + g3.w * w[15];
            gl[j] = log_sigmoid(bias + ((p0 + p1) + (p2 + p3))) * (1.f / 16.f);
        }
#pragma unroll
        for (int j = 0; j < 8; ++j) { run += gl[j]; cumL[(c0 + j) * CUM_LD + d] = run; }
    }
    __syncthreads();
    if (part == 1) {
        const float add = cumL[31 * CUM_LD + d];
#pragma unroll 8
        for (int c = 32; c < 64; ++c) cumL[c * CUM_LD + d] += add;
    }
    __syncthreads();
}

DI void gla_pass1(const Params& p, char* smem, int bid, int nb) {
    const int tid = opaque_tid(p), wave = tid >> 6, lane = tid & 63, r = lane & 31, half = lane >> 5;
    float* cumL = (float*)smem; char* vT = smem; char* kdT = smem + 36864; float* glrL = (float*)(smem + 36864);
    const u16* proj = (const u16*)(p.ws + WS_PROJ);
    for (int u = bid; u < 2048; u += nb) {
        const int bh = u >> 8, n = u & 255, b = bh >> 2, h = bh & 3;
        const int tok0 = b * SEQ + n * 64;
        __syncthreads();
        gla_cum(p, tok0, h, cumL, glrL);
        if (tid < 128) ((float*)(p.ws + WS_DEC))[(size_t)u * 128 + tid] = __expf(cumL[63 * CUM_LD + tid]);
#pragma unroll 1
        for (int it = 0; it < 4; ++it) {
            const int d0 = (wave + 4 * it) * 8;
            const u32x4 kreg = *(const u32x4*)(proj + (size_t)(tok0 + lane) * 3072 + 512 + h * 128 + d0);
            const unsigned wv[4] = {kreg.x, kreg.y, kreg.z, kreg.w};
            const float* cl = cumL + 63 * CUM_LD + d0; const float* cc = cumL + lane * CUM_LD + d0;
            char* dst = kdT + (d0 * 72 + lane) * 2;
#pragma unroll
            for (int i = 0; i < 8; ++i) {
                const float kv = (i & 1) ? bfhi(wv[i >> 1]) : bflo(wv[i >> 1]);
                const float e = __expf(cl[i] - cc[i]);
                *(u16*)(dst + i * 144) = f2bf(kv * e);
            }
        }
        __syncthreads();
#pragma unroll 1
        for (int it = 0; it < 8; ++it) {
            const int v0 = (wave + 4 * it) * 8;
            const u32x4 vr = *(const u32x4*)(proj + (size_t)(tok0 + lane) * 3072 + 1024 + h * 256 + v0);
            const unsigned wv[4] = {vr.x, vr.y, vr.z, vr.w};
            char* dst = vT + (v0 * 72 + lane) * 2;
#pragma unroll
            for (int i = 0; i < 8; ++i) *(u16*)(dst + i * 144) = (u16)((i & 1) ? (wv[i >> 1] >> 16) : (wv[i >> 1] & 0xffffu));
        }
        __syncthreads();
        u16* kvo = (u16*)(p.ws + WS_KV) + (size_t)u * 32768;
#pragma unroll 1
        for (int jh = 0; jh < 2; ++jh) {
            f32x16 acc[2][2];
#pragma unroll
            for (int i = 0; i < 2; ++i)
#pragma unroll
                for (int j = 0; j < 2; ++j) acc[i][j] = zero16();
#pragma unroll
            for (int ks = 0; ks < 4; ++ks) {
                bf16x8 af[2], bfr[2];
#pragma unroll
                for (int i = 0; i < 2; ++i) af[i] = lds_frag(vT + (64 * wave + 32 * i + r) * 144 + ks * 32 + half * 16);
#pragma unroll
                for (int j = 0; j < 2; ++j) bfr[j] = lds_frag(kdT + (64 * jh + 32 * j + r) * 144 + ks * 32 + half * 16);
#pragma unroll
                for (int i = 0; i < 2; ++i)
#pragma unroll
                    for (int j = 0; j < 2; ++j) acc[i][j] = MFMA32(af[i], bfr[j], acc[i][j]);
            }
#pragma unroll
            for (int i = 0; i < 2; ++i)
#pragma unroll
                for (int j = 0; j < 2; ++j)
#pragma unroll
                    for (int q = 0; q < 16; ++q) kvo[(64 * wave + 32 * i + crow(q, half)) * 128 + 64 * jh + 32 * j + r] = f2bf(acc[i][j][q]);
        }
    }
}

DI void gla_scan(const Params& p, int bid, int nb) {
    u16* kv = (u16*)(p.ws + WS_KV);
    const float* dec = (const float*)(p.ws + WS_DEC);
    for (int g = bid * NTHR + opaque_tid(p); g < 32768; g += nb * NTHR) {
        const int bh = g >> 12, rem = g & 4095;
        const int dch = rem & 15;
        float st[8];
#pragma unroll
        for (int i = 0; i < 8; ++i) st[i] = 0.f;
        const size_t base = (size_t)bh * 256 * 32768 + (size_t)rem * 8;
        const float* dbase = dec + (size_t)bh * 256 * 128 + dch * 8;
        for (int n0 = 0; n0 < 256; n0 += 8) {
            u32x4 kk[8]; f32x4 d0[8], d1[8];
#pragma unroll
            for (int j = 0; j < 8; ++j) {
                kk[j] = *(const u32x4*)(kv + base + (size_t)(n0 + j) * 32768);
                d0[j] = *(const f32x4*)(dbase + (size_t)(n0 + j) * 128);
                d1[j] = *(const f32x4*)(dbase + (size_t)(n0 + j) * 128 + 4);
            }
#pragma unroll
            for (int j = 0; j < 8; ++j) {
                const u32x4 o = u32x4{pk2(st[0], st[1]), pk2(st[2], st[3]), pk2(st[4], st[5]), pk2(st[6], st[7])};
                *(u32x4*)(kv + base + (size_t)(n0 + j) * 32768) = o;
                const float dd[8] = {d0[j].x, d0[j].y, d0[j].z, d0[j].w, d1[j].x, d1[j].y, d1[j].z, d1[j].w};
                const unsigned wv[4] = {kk[j].x, kk[j].y, kk[j].z, kk[j].w};
#pragma unroll
                for (int i = 0; i < 8; ++i) st[i] = dd[i] * st[i] + ((i & 1) ? bfhi(wv[i >> 1]) : bflo(wv[i >> 1]));
            }
        }
    }
}

DI void gla_pass3(const Params& p, char* smem, int bid, int nb) {
    const int tid = opaque_tid(p), wave = tid >> 6, lane = tid & 63, r = lane & 31, half = lane >> 5;
    float* cumL = (float*)smem; char* vT = smem; char* aM = smem + 18432; char* qd = smem + 36864; char* kq = smem + 54272; float* glrL = (float*)(smem + 36864);
    float* oL = (float*)smem;
    const u16* proj = (const u16*)(p.ws + WS_PROJ);
    const float scale = 0.08838834764831845f;
    for (int u = bid; u < 2048; u += nb) {
        const int bh = u >> 8, n = u & 255, b = bh >> 2, h = bh & 3;
        const int tok0 = b * SEQ + n * 64;
        const u16* st = (const u16*)(p.ws + WS_KV) + (size_t)u * 32768;
        __syncthreads();
        u32x4 qreg[4], kreg[4];
#pragma unroll
        for (int it = 0; it < 4; ++it) {
            const int id = tid + 256 * it, c = id >> 4, dch = id & 15;
            qreg[it] = *(const u32x4*)(proj + (size_t)(tok0 + c) * 3072 + h * 128 + dch * 8);
            kreg[it] = *(const u32x4*)(proj + (size_t)(tok0 + c) * 3072 + 512 + h * 128 + dch * 8);
        }
        gla_cum(p, tok0, h, cumL, glrL);
        u32x4 vreg[4], sreg[8];
#pragma unroll
        for (int it = 0; it < 4; ++it) {
            const int q = wave + 4 * it, wq = q >> 2, vv0 = (q & 3) * 8;
            vreg[it] = *(const u32x4*)(proj + (size_t)(tok0 + lane) * 3072 + 1024 + h * 256 + 64 * wq + vv0);
        }
#pragma unroll
        for (int ks = 0; ks < 8; ++ks) sreg[ks] = *(const u32x4*)(st + (size_t)(64 * wave + r) * 128 + ks * 16 + half * 8);
#pragma unroll
        for (int it = 0; it < 4; ++it) {
            const int id = tid + 256 * it, c = id >> 4, dch = id & 15;
            const unsigned qw[4] = {qreg[it].x, qreg[it].y, qreg[it].z, qreg[it].w}, kw[4] = {kreg[it].x, kreg[it].y, kreg[it].z, kreg[it].w};
            unsigned qo[4], ko[4];
#pragma unroll
            for (int i = 0; i < 4; ++i) {
                const int d = dch * 8 + 2 * i;
                const float e0 = cumL[c * CUM_LD + d] - cumL[31 * CUM_LD + d], e1 = cumL[c * CUM_LD + d + 1] - cumL[31 * CUM_LD + d + 1];
                qo[i] = pk2(bflo(qw[i]) * scale * __expf(e0), bfhi(qw[i]) * scale * __expf(e1));
                ko[i] = pk2(bflo(kw[i]) * __expf(-e0), bfhi(kw[i]) * __expf(-e1));
            }
            *(u32x4*)(qd + c * 272 + dch * 16) = u32x4{qo[0], qo[1], qo[2], qo[3]};
            *(u32x4*)(kq + c * 272 + dch * 16) = u32x4{ko[0], ko[1], ko[2], ko[3]};
        }
        __syncthreads();
        const int rb = wave >> 1, cb = wave & 1;
        f32x16 aacc = zero16();
        if (cb <= rb) {
#pragma unroll
            for (int ks = 0; ks < 8; ++ks) {
                const bf16x8 af = lds_frag(qd + (32 * rb + r) * 272 + ks * 32 + half * 16);
                const bf16x8 bf = lds_frag(kq + (32 * cb + r) * 272 + ks * 32 + half * 16);
                aacc = MFMA32(af, bf, aacc);
            }
        }
        __syncthreads();
#pragma unroll
        for (int it = 0; it < 4; ++it) {
            const int id = tid + 256 * it, c = id >> 4, dch = id & 15;
            const unsigned qw[4] = {qreg[it].x, qreg[it].y, qreg[it].z, qreg[it].w};
            unsigned qo[4];
#pragma unroll
            for (int i = 0; i < 4; ++i) {
                const int d = dch * 8 + 2 * i;
                qo[i] = pk2(bflo(qw[i]) * scale * __expf(cumL[c * CUM_LD + d]), bfhi(qw[i]) * scale * __expf(cumL[c * CUM_LD + d + 1]));
            }
            *(u32x4*)(kq + c * 272 + dch * 16) = u32x4{qo[0], qo[1], qo[2], qo[3]};
        }
        __syncthreads();
#pragma unroll
        for (int q = 0; q < 16; ++q) {
            const int c = 32 * rb + crow(q, half), j = 32 * cb + r;
            *(u16*)(aM + (c * 72 + j) * 2) = f2bf((j <= c) ? aacc[q] : 0.f);
        }
        f32x16 o[2][2];
#pragma unroll
        for (int i = 0; i < 2; ++i)
#pragma unroll
            for (int j = 0; j < 2; ++j) o[i][j] = zero16();
        u32x2 rreg[16];
#pragma unroll
        for (int ps = 0; ps < 2; ++ps) {
            if (ps == 1) __syncthreads();
#pragma unroll
            for (int it = 0; it < 4; ++it) {
                const int q = wave + 4 * it, wq = q >> 2, vv0 = (q & 3) * 8;
                const unsigned wv[4] = {vreg[it].x, vreg[it].y, vreg[it].z, vreg[it].w};
                char* dst = vT + ((wq * 32 + vv0) * 72 + lane) * 2;
#pragma unroll
                for (int i = 0; i < 8; ++i) *(u16*)(dst + i * 144) = (u16)((i & 1) ? (wv[i >> 1] >> 16) : (wv[i >> 1] & 0xffffu));
            }
            if (ps == 0) {
#pragma unroll
                for (int it = 0; it < 4; ++it) {
                    const int q = wave + 4 * it, wq = q >> 2, vv0 = (q & 3) * 8;
                    vreg[it] = *(const u32x4*)(proj + (size_t)(tok0 + lane) * 3072 + 1024 + h * 256 + 64 * wq + 32 + vv0);
                }
            } else {
                const u16* rrow = proj + (size_t)(tok0 + (tid >> 2)) * 3072 + 2048 + h * 256 + 4 * (tid & 3);
#pragma unroll
                for (int j = 0; j < 16; ++j) rreg[j] = *(const u32x2*)(rrow + 16 * j);
            }
            __syncthreads();
#pragma unroll
            for (int ks = 0; ks < 4; ++ks) {
                const bf16x8 bf = lds_frag(vT + (wave * 32 + r) * 144 + ks * 32 + half * 16);
#pragma unroll
                for (int i = 0; i < 2; ++i) {
                    const bf16x8 af = lds_frag(aM + (32 * i + r) * 144 + ks * 32 + half * 16);
                    o[ps][i] = MFMA32(af, bf, o[ps][i]);
                }
            }
#pragma unroll
            for (int ks = 0; ks < 8; ++ks) {
                const bf16x8 bf = __builtin_bit_cast(bf16x8, sreg[ks]);
#pragma unroll
                for (int i = 0; i < 2; ++i) {
                    const bf16x8 af = lds_frag(kq + (32 * i + r) * 272 + ks * 32 + half * 16);
                    o[ps][i] = MFMA32(af, bf, o[ps][i]);
                }
            }
            if (ps == 0) {
#pragma unroll
                for (int ks = 0; ks < 8; ++ks) sreg[ks] = *(const u32x4*)(st + (size_t)(64 * wave + 32 + r) * 128 + ks * 16 + half * 8);
            }
        }
        __syncthreads();
#pragma unroll
        for (int ps = 0; ps < 2; ++ps)
#pragma unroll
            for (int i = 0; i < 2; ++i)
#pragma unroll
                for (int q = 0; q < 16; ++q) oL[(32 * i + crow(q, half)) * 260 + 64 * wave + 32 * ps + r] = o[ps][i][q];
        __syncthreads();
        {
            const int c = tid >> 2, qq = tid & 3;
            f32x4 vals[16]; float ss = 0.f;
#pragma unroll
            for (int j = 0; j < 16; ++j) {
                vals[j] = *(const f32x4*)(oL + c * 260 + 16 * j + 4 * qq);
                ss += vals[j].x * vals[j].x + vals[j].y * vals[j].y + vals[j].z * vals[j].z + vals[j].w * vals[j].w;
            }
            ss += sxf<1>(ss, 0); ss += sxf<2>(ss, 0);
            const float rinv = rsqrtf(ss * (1.f / 256.f) + 1e-6f);
            const float* gn = p.gla_norm + h * 256;
            u16* orow = (u16*)(p.ws + WS_HN) + (size_t)(tok0 + c) * 1024 + h * 256;
#pragma unroll
            for (int j = 0; j < 16; ++j) {
                const int v0 = 16 * j + 4 * qq;
                const u32x2 rr = rreg[j];
                const f32x4 g4 = *(const f32x4*)(gn + v0);
                const float r0 = bflo(rr.x), r1 = bfhi(rr.x), r2 = bflo(rr.y), r3 = bfhi(rr.y);
                const float o0 = vals[j].x * rinv * g4.x * (r0 / (1.f + __expf(-r0)));
                const float o1 = vals[j].y * rinv * g4.y * (r1 / (1.f + __expf(-r1)));
                const float o2 = vals[j].z * rinv * g4.z * (r2 / (1.f + __expf(-r2)));
                const float o3 = vals[j].w * rinv * g4.w * (r3 / (1.f + __expf(-r3)));
                *(u32x2*)(orow + v0) = u32x2{pk2(o0, o1), pk2(o2, o3)};
            }
        }
    }
}
DI unsigned sortable(float v) { const unsigned u = __float_as_uint(v); return (u & 0x80000000u) ? ~u : (u | 0x80000000u); }
DI float unsortable(unsigned k) { const unsigned u = (k & 0x80000000u) ? (k & 0x7fffffffu) : ~k; return __uint_as_float(u); }
DI void ins16(unsigned (&L)[16], unsigned x) {
#pragma unroll
    for (int i = 0; i < 16; ++i) { const unsigned hi = max(L[i], x); x = min(L[i], x); L[i] = hi; }
}

DI void ce(unsigned& a, unsigned& b) { const unsigned hi = max(a, b), lo = min(a, b); a = hi; b = lo; }
template <int N> DI void bitonic_sort_desc(unsigned (&v)[N]) {
#pragma unroll
    for (int k = 2; k <= N; k <<= 1)
#pragma unroll
        for (int j = k >> 1; j > 0; j >>= 1)
#pragma unroll
            for (int i = 0; i < N; ++i) {
                const int l = i ^ j;
                if (l > i) { if ((i & k) == 0) ce(v[i], v[l]); else ce(v[l], v[i]); }
            }
}
DI void top16_merge(unsigned (&a)[16], const unsigned (&b)[16]) {
#pragma unroll
    for (int i = 0; i < 16; ++i) a[i] = max(a[i], b[15 - i]);
#pragma unroll
    for (int j = 8; j > 0; j >>= 1)
#pragma unroll
        for (int i = 0; i < 16; ++i) { const int l = i ^ j; if (l > i) ce(a[i], a[l]); }
}
constexpr int PQ_LDS_BYTES = G_LDS_BYTES;
DI void peer_query_phase(const Params& p, int layer, char* smem, int bid, int nb) {
    const int tid = opaque_tid(p), wave = tid >> 6, lane = tid & 63, r = lane & 31, half = lane >> 5;
    const u16* hn = (const u16*)(p.ws + WS_HN);
    const u16* wq = (const u16*)(p.ws + WS_WPQ) + (size_t)layer * 2048 * 1024;
    const u16* sk = (const u16*)(p.ws + WS_SK) + (size_t)layer * 8 * 2 * 128 * 128;
    char* Bk = smem;
    for (int j = 0; j * nb < 2048; ++j) {
        const int u = xcd_unit(j, bid, nb);
        if (u >= 2048) continue;
        const int tb = u >> 3, h = u & 7;
        unsigned Lp[2][16];
        __syncthreads();
        f32x16 acc[8][1];
#pragma unroll
        for (int i = 0; i < 8; ++i) acc[i][0] = zero16();
        gemm_mainloop<8, 1, 128, 256>(p, wq + (size_t)(h * 256) * 1024, 1024, hn + (size_t)(tb * 128) * 1024, 1024, 1024, smem, 0, 32 * wave, acc);
        bf16x8 bqa[2][8];
#pragma unroll
        for (int pp = 0; pp < 2; ++pp)
#pragma unroll
            for (int di = 0; di < 4; ++di) { bqa[pp][2 * di] = pack8(acc[4 * pp + di][0], 0); bqa[pp][2 * di + 1] = pack8(acc[4 * pp + di][0], 1); }
#pragma unroll
        for (int pp = 0; pp < 2; ++pp) {
            __syncthreads();
            const u16* skt = sk + (size_t)(h * 2 + pp) * 128 * 128;
            int tidl = tid; asm volatile("" : "+v"(tidl));
            {
                const int n0 = tidl >> 4, ch = tidl & 15;
                u32x4 tmp[8];
#pragma unroll
                for (int it = 0; it < 8; ++it) tmp[it] = *(const u32x4*)(skt + (n0 + 16 * it) * 128 + ch * 8);
#pragma unroll
                for (int it = 0; it < 8; ++it) *(u32x4*)(Bk + (n0 + 16 * it) * 272 + ch * 16) = tmp[it];
            }
            __syncthreads();
            f32x16 sc[4];
#pragma unroll
            for (int i = 0; i < 4; ++i) sc[i] = zero16();
#pragma unroll
            for (int di = 0; di < 4; ++di)
#pragma unroll
                for (int s = 0; s < 2; ++s) {
                    const bf16x8 bq = bqa[pp][2 * di + s];
#pragma unroll
                    for (int kb = 0; kb < 4; ++kb) {
                        const char* rowp = Bk + (32 * kb + r) * 272 + (32 * di + 16 * s + 4 * half) * 2;
                        const bf16x8 ak = lds_frag2(rowp, rowp + 16);
                        sc[kb] = MFMA32(ak, bq, sc[kb]);
                    }
                }
            unsigned L[16];
            {
                unsigned G[4][16];
                int hq4 = 4 * half; asm volatile("" : "+v"(hq4));
#pragma unroll
                for (int kb = 0; kb < 4; ++kb) {
#pragma unroll
                    for (int q = 0; q < 16; ++q) G[kb][q] = (sortable(sc[kb][q]) & 0xffffff80u) | (unsigned)(127 - 32 * kb - crow(q, 0) - hq4);
                    bitonic_sort_desc<16>(G[kb]);
                }
                top16_merge(G[0], G[1]); top16_merge(G[2], G[3]); top16_merge(G[0], G[2]);
#pragma unroll
                for (int i = 0; i < 16; ++i) L[i] = G[0][i];
            }
            {
                unsigned O[16];
#pragma unroll
                for (int i = 0; i < 16; ++i) O[i] = sxu<32>(L[i], half);
                top16_merge(L, O);
            }
#pragma unroll
            for (int i = 0; i < 16; ++i) Lp[pp][i] = L[i];
        }
        float s1[16], s2[16]; int i1[16], i2[16];
#pragma unroll
        for (int i = 0; i < 16; ++i) {
            s1[i] = unsortable(Lp[0][i] & 0xffffff80u); i1[i] = 127 - (int)(Lp[0][i] & 127u);
            s2[i] = unsortable(Lp[1][i] & 0xffffff80u); i2[i] = 127 - (int)(Lp[1][i] & 127u);
        }
        __syncthreads();
        int* tabL = (int*)(smem + wave * 8192);
        if (half == 0) {
#pragma unroll
            for (int i = 0; i < 16; ++i) { tabL[i * 32 + r] = i1[i]; tabL[(16 + i) * 32 + r] = i2[i]; tabL[(32 + i) * 32 + r] = __float_as_int(s1[i]); tabL[(48 + i) * 32 + r] = __float_as_int(s2[i]); }
        }
        unsigned C[16], D[16];
#pragma unroll
        for (int i = 0; i < 16; ++i) { C[i] = 0u; D[i] = 0u; }
#define CANDK(a0, b0, a1, b1) ((sortable(half ? (s1[a1] + s2[b1]) : (s1[a0] + s2[b0])) & 0xffffff00u) | (unsigned)(255 - (half ? (16 * a1 + b1) : (16 * a0 + b0))))
        C[0] = CANDK(0, 0, 0, 1);
        C[1] = CANDK(0, 2, 0, 3);
        C[2] = CANDK(0, 4, 0, 5);
        C[3] = CANDK(0, 6, 0, 7);
        C[4] = CANDK(0, 8, 0, 9);
        C[5] = CANDK(0, 10, 0, 11);
        C[6] = CANDK(0, 12, 0, 13);
        C[7] = CANDK(0, 14, 0, 15);
        C[8] = CANDK(1, 0, 1, 1);
        C[9] = CANDK(1, 2, 1, 3);
        C[10] = CANDK(1, 4, 1, 5);
        C[11] = CANDK(1, 6, 1, 7);
        C[12] = CANDK(2, 0, 2, 1);
        C[13] = CANDK(2, 2, 2, 3);
        C[14] = CANDK(2, 4, 3, 0);
        C[15] = CANDK(3, 1, 3, 2);
        D[0] = CANDK(3, 3, 4, 0);
        D[1] = CANDK(4, 1, 4, 2);
        D[2] = CANDK(5, 0, 5, 1);
        D[3] = CANDK(6, 0, 6, 1);
        D[4] = CANDK(7, 0, 7, 1);
        D[5] = CANDK(8, 0, 9, 0);
        D[6] = CANDK(10, 0, 11, 0);
        D[7] = CANDK(12, 0, 13, 0);
        D[8] = CANDK(14, 0, 15, 0);
#undef CANDK
        bitonic_sort_desc<16>(C); bitonic_sort_desc<16>(D);
        top16_merge(C, D);
        {
            unsigned O[16];
#pragma unroll
            for (int i = 0; i < 16; ++i) O[i] = sxu<32>(C[i], half);
            top16_merge(C, O);
        }
        float bs[16]; int bi[16];
#pragma unroll
        for (int i = 0; i < 16; ++i) {
            const int id = 255 - (int)(C[i] & 255u), a = id >> 4, b = id & 15;
            bi[i] = tabL[a * 32 + r] * 128 + tabL[(16 + b) * 32 + r];
            bs[i] = __int_as_float(tabL[(32 + a) * 32 + r]) + __int_as_float(tabL[(48 + b) * 32 + r]);
        }
        float den = 0.f, ex[16];
#pragma unroll
        for (int i = 0; i < 16; ++i) { ex[i] = __expf(bs[i] - bs[0]); den += ex[i]; }
        const float rden = 1.f / den;
        int rl = r; asm volatile("" : "+v"(rl));
        const int tok = tb * 128 + 32 * wave + rl;
        int* io = (int*)(p.ws + WS_IDX) + (size_t)tok * 128 + h * 16 + 8 * half;
        float* go = (float*)(p.ws + WS_GATE) + (size_t)tok * 128 + h * 16 + 8 * half;
        if (half == 0) {
            *(u32x4*)(io) = u32x4{(unsigned)bi[0], (unsigned)bi[1], (unsigned)bi[2], (unsigned)bi[3]};
            *(u32x4*)(io + 4) = u32x4{(unsigned)bi[4], (unsigned)bi[5], (unsigned)bi[6], (unsigned)bi[7]};
            *(f32x4*)(go) = f32x4{ex[0] * rden, ex[1] * rden, ex[2] * rden, ex[3] * rden};
            *(f32x4*)(go + 4) = f32x4{ex[4] * rden, ex[5] * rden, ex[6] * rden, ex[7] * rden};
        } else {
            *(u32x4*)(io) = u32x4{(unsigned)bi[8], (unsigned)bi[9], (unsigned)bi[10], (unsigned)bi[11]};
            *(u32x4*)(io + 4) = u32x4{(unsigned)bi[12], (unsigned)bi[13], (unsigned)bi[14], (unsigned)bi[15]};
            *(f32x4*)(go) = f32x4{ex[8] * rden, ex[9] * rden, ex[10] * rden, ex[11] * rden};
            *(f32x4*)(go + 4) = f32x4{ex[12] * rden, ex[13] * rden, ex[14] * rden, ex[15] * rden};
        }
    }
}

typedef __attribute__((ext_vector_type(2))) float f32x2;
DI float gelu_exact(float a) { return 0.5f * a * (1.f + erff(a * 0.7071067811865476f)); }
DI void unpack8_fp4(unsigned w, float (&f)[8]) {
    const f32x2 a = __builtin_amdgcn_cvt_scalef32_pk_f32_fp4(w, 1.0f, 0), b = __builtin_amdgcn_cvt_scalef32_pk_f32_fp4(w, 1.0f, 1);
    const f32x2 c = __builtin_amdgcn_cvt_scalef32_pk_f32_fp4(w, 1.0f, 2), d = __builtin_amdgcn_cvt_scalef32_pk_f32_fp4(w, 1.0f, 3);
    f[0] = a.x; f[1] = a.y; f[2] = b.x; f[3] = b.y; f[4] = c.x; f[5] = c.y; f[6] = d.x; f[7] = d.y;
}
constexpr float PG_SX = 21.6f;
constexpr int PG_RING_SLOTS = 16, PG_DEPTH = 14;
constexpr int PG_LDS_BYTES = 4 * PG_RING_SLOTS * 1024 + 4096;
DI void pg_dma(const unsigned char* tab, unsigned e, unsigned lane_off, char* slot) {
    __builtin_amdgcn_global_load_lds((const unsigned*)(tab + (e * 512u + lane_off)), (unsigned*)slot, 16, 0, 0);
}
DI void pg_dma4(const unsigned char* tab, const u32x4 e4, unsigned lane_off, char* ring, int g) {
    pg_dma(tab, e4.x, lane_off, ring + ((4 * g + 0) & 15) * 1024); pg_dma(tab, e4.y, lane_off, ring + ((4 * g + 1) & 15) * 1024);
    pg_dma(tab, e4.z, lane_off, ring + ((4 * g + 2) & 15) * 1024); pg_dma(tab, e4.w, lane_off, ring + ((4 * g + 3) & 15) * 1024);
}
#define PG_WAIT_GROUP(g) do { if ((g) + 3 < 16) asm volatile("s_waitcnt vmcnt(12)" ::: "memory"); else if ((g) == 13) asm volatile("s_waitcnt vmcnt(8)" ::: "memory"); \
                              else if ((g) == 14) asm volatile("s_waitcnt vmcnt(4)" ::: "memory"); else asm volatile("s_waitcnt vmcnt(0)" ::: "memory"); } while (0)
DI void peer_u_phase(const Params& p, int layer, char* smem, int bid, int nb) {
    const int tid = opaque_tid(p), wave = __builtin_amdgcn_readfirstlane(tid >> 6), lane = tid & 63, hh = lane >> 5, li = lane & 31;
    char* ring = smem + wave * (PG_RING_SLOTS * 1024);
    int* idxL = (int*)(smem + 4 * PG_RING_SLOTS * 1024 + wave * 1024); float* cL = (float*)(idxL + 128);
    const unsigned char* tu = (const unsigned char*)(p.ws + WS_TAB) + (size_t)layer * 16 * MB;
    const u16* hn = (const u16*)(p.ws + WS_HN);
    const char* myslot = ring + lane * 16;
    const unsigned lane_off = (unsigned)li * 16u;
    const int* idxH = idxL + hh * 64;
    for (int t = bid * 4 + wave; t < T_TOK; t += nb * 4) {
        const int* ig = (const int*)(p.ws + WS_IDX) + (size_t)t * 128;
        idxL[(lane & 1) * 64 + (lane >> 1)] = ig[lane]; idxL[(lane & 1) * 64 + 32 + (lane >> 1)] = ig[lane + 64];
        unsigned xh[4], xl[4];
        {
            const u16* xr = hn + (size_t)t * 1024 + 32 * li;
            const u32x4 xa = *(const u32x4*)(xr), xb = *(const u32x4*)(xr + 8), xc = *(const u32x4*)(xr + 16), xd = *(const u32x4*)(xr + 24);
            const unsigned xw[16] = {xa.x, xa.y, xa.z, xa.w, xb.x, xb.y, xb.z, xb.w, xc.x, xc.y, xc.z, xc.w, xd.x, xd.y, xd.z, xd.w};
#pragma unroll
            for (int d = 0; d < 4; ++d) {
                unsigned hw = 0, lw = 0;
#pragma unroll
                for (int j = 0; j < 8; ++j) {
                    const unsigned w = xw[4 * d + (j >> 1)];
                    const float xv = (j & 1) ? bfhi(w) : bflo(w);
                    const int q = (int)rintf(fminf(fmaxf(xv * PG_SX, -119.f), 119.f));
                    const int lo = ((q + 8) & 15) - 8, hi = (q - lo) >> 4;
                    hw |= ((unsigned)hi & 15u) << (4 * j); lw |= ((unsigned)lo & 15u) << (4 * j);
                }
                xh[d] = hw; xl[d] = lw;
            }
        }
        asm volatile("s_waitcnt vmcnt(0) lgkmcnt(0)" ::: "memory");
#pragma unroll
        for (int g = 0; g < 3; ++g) pg_dma4(tu, *(const u32x4*)(idxH + 4 * g), lane_off, ring, g);
#pragma unroll 1
        for (int bt = 0; bt < 4; ++bt) {
            float pr[16];
#pragma unroll
            for (int gg = 0; gg < 4; ++gg) {
                const int g = bt * 4 + gg;
                if (g + 3 < 16) pg_dma4(tu, *(const u32x4*)(idxH + 4 * (g + 3)), lane_off, ring, g + 3);
                PG_WAIT_GROUP(g);
                u32x4 w[4];
#pragma unroll
                for (int i = 0; i < 4; ++i) w[i] = *(const u32x4*)(myslot + ((4 * gg + i) & 15) * 1024);
#pragma unroll
                for (int i = 0; i < 4; ++i) {
                    const unsigned ww[4] = {w[i].x, w[i].y, w[i].z, w[i].w};
                    int ah = 0, al = 0;
#pragma unroll
                    for (int c = 0; c < 4; ++c) { ah = __builtin_amdgcn_sdot8((int)ww[c], (int)xh[c], ah, false); al = __builtin_amdgcn_sdot8((int)ww[c], (int)xl[c], al, false); }
                    pr[4 * gg + i] = (float)(16 * ah + al);
                }
            }
            float q8[8], q4[4], q2[2], q1;
            { const bool up = (lane & 1) != 0;
#pragma unroll
              for (int i = 0; i < 8; ++i) { const float send = up ? pr[i] : pr[i + 8]; const float keep = up ? pr[i + 8] : pr[i]; q8[i] = keep + sxf<1>(send, hh); } }
            { const bool up = (lane & 2) != 0;
#pragma unroll
              for (int i = 0; i < 4; ++i) { const float send = up ? q8[i] : q8[i + 4]; const float keep = up ? q8[i + 4] : q8[i]; q4[i] = keep + sxf<2>(send, hh); } }
            { const bool up = (lane & 4) != 0;
#pragma unroll
              for (int i = 0; i < 2; ++i) { const float send = up ? q4[i] : q4[i + 2]; const float keep = up ? q4[i + 2] : q4[i]; q2[i] = keep + sxf<4>(send, hh); } }
            { const bool up = (lane & 8) != 0; const float send = up ? q2[0] : q2[1]; const float keep = up ? q2[1] : q2[0]; q1 = keep + sxf<8>(send, hh); }
            q1 += sxf<16>(q1, hh);
            const int jj = 8 * (lane & 1) + 4 * ((lane >> 1) & 1) + 2 * ((lane >> 2) & 1) + ((lane >> 3) & 1);
            if ((lane & 16) == 0) cL[2 * (bt * 16 + jj) + hh] = q1;
        }
        float* dg = (float*)(p.ws + WS_DOT) + (size_t)t * 128;
        dg[lane] = cL[lane]; dg[lane + 64] = cL[lane + 64];
    }
}
typedef __attribute__((ext_vector_type(2))) _Float16 h2_t;
DI void pg_axpy(h2_t (&o2)[16], const u32x4 w, float cfs) {
    const _Float16 ch = (_Float16)cfs; const h2_t cf2 = {ch, ch};
    const unsigned ww[4] = {w.x, w.y, w.z, w.w};
#pragma unroll
    for (int c = 0; c < 4; ++c) {
        o2[4 * c + 0] = __builtin_amdgcn_cvt_scalef32_pk_f16_fp4(ww[c], 1.0f, 0) * cf2 + o2[4 * c + 0];
        o2[4 * c + 1] = __builtin_amdgcn_cvt_scalef32_pk_f16_fp4(ww[c], 1.0f, 1) * cf2 + o2[4 * c + 1];
        o2[4 * c + 2] = __builtin_amdgcn_cvt_scalef32_pk_f16_fp4(ww[c], 1.0f, 2) * cf2 + o2[4 * c + 2];
        o2[4 * c + 3] = __builtin_amdgcn_cvt_scalef32_pk_f16_fp4(ww[c], 1.0f, 3) * cf2 + o2[4 * c + 3];
    }
}
template <bool FINAL>
DI void peer_v_phase(const Params& p, int layer, const float* gnext, char* smem, int bid, int nb) {
    const int tid = opaque_tid(p), wave = __builtin_amdgcn_readfirstlane(tid >> 6), lane = tid & 63, hh = lane >> 5, li = lane & 31;
    char* ring = smem + wave * (PG_RING_SLOTS * 1024);
    int* idxL = (int*)(smem + 4 * PG_RING_SLOTS * 1024 + wave * 1024); float* cL = (float*)(idxL + 128);
    const unsigned char* tv = (const unsigned char*)(p.ws + WS_TAB) + (size_t)layer * 16 * MB + (size_t)16384 * 512;
    const char* myslot = ring + lane * 16;
    const unsigned lane_off = (unsigned)li * 16u;
    const int* idxH = idxL + hh * 64; const float* cH = cL + hh * 64;
    for (int t = bid * 4 + wave; t < T_TOK; t += nb * 4) {
        const int* ig = (const int*)(p.ws + WS_IDX) + (size_t)t * 128;
        const float* gg = (const float*)(p.ws + WS_GATE) + (size_t)t * 128;
        const float* dg = (const float*)(p.ws + WS_DOT) + (size_t)t * 128;
        const int s0 = (lane & 1) * 64 + (lane >> 1), s1 = s0 + 32;
        idxL[s0] = ig[lane]; idxL[s1] = ig[lane + 64];
        {
            const float d0 = dg[lane] * (1.f / (TAB_SCALE_UI * PG_SX)), d1 = dg[lane + 64] * (1.f / (TAB_SCALE_UI * PG_SX));
            cL[s0] = gg[lane] * gelu_exact(d0) * (1.f / TAB_SCALE_V); cL[s1] = gg[lane + 64] * gelu_exact(d1) * (1.f / TAB_SCALE_V);
        }
        asm volatile("s_waitcnt vmcnt(0) lgkmcnt(0)" ::: "memory");
#pragma unroll
        for (int g = 0; g < 3; ++g) pg_dma4(tv, *(const u32x4*)(idxH + 4 * g), lane_off, ring, g);
        h2_t o2[16];
#pragma unroll
        for (int i = 0; i < 16; ++i) o2[i] = h2_t{(_Float16)0.f, (_Float16)0.f};
#pragma unroll 1
        for (int bt = 0; bt < 4; ++bt) {
#pragma unroll
            for (int gg = 0; gg < 4; ++gg) {
                const int g = bt * 4 + gg;
                if (g + 3 < 16) pg_dma4(tv, *(const u32x4*)(idxH + 4 * (g + 3)), lane_off, ring, g + 3);
                const f32x4 c4 = *(const f32x4*)(cH + 4 * g);
                PG_WAIT_GROUP(g);
                u32x4 w[4];
#pragma unroll
                for (int i = 0; i < 4; ++i) w[i] = *(const u32x4*)(myslot + ((4 * gg + i) & 15) * 1024);
                pg_axpy(o2, w[0], c4.x); pg_axpy(o2, w[1], c4.y); pg_axpy(o2, w[2], c4.z); pg_axpy(o2, w[3], c4.w);
            }
        }
        float r[16];
#pragma unroll
        for (int i = 0; i < 8; ++i) {
            const h2_t send = hh ? o2[i] : o2[i + 8]; const h2_t keep = hh ? o2[i + 8] : o2[i];
            const h2_t got = __builtin_bit_cast(h2_t, sxu<32>(__builtin_bit_cast(unsigned, send), hh));
            r[2 * i] = (float)keep.x + (float)got.x; r[2 * i + 1] = (float)keep.y + (float)got.y;
        }
        float* hr = p.out + (size_t)t * 1024 + 32 * li + 16 * hh;
        f32x4 h0 = *(f32x4*)(hr), h1 = *(f32x4*)(hr + 4), h2 = *(f32x4*)(hr + 8), h3 = *(f32x4*)(hr + 12);
        h0 += f32x4{r[0], r[1], r[2], r[3]}; h1 += f32x4{r[4], r[5], r[6], r[7]};
        h2 += f32x4{r[8], r[9], r[10], r[11]}; h3 += f32x4{r[12], r[13], r[14], r[15]};
        float ss = h0.x * h0.x + h0.y * h0.y + h0.z * h0.z + h0.w * h0.w + h1.x * h1.x + h1.y * h1.y + h1.z * h1.z + h1.w * h1.w
                 + h2.x * h2.x + h2.y * h2.y + h2.z * h2.z + h2.w * h2.w + h3.x * h3.x + h3.y * h3.y + h3.z * h3.z + h3.w * h3.w;
        ss = wave_sum(ss, hh);
        const float rn = rsqrtf(ss * (1.f / 1024.f) + 1e-6f);
        const float* gp = gnext + 32 * li + 16 * hh;
        const f32x4 g0v = *(const f32x4*)(gp), g1v = *(const f32x4*)(gp + 4), g2v = *(const f32x4*)(gp + 8), g3v = *(const f32x4*)(gp + 12);
        if constexpr (FINAL) {
            *(f32x4*)(hr) = h0 * rn * g0v; *(f32x4*)(hr + 4) = h1 * rn * g1v; *(f32x4*)(hr + 8) = h2 * rn * g2v; *(f32x4*)(hr + 12) = h3 * rn * g3v;
        } else {
            *(f32x4*)(hr) = h0; *(f32x4*)(hr + 4) = h1; *(f32x4*)(hr + 8) = h2; *(f32x4*)(hr + 12) = h3;
            const f32x4 n0 = h0 * rn * g0v, n1 = h1 * rn * g1v, n2 = h2 * rn * g2v, n3 = h3 * rn * g3v;
            u16* hno = (u16*)(p.ws + WS_HN) + (size_t)t * 1024 + 32 * li + 16 * hh;
            *(u32x4*)(hno) = u32x4{pk2(n0.x, n0.y), pk2(n0.z, n0.w), pk2(n1.x, n1.y), pk2(n1.z, n1.w)};
            *(u32x4*)(hno + 8) = u32x4{pk2(n2.x, n2.y), pk2(n2.z, n2.w), pk2(n3.x, n3.y), pk2(n3.z, n3.w)};
        }
    }
}
constexpr int AT_LDS_BYTES = 65536;
constexpr float LAMBDA_INIT = 0.35550906759096927f;
constexpr float AT_THR = 8.f;


DI float max16(const f32x16& S) {
    float t0, t1, t2, t3, t4;
    asm volatile("s_nop 15\n\tv_max3_f32 %0, %5, %6, %7\n\tv_max3_f32 %1, %8, %9, %10\n\tv_max3_f32 %2, %11, %12, %13\n\tv_max3_f32 %3, %14, %15, %16\n\t"
                 "v_max3_f32 %4, %17, %18, %19\n\tv_max3_f32 %0, %0, %1, %20\n\tv_max3_f32 %2, %2, %3, %4\n\tv_max_f32 %0, %0, %2"
                 : "=&v"(t0), "=&v"(t1), "=&v"(t2), "=&v"(t3), "=&v"(t4)
                 : "v"(S[0]), "v"(S[1]), "v"(S[2]), "v"(S[3]), "v"(S[4]), "v"(S[5]), "v"(S[6]), "v"(S[7]), "v"(S[8]), "v"(S[9]), "v"(S[10]), "v"(S[11]),
                   "v"(S[12]), "v"(S[13]), "v"(S[14]), "v"(S[15]));
    return t0;
}
DI void attn_tile(const char* Kb, const char* Vb, const char* Qw, f32x16 (&O1)[4], f32x16 (&O2)[4], float& m1, float& l1, float& m2, float& l2,
                  bool diag, bool first, int k0, int qidx, int r, int half) {
    const int ksw = (r >> 1) & 7;
    const char* krow = Kb + r * 128;
    f32x16 S0, S1;
#pragma unroll
    for (int i = 0; i < 16; ++i) { S0[i] = -m1; S1[i] = -m2; }
    __builtin_amdgcn_s_setprio(1);
    {
        bf16x8 kf[4], qf[4];
#pragma unroll
        for (int ks = 0; ks < 4; ++ks) { kf[ks] = lds_frag(krow + (((2 * ks + half) ^ ksw) << 4)); qf[ks] = lds_frag(Qw + ks * 1024); }
#pragma unroll
        for (int ks = 0; ks < 4; ++ks) S0 = MFMA32(kf[ks], qf[ks], S0);
    }
    {
        bf16x8 kf[4], qf[4];
#pragma unroll
        for (int ks = 0; ks < 4; ++ks) { kf[ks] = lds_frag(krow + 4096 + (((2 * ks + half) ^ ksw) << 4)); qf[ks] = lds_frag(Qw + (4 + ks) * 1024); }
#pragma unroll
        for (int ks = 0; ks < 4; ++ks) S1 = MFMA32(kf[ks], qf[ks], S1);
    }
    __builtin_amdgcn_s_setprio(0);
    const int vsw = (r >> 2) & 3;
    const char* vrow = Vb + r * 64;
    const int vo0 = ((0 + half) ^ vsw) << 4, vo1 = ((2 + half) ^ vsw) << 4;
    __builtin_amdgcn_sched_barrier(0);
    if (diag) {
#pragma unroll
        for (int i = 0; i < 16; ++i) if (k0 + crow(i, half) > qidx) { S0[i] = -INFINITY; S1[i] = -INFINITY; }
    }
    float mx0 = max16(S0), mx1 = max16(S1);
    mx0 = fmaxf(mx0, sxf<32>(mx0, half)); mx1 = fmaxf(mx1, sxf<32>(mx1, half));
    if (first || !__all((mx0 <= AT_THR) && (mx1 <= AT_THR))) {
        const float d1 = fmaxf(mx0, 0.f), d2 = fmaxf(mx1, 0.f);
        const float e1 = first ? mx0 : d1, e2 = first ? mx1 : d2;
#pragma unroll
        for (int i = 0; i < 16; ++i) { S0[i] -= e1; S1[i] -= e2; }
        if (!first) {
            const float a1 = __builtin_amdgcn_exp2f(-d1), a2 = __builtin_amdgcn_exp2f(-d2);
#pragma unroll
            for (int d = 0; d < 4; ++d) { O1[d] *= a1; O2[d] *= a2; }
            l1 *= a1; l2 *= a2;
        }
        m1 += e1; m2 += e2;
    }
    __builtin_amdgcn_sched_barrier(0);
    bf16x8 vf[8];
#pragma unroll
    for (int d = 0; d < 4; ++d) { vf[2 * d] = lds_frag(vrow + d * 2048 + vo0); vf[2 * d + 1] = lds_frag(vrow + d * 2048 + vo1); }
    float ps0 = 0.f;
#pragma unroll
    for (int i = 0; i < 16; ++i) { const float pv = __builtin_amdgcn_exp2f(S0[i]); S0[i] = pv; ps0 += pv; }
    l1 += ps0;
    const bf16x8 P00 = pack8(S0, 0), P01 = pack8(S0, 1);
    __builtin_amdgcn_sched_barrier(0);
    __builtin_amdgcn_s_setprio(1);
#pragma unroll
    for (int d = 0; d < 4; ++d) { O1[d] = MFMA32(vf[2 * d], P00, O1[d]); O1[d] = MFMA32(vf[2 * d + 1], P01, O1[d]); }
    float ps1 = 0.f;
#pragma unroll
    for (int i = 0; i < 16; ++i) { const float pv = __builtin_amdgcn_exp2f(S1[i]); S1[i] = pv; ps1 += pv; }
    l2 += ps1;
    const bf16x8 P10 = pack8(S1, 0), P11 = pack8(S1, 1);
#pragma unroll
    for (int g = 0; g < 8; ++g) { __builtin_amdgcn_sched_group_barrier(0x8, 1, 0); __builtin_amdgcn_sched_group_barrier(0x2, 8, 0); }
    __builtin_amdgcn_sched_barrier(0);
#pragma unroll
    for (int d = 0; d < 4; ++d) { O2[d] = MFMA32(vf[2 * d], P10, O2[d]); O2[d] = MFMA32(vf[2 * d + 1], P11, O2[d]); }
    __builtin_amdgcn_s_setprio(0);
    __builtin_amdgcn_sched_barrier(0);
}

DI void attn_phase(const Params& p, char* smem, int bid, int nb) {
    const int tid = opaque_tid(p), wave = __builtin_amdgcn_readfirstlane(tid >> 6), lane = tid & 63, r = lane & 31, half = lane >> 5;
    char* Qs = smem; char* Kbuf = smem + 32768; char* Vbuf = smem + 49152;
    const u16* qk = (const u16*)(p.ws + WS_PROJ);
    const u16* vt = (const u16*)(p.ws + WS_VT);
    const float lam = __uint_as_float(__builtin_amdgcn_readfirstlane(__float_as_uint(
        __expf(wave_sum(p.lq1[lane] * p.lk1[lane], half)) - __expf(wave_sum(p.lq2[lane] * p.lk2[lane], half)) + LAMBDA_INIT)));
    const unsigned q_off = (unsigned)(lane & 31) * 4096u + (unsigned)(lane >> 5) * 16u;
    const unsigned kx = (unsigned)((lane & 7) ^ (lane >> 4));
    const unsigned k_off0 = (unsigned)(lane >> 3) * 4096u + (kx << 4), k_off1 = (unsigned)(lane >> 3) * 4096u + ((kx ^ 4u) << 4);
    const unsigned v_off = (unsigned)(lane >> 2) * (unsigned)(SEQ * 2) + (unsigned)(((lane & 3) ^ ((lane >> 4) & 3)) << 4);
    const int nrounds = (2048 + nb - 1) / nb;
    for (int j = 0; j < nrounds; ++j) {
        const int rank = j * nb + ((j & 1) ? (nb - 1 - bid) : bid);
        if (rank >= 2048) continue;
        const int qb = 127 - (rank >> 4), bh = rank & 15, b = bh >> 3, h = bh & 7;
        const int q0 = qb * 128, tokbase = b * SEQ, qlo = q0 + 32 * wave, qidx = qlo + r;
        const u16* kbase = qk + (size_t)tokbase * 2048 + 1024 + h * 128;
        const u16* vbase = vt + (size_t)(b * 8 + h) * 128 * SEQ;
        const int nkt = 4 * (qb + 1);
        __syncthreads();
        {
            const char* qsrc = (const char*)(qk + (size_t)(tokbase + q0 + wave * 32) * 2048 + h * 128);
#pragma unroll
            for (int i = 0; i < 8; ++i) dma16(qsrc + i * 32, q_off, Qs + (wave * 8 + i) * 1024);
        }
        const char* ksrc = (const char*)(kbase + (size_t)(16 * (wave & 1)) * 2048 + (wave >> 1) * 64);
        const char* vsrc = (const char*)(vbase + (size_t)(wave * 32) * SEQ);
        dma16(ksrc, k_off0, Kbuf + (wave * 2) * 1024);
        dma16(ksrc + 8 * 4096, k_off1, Kbuf + (wave * 2 + 1) * 1024);
        dma16(vsrc, v_off, Vbuf + (wave * 2) * 1024);
        dma16(vsrc + 16 * SEQ * 2, v_off, Vbuf + (wave * 2 + 1) * 1024);
        f32x16 O1[4], O2[4];
#pragma unroll
        for (int d = 0; d < 4; ++d) { O1[d] = zero16(); O2[d] = zero16(); }
        float m1 = 0.f, m2 = 0.f, l1 = 0.f, l2 = 0.f;
        const char* Qw = Qs + wave * 8192 + lane * 16;
        for (int kt = 0; kt < nkt; ++kt) {
            const int k0 = kt * 32, buf = kt & 1;
            asm volatile("s_waitcnt vmcnt(0)" ::: "memory");
            __syncthreads();
            if (kt + 1 < nkt) {
                const char* kn = ksrc + (size_t)(k0 + 32) * 4096; const char* vn = vsrc + (k0 + 32) * 2;
                char* kd = Kbuf + (buf ^ 1) * 8192 + (wave * 2) * 1024; char* vd = Vbuf + (buf ^ 1) * 8192 + (wave * 2) * 1024;
                dma16(kn, k_off0, kd);
                dma16(kn + 8 * 4096, k_off1, kd + 1024);
                dma16(vn, v_off, vd);
                dma16(vn + 16 * SEQ * 2, v_off, vd + 1024);
            }
            if (k0 <= qlo + 31) {
                const bool diag = (k0 + 31 > qlo);
                const char* Kb = Kbuf + buf * 8192; const char* Vb = Vbuf + buf * 8192;
                attn_tile(Kb, Vb, Qw, O1, O2, m1, l1, m2, l2, diag, kt == 0, k0, qidx, r, half);
            }
        }
        l1 += sxf<32>(l1, half); l2 += sxf<32>(l2, half);
        const float i1 = __builtin_amdgcn_rcpf(l1), i2 = lam * __builtin_amdgcn_rcpf(l2);
        float ss = 0.f;
#pragma unroll
        for (int d = 0; d < 4; ++d)
#pragma unroll
            for (int i = 0; i < 16; ++i) { const float v = O1[d][i] * i1 - O2[d][i] * i2; O1[d][i] = v; ss += v * v; }
        ss += sxf<32>(ss, half);
        const float rn = rsqrtf(ss * (1.f / 128.f) + 1e-6f) * (1.f - LAMBDA_INIT);
        u16* orow = (u16*)(p.ws + WS_HN) + (size_t)(tokbase + qidx) * 1024 + h * 128;
        const float* gn = p.diff_norm + h * 128;
        int half_e = half; asm volatile("" : "+v"(half_e));
        f32x4 gv[16];
#pragma unroll
        for (int i = 0; i < 16; ++i) gv[i] = *(const f32x4*)(gn + 32 * (i >> 2) + 8 * (i & 3) + 4 * half_e);
#pragma unroll
        for (int d = 0; d < 4; ++d)
#pragma unroll
            for (int g = 0; g < 4; ++g) {
                const int c0 = 32 * d + 8 * g + 4 * half_e;
                const f32x4 gq = gv[4 * d + g];
                *(u32x2*)(orow + c0) = u32x2{pk2(O1[d][4 * g] * rn * gq.x, O1[d][4 * g + 1] * rn * gq.y), pk2(O1[d][4 * g + 2] * rn * gq.z, O1[d][4 * g + 3] * rn * gq.w)};
            }
    }
}
extern __shared__ __attribute__((aligned(16))) char dyn_smem[];
constexpr int MEGA_LDS_WORK = G_LDS_BYTES;
constexpr int MEGA_LDS_BYTES = MEGA_LDS_WORK + 16;

__global__ void __launch_bounds__(256, 2) mega_fwd(Params pk) {
    Params p = pk; p.wv = __builtin_amdgcn_readfirstlane((int)(threadIdx.x >> 6));
    volatile LAS unsigned* st = (volatile LAS unsigned*)(dyn_smem + MEGA_LDS_WORK);
    if (threadIdx.x == 0) { st[0] = 0u; st[1] = 0u; st[2] = 0u; st[3] = 0u; }
    __syncthreads();
    XcdBarrier bar = xcd_barrier_post((unsigned*)(p.ws + WS_BAR), st, threadIdx.x == 0);
#define XBAR() xcd_barrier(bar, opaque_tid(p) == 0)
    const int bid = blockIdx.x, nb = gridDim.x;
    const u16* hn = (const u16*)(p.ws + WS_HN);
    phase_prep_a(p, bid, nb);
    asm volatile("; PHASE_END 1");
    XBAR();
    gemm_phase<EPI_GLA_IN>(p, hn, (const u16*)(p.ws + WS_WGIN), 3072, nullptr, dyn_smem, bid, nb);
    gla_glr_phase(p, dyn_smem, (bid + nb / 2) % nb, nb);
    asm volatile("; PHASE_END 2");
    XBAR();
    gla_pass1(p, dyn_smem, bid, nb);
    asm volatile("; PHASE_END 3");
    XBAR();
    if (nb >= 256) { if (bid < 128) gla_scan(p, bid, 128); else { phase_prep_b(p, bid - 128, nb - 128); phase_tabconv(p, 0, bid - 128, nb - 128); phase_tabconv(p, 1, bid - 128, nb - 128); } }
    else { gla_scan(p, bid, nb); phase_prep_b(p, bid, nb); phase_tabconv(p, 0, bid, nb); phase_tabconv(p, 1, bid, nb); }
    asm volatile("; PHASE_END 4");
    XBAR();
    gla_pass3(p, dyn_smem, bid, nb);
    asm volatile("; PHASE_END 5");
    XBAR();
    gemm_phase<EPI_RESID>(p, hn, (const u16*)(p.ws + WS_WGOUT), 1024, p.x, dyn_smem, bid, nb);
    asm volatile("; PHASE_END 6");
    XBAR();
    phase_rmsnorm(p, p.norm_ffn, bid, nb);
    asm volatile("; PHASE_END 7");
    XBAR();
    peer_query_phase(p, 0, dyn_smem, bid, nb);
    asm volatile("; PHASE_END 8");
    XBAR();
    peer_u_phase(p, 0, dyn_smem, bid, nb);
    XBAR();
    peer_v_phase<false>(p, 0, p.norm_mix + 1024, dyn_smem, bid, nb);
    asm volatile("; PHASE_END 9");
    XBAR();
    gemm_phase<EPI_DIFF_IN>(p, hn, (const u16*)(p.ws + WS_WDIN), 3072, nullptr, dyn_smem, bid, nb);
    asm volatile("; PHASE_END 10");
    XBAR();
    attn_phase(p, dyn_smem, bid, nb);
    asm volatile("; PHASE_END 11");
    XBAR();
    gemm_phase<EPI_RESID>(p, hn, (const u16*)(p.ws + WS_WDOUT), 1024, p.out, dyn_smem, bid, nb);
    asm volatile("; PHASE_END 12");
    XBAR();
    phase_rmsnorm(p, p.norm_ffn + 1024, bid, nb);
    asm volatile("; PHASE_END 13");
    XBAR();
    peer_query_phase(p, 1, dyn_smem, bid, nb);
    asm volatile("; PHASE_END 14");
    XBAR();
    peer_u_phase(p, 1, dyn_smem, bid, nb);
    XBAR();
    peer_v_phase<true>(p, 1, p.norm_final, dyn_smem, bid, nb);
}

extern "C" void kernel_launch(void* const* d_in, const int* in_sizes, int n_in, void* d_out, int out_size, void* d_ws, size_t ws_size, hipStream_t stream) {
    Params p{};
    p.x = (const float*)d_in[0]; p.pos = (const int*)d_in[1]; p.norm_mix = (const float*)d_in[2]; p.norm_ffn = (const float*)d_in[3]; p.norm_final = (const float*)d_in[4];
    p.gla_w_in = (const float*)d_in[5]; p.gla_wgu = (const float*)d_in[6]; p.gla_bg = (const float*)d_in[7]; p.gla_norm = (const float*)d_in[8]; p.gla_w_out = (const float*)d_in[9];
    p.diff_w_in = (const float*)d_in[10]; p.lq1 = (const float*)d_in[11]; p.lk1 = (const float*)d_in[12]; p.lq2 = (const float*)d_in[13]; p.lk2 = (const float*)d_in[14];
    p.diff_norm = (const float*)d_in[15]; p.diff_w_out = (const float*)d_in[16];
    p.peer_wq = (const float*)d_in[17]; p.peer_sk = (const float*)d_in[18]; p.peer_u = (const float*)d_in[19]; p.peer_v = (const float*)d_in[20];
    p.out = (float*)d_out; p.ws = (char*)d_ws;
    static int grid = 0;
    if (grid == 0) {
        int dev = 0, cus = 0, per_cu = 0;
        hipGetDevice(&dev);
        hipDeviceGetAttribute(&cus, hipDeviceAttributeMultiprocessorCount, dev);
        hipFuncSetAttribute((const void*)mega_fwd, hipFuncAttributeMaxDynamicSharedMemorySize, MEGA_LDS_BYTES);
        hipOccupancyMaxActiveBlocksPerMultiprocessor(&per_cu, (const void*)mega_fwd, 256, MEGA_LDS_BYTES);
        (void)hipGetLastError();
        if (per_cu < 1) per_cu = 1;
        if (cus < 1) cus = 256;
        grid = cus * (per_cu < 2 ? per_cu : 2);
    }
    hipMemsetAsync((char*)d_ws + WS_BAR, 0, XCD_BAR_WORDS * sizeof(unsigned), stream);
    mega_fwd<<<grid, 256, MEGA_LDS_BYTES, stream>>>(p);
}
```

```cpp
#include <hip/hip_runtime.h>
#include <stdint.h>

#define DI __device__ __forceinline__
typedef unsigned short u16;
typedef __attribute__((ext_vector_type(8))) short bf16x8;
typedef __attribute__((ext_vector_type(16))) float f32x16;
typedef __attribute__((ext_vector_type(2))) __bf16 bf2_t;
typedef __attribute__((ext_vector_type(4))) unsigned u32x4;
typedef __attribute__((ext_vector_type(2))) unsigned u32x2;
typedef __attribute__((ext_vector_type(4))) float f32x4;
#define MFMA32(a, b, c) __builtin_amdgcn_mfma_f32_32x32x16_bf16((a), (b), (c), 0, 0, 0)

constexpr int T_TOK = 32768, SEQ = 16384, DM = 1024;
constexpr int GLA_NPAD = 3328;
constexpr int NTHR = 256;

constexpr size_t MB = 1024ull * 1024ull;
constexpr size_t WS_BAR    = 0;
constexpr size_t WS_ROPE   = 64 * 1024;
constexpr size_t WS_WGIN   = WS_ROPE + 2 * MB;
constexpr size_t WS_WGOUT  = WS_WGIN + (size_t)GLA_NPAD * 1024 * 2;
constexpr size_t WS_WDIN   = WS_WGOUT + 2 * MB;
constexpr size_t WS_WDOUT  = WS_WDIN + 6 * MB;
constexpr size_t WS_WPQ    = WS_WDOUT + 2 * MB;
constexpr size_t WS_SK     = WS_WPQ + 8 * MB;
constexpr size_t WS_GLR    = WS_SK + 1 * MB;
constexpr size_t WS_DEC    = WS_GLR + 2 * MB;
constexpr size_t WS_TAB    = WS_DEC + 1 * MB;
constexpr size_t WS_HN     = WS_TAB + 64 * MB;
constexpr size_t WS_PROJ   = WS_HN + 64 * MB;
constexpr size_t WS_KV     = WS_PROJ + 192 * MB;
constexpr size_t WS_END    = WS_KV + 128 * MB;
static_assert(WS_END <= 512 * MB, "workspace overflow");
constexpr size_t WS_VT     = WS_PROJ + 128 * MB;
constexpr size_t WS_IDX    = WS_KV;
constexpr size_t WS_GATE   = WS_KV + 16 * MB;
constexpr size_t WS_DOT    = WS_KV + 32 * MB;

struct Params {
    const float* x; const int* pos; const float* norm_mix; const float* norm_ffn; const float* norm_final;
    const float* gla_w_in; const float* gla_wgu; const float* gla_bg; const float* gla_norm; const float* gla_w_out;
    const float* diff_w_in; const float* lq1; const float* lk1; const float* lq2; const float* lk2;
    const float* diff_norm; const float* diff_w_out;
    const float* peer_wq; const float* peer_sk; const float* peer_u; const float* peer_v;
    float* out; char* ws;
    int wv; int pad_;
};

DI int opaque_tid(const Params& p) { int l; asm volatile("v_mbcnt_lo_u32_b32 %0, -1, 0\n\tv_mbcnt_hi_u32_b32 %0, -1, %0" : "=v"(l)); return (p.wv << 6) | l; }
DI unsigned pk2(float a, float b) { bf2_t v = {(__bf16)a, (__bf16)b}; return __builtin_bit_cast(unsigned, v); }
DI u16 f2bf(float a) { return (u16)(pk2(a, 0.f) & 0xffffu); }
DI float bflo(unsigned w) { return __uint_as_float(w << 16); }
DI float bfhi(unsigned w) { return __uint_as_float(w & 0xffff0000u); }
DI float bf2f(u16 h) { return __uint_as_float(((unsigned)h) << 16); }
DI int xcd_unit(int j, int bid, int nb) { return ((nb & 7) == 0) ? j * nb + (bid & 7) * (nb >> 3) + (bid >> 3) : j * nb + bid; }
DI int crow(int i, int half) { return (i & 3) + 8 * (i >> 2) + 4 * half; }
template <int MASK> DI unsigned sxu(unsigned v, int half) {
    if constexpr (MASK < 32) return (unsigned)__builtin_amdgcn_ds_swizzle((int)v, (MASK << 10) | 0x1f);
    else { auto r = __builtin_amdgcn_permlane32_swap(v, v, false, false); return half ? r[0] : r[1]; }
}
template <int MASK> DI float sxf(float v, int half) { return __uint_as_float(sxu<MASK>(__float_as_uint(v), half)); }
template <int MASK> DI int sxi(int v, int half) { return (int)sxu<MASK>((unsigned)v, half); }
DI float wave_sum(float v, int half) { v += sxf<32>(v, half); v += sxf<16>(v, half); v += sxf<8>(v, half); v += sxf<4>(v, half); v += sxf<2>(v, half); v += sxf<1>(v, half); return v; }
DI f32x16 zero16() { f32x16 z; for (int i = 0; i < 16; ++i) z[i] = 0.f; return z; }
DI bf16x8 lds_frag(const char* p) { return *(const bf16x8*)p; }
DI bf16x8 lds_frag2(const char* p0, const char* p1) {
    u32x2 a = *(const u32x2*)p0, b = *(const u32x2*)p1; u32x4 r = {a.x, a.y, b.x, b.y}; return __builtin_bit_cast(bf16x8, r);
}
DI bf16x8 pack8(const f32x16& x, int s) {
    u32x4 r = {pk2(x[8 * s], x[8 * s + 1]), pk2(x[8 * s + 2], x[8 * s + 3]), pk2(x[8 * s + 4], x[8 * s + 5]), pk2(x[8 * s + 6], x[8 * s + 7])};
    return __builtin_bit_cast(bf16x8, r);
}
#define XB_TMO      128
#define XB_XCNT(j)  (256  + 64 * (j))
#define XB_XSUB(j)  (1280 + 64 * (j))
#define XB_XGEN(j)  (2304 + 64 * (j))
#define XB_TOP      3328
#define XB_TOPGEN   3392
#define XCD_BAR_WORDS 3456
#define XB_SPIN_CAP (1u << 18)
#define LAS __attribute__((address_space(3)))

__device__ __forceinline__ unsigned xb_ld(unsigned* p)              { return __hip_atomic_load(p, __ATOMIC_RELAXED, __HIP_MEMORY_SCOPE_AGENT); }
__device__ __forceinline__ unsigned xb_add(unsigned* p, unsigned v) { return __hip_atomic_fetch_add(p, v, __ATOMIC_RELAXED, __HIP_MEMORY_SCOPE_AGENT); }
__device__ __forceinline__ unsigned xb_xcc_id() { return (unsigned)__builtin_amdgcn_s_getreg((3 << 11) | 20) & 0xFu; }
#define XB_SPIN(cond, bar) do { unsigned _sp = 0; while (cond) { __builtin_amdgcn_s_sleep(1); \
    if ((++_sp & 255u) == 0u) { if (xb_ld(&(bar)[XB_TMO])) break; if (_sp > XB_SPIN_CAP) { atomicAdd(&(bar)[XB_TMO], 1u); break; } } } } while (0)

struct XcdBarrier {
    unsigned* bar; unsigned x;
    volatile LAS unsigned* st;
};

__device__ __forceinline__ XcdBarrier xcd_barrier_post(unsigned* bar, volatile LAS unsigned* st, bool t0) {
    XcdBarrier b; b.bar = bar; b.x = xb_xcc_id(); b.st = st;
    if (t0) (void)xb_add(&bar[XB_XCNT(b.x)], 1u);
    return b;
}
__device__ __forceinline__ void xcd_barrier_complete(unsigned* bar, unsigned x, unsigned& nloc, unsigned& nx) {
    const unsigned G = gridDim.x * gridDim.y * gridDim.z;
    unsigned sum, cnt, mine, sp = 0u;
    for (;;) {
        sum = 0u; cnt = 0u; mine = 0u;
#pragma unroll
        for (unsigned j = 0; j < 16; ++j) { const unsigned c = xb_ld(&bar[XB_XCNT(j)]); sum += c; cnt += (c > 0u) ? 1u : 0u; mine = (j == x) ? c : mine; }
        if (sum == G) break;
        __builtin_amdgcn_s_sleep(1);
        if ((++sp & 255u) == 0u) { if (xb_ld(&bar[XB_TMO])) break; if (sp > XB_SPIN_CAP) { atomicAdd(&bar[XB_TMO], 1u); break; } }
    }
    nloc = mine > 0u ? mine : 1u; nx = cnt > 0u ? cnt : 1u;
}

__device__ __forceinline__ void xcd_barrier(const XcdBarrier& b, bool t0) {
    asm volatile("s_waitcnt vmcnt(0)" ::: "memory");
    __syncthreads();
    if (t0) {
        unsigned* bar = b.bar;
        __builtin_amdgcn_s_waitcnt(0);
        unsigned nloc = b.st[0], nx = b.st[1];
        if (nloc == 0u) { xcd_barrier_complete(bar, b.x, nloc, nx); b.st[0] = nloc; b.st[1] = nx; }
        const unsigned old = xb_add(&bar[XB_XSUB(b.x)], 1u);
        const unsigned gen = old / nloc;
        if (old + 1u == (gen + 1u) * nloc) {
            __builtin_amdgcn_fence(__ATOMIC_RELEASE, "agent");
            asm volatile("s_waitcnt vmcnt(0)" ::: "memory");
            const unsigned og = xb_add(&bar[XB_TOP], 1u);
            const unsigned tg = og / nx;
            if (og + 1u == (tg + 1u) * nx) xb_add(&bar[XB_TOPGEN], 1u);
            else XB_SPIN(xb_ld(&bar[XB_TOPGEN]) == tg, bar);
            __builtin_amdgcn_fence(__ATOMIC_ACQUIRE, "agent");
            xb_add(&bar[XB_XGEN(b.x)], 1u);
            asm volatile("s_waitcnt vmcnt(0)" ::: "memory");
        } else {
            XB_SPIN(xb_ld(&bar[XB_XGEN(b.x)]) == gen, bar);
            __builtin_amdgcn_fence(__ATOMIC_ACQUIRE, "agent");
            asm volatile("s_waitcnt vmcnt(0)" ::: "memory");
        }
    }
    __syncthreads();
}
DI void rmsnorm_row_bf16(const float* __restrict__ src, const float* __restrict__ g, u16* __restrict__ dst, int lane) {
    const f32x4* xr = (const f32x4*)src;
    f32x4 a0 = xr[lane * 2], a1 = xr[lane * 2 + 1], b0 = xr[128 + lane * 2], b1 = xr[128 + lane * 2 + 1];
    float ss = a0.x * a0.x + a0.y * a0.y + a0.z * a0.z + a0.w * a0.w + a1.x * a1.x + a1.y * a1.y + a1.z * a1.z + a1.w * a1.w
             + b0.x * b0.x + b0.y * b0.y + b0.z * b0.z + b0.w * b0.w + b1.x * b1.x + b1.y * b1.y + b1.z * b1.z + b1.w * b1.w;
    ss = wave_sum(ss, lane >> 5);
    const float r = rsqrtf(ss * (1.f / 1024.f) + 1e-6f);
    const f32x4* gr = (const f32x4*)g;
    f32x4 g0 = gr[lane * 2], g1 = gr[lane * 2 + 1], g2 = gr[128 + lane * 2], g3 = gr[128 + lane * 2 + 1];
    u32x4 o0 = u32x4{pk2(a0.x * r * g0.x, a0.y * r * g0.y), pk2(a0.z * r * g0.z, a0.w * r * g0.w), pk2(a1.x * r * g1.x, a1.y * r * g1.y), pk2(a1.z * r * g1.z, a1.w * r * g1.w)};
    u32x4 o1 = u32x4{pk2(b0.x * r * g2.x, b0.y * r * g2.y), pk2(b0.z * r * g2.z, b0.w * r * g2.w), pk2(b1.x * r * g3.x, b1.y * r * g3.y), pk2(b1.z * r * g3.z, b1.w * r * g3.w)};
    ((u32x4*)dst)[lane] = o0;
    ((u32x4*)dst)[64 + lane] = o1;
}

DI void tconv_item(const float* __restrict__ src, u16* __restrict__ dst, int K, int N, int item, int lane) {
    const int kgroups = K >> 3;
    const int ng = item / kgroups, kg = item - ng * kgroups;
    const int n = ng * 64 + lane, k0 = kg * 8;
    float v[8];
#pragma unroll
    for (int i = 0; i < 8; ++i) v[i] = (n < N) ? src[(size_t)(k0 + i) * N + n] : 0.f;
    u32x4 o = u32x4{pk2(v[0], v[1]), pk2(v[2], v[3]), pk2(v[4], v[5]), pk2(v[6], v[7])};
    *(u32x4*)(dst + (size_t)n * K + k0) = o;
}

DI void conv8(const float* __restrict__ src, u16* __restrict__ dst, size_t i8) {
    const f32x4* s = (const f32x4*)(src + i8 * 8);
    f32x4 a = s[0], b = s[1];
    *(u32x4*)(dst + i8 * 8) = u32x4{pk2(a.x, a.y), pk2(a.z, a.w), pk2(b.x, b.y), pk2(b.z, b.w)};
}

DI void phase_prep_a(const Params& p, int bid, int nb) {
    const int wave = opaque_tid(p) >> 6, lane = opaque_tid(p) & 63;
    const int gw = bid * 4 + wave, nw = nb * 4;
    char* ws = p.ws;
    for (int t = gw; t < T_TOK; t += nw) rmsnorm_row_bf16(p.x + (size_t)t * DM, p.norm_mix, (u16*)(ws + WS_HN) + (size_t)t * DM, lane);
    const int n0 = (GLA_NPAD / 64) * 128, n1 = n0 + 16 * 128;
    for (int it = gw; it < n1; it += nw) {
        if (it < n0) tconv_item(p.gla_w_in, (u16*)(ws + WS_WGIN), 1024, 3088, it, lane);
        else         tconv_item(p.gla_w_out, (u16*)(ws + WS_WGOUT), 1024, 1024, it - n0, lane);
    }
}
DI void phase_prep_b(const Params& p, int bid, int nb) {
    const int wave = opaque_tid(p) >> 6, lane = opaque_tid(p) & 63;
    const int gw = bid * 4 + wave, nw = nb * 4;
    char* ws = p.ws;
    {
        const int n2 = 48 * 128, n3 = n2 + 16 * 128, n4 = n3 + 32 * 128, n5 = n4 + 32 * 128;
        for (int it = gw; it < n5; it += nw) {
            if (it < n2)      tconv_item(p.diff_w_in, (u16*)(ws + WS_WDIN), 1024, 3072, it, lane);
            else if (it < n3) tconv_item(p.diff_w_out, (u16*)(ws + WS_WDOUT), 1024, 1024, it - n2, lane);
            else if (it < n4) tconv_item(p.peer_wq, (u16*)(ws + WS_WPQ), 1024, 2048, it - n3, lane);
            else              tconv_item(p.peer_wq + (size_t)1024 * 2048, (u16*)(ws + WS_WPQ) + (size_t)2048 * 1024, 1024, 2048, it - n4, lane);
        }
    }
    for (int i = gw * 64 + lane; i < 65536; i += nw * 64) conv8(p.peer_sk, (u16*)(ws + WS_SK), (size_t)i);
    for (int i = gw * 64 + lane; i < T_TOK * 8; i += nw * 64) {
        const int t = i >> 3, f = i & 7;
        const float inv = exp2f(-(float)f * (18.931568569324174f / 8.f));
        const float ang = (float)p.pos[t] * inv;
        float sn, cs; sincosf(ang, &sn, &cs);
        ((float2*)(ws + WS_ROPE))[i] = make_float2(cs, sn);
    }
}

constexpr float TAB_SCALE_U = 64.f, TAB_SCALE_V = 6.f;
DI float clamp6(float a) { return fminf(fmaxf(a, -6.f), 6.f); }
DI unsigned pk8_fp4(f32x4 a, f32x4 b, float s) {
    unsigned w = 0;
    w = __builtin_amdgcn_cvt_scalef32_pk_fp4_f32(w, clamp6(a.x * s), clamp6(a.y * s), 1.0f, 0);
    w = __builtin_amdgcn_cvt_scalef32_pk_fp4_f32(w, clamp6(a.z * s), clamp6(a.w * s), 1.0f, 1);
    w = __builtin_amdgcn_cvt_scalef32_pk_fp4_f32(w, clamp6(b.x * s), clamp6(b.y * s), 1.0f, 2);
    w = __builtin_amdgcn_cvt_scalef32_pk_fp4_f32(w, clamp6(b.z * s), clamp6(b.w * s), 1.0f, 3);
    return w;
}
constexpr float TAB_SCALE_UI = 90.f;
DI unsigned pk8_i4(f32x4 a, f32x4 b, float s) {
    const float f[8] = {a.x, a.y, a.z, a.w, b.x, b.y, b.z, b.w};
    unsigned w = 0;
#pragma unroll
    for (int j = 0; j < 8; ++j) { const int q = (int)rintf(fminf(fmaxf(f[j] * s, -7.f), 7.f)); w |= ((unsigned)q & 15u) << (4 * j); }
    return w;
}
DI void phase_tabconv(const Params& p, int layer, int bid, int nb) {
    const size_t n16 = (size_t)16384 * 1024 / 16;
    const float* su = p.peer_u + (size_t)layer * 16384 * 1024;
    const float* sv = p.peer_v + (size_t)layer * 16384 * 1024;
    unsigned char* du = (unsigned char*)(p.ws + WS_TAB) + (size_t)layer * 16 * MB; unsigned char* dv = du + (size_t)16384 * 512;
    for (size_t i = (size_t)bid * NTHR + opaque_tid(p); i < n16; i += (size_t)nb * NTHR) {
        const f32x4* a = (const f32x4*)(su + i * 16); const f32x4* b = (const f32x4*)(sv + i * 16);
        const f32x4 a0 = __builtin_nontemporal_load(a), a1 = __builtin_nontemporal_load(a + 1), a2 = __builtin_nontemporal_load(a + 2), a3 = __builtin_nontemporal_load(a + 3);
        const f32x4 b0 = __builtin_nontemporal_load(b), b1 = __builtin_nontemporal_load(b + 1), b2 = __builtin_nontemporal_load(b + 2), b3 = __builtin_nontemporal_load(b + 3);
        *(u32x2*)(du + i * 8) = u32x2{pk8_i4(a0, a1, TAB_SCALE_UI), pk8_i4(a2, a3, TAB_SCALE_UI)};
        *(u32x2*)(dv + i * 8) = u32x2{pk8_fp4(b0, b1, TAB_SCALE_V), pk8_fp4(b2, b3, TAB_SCALE_V)};
    }
}

DI void phase_rmsnorm(const Params& p, const float* g, int bid, int nb) {
    const int wave = opaque_tid(p) >> 6, lane = opaque_tid(p) & 63;
    for (int t = bid * 4 + wave; t < T_TOK; t += nb * 4) rmsnorm_row_bf16(p.out + (size_t)t * DM, g, (u16*)(p.ws + WS_HN) + (size_t)t * DM, lane);
}
constexpr int G_ROW = 64;
constexpr int G_SLOT = 384 * G_ROW;
constexpr int G_LDS_BYTES = 3 * G_SLOT;
DI const char* uni_ptr(const char* p) {
    const unsigned long long v = (unsigned long long)p;
    const unsigned lo = __builtin_amdgcn_readfirstlane((unsigned)v), hi = __builtin_amdgcn_readfirstlane((unsigned)(v >> 32));
    return (const char*)(((unsigned long long)hi << 32) | lo);
}
DI void dma16(const char* ubase, unsigned voff, char* lds_wave_base) { __builtin_amdgcn_global_load_lds((const unsigned*)(uni_ptr(ubase) + voff), (unsigned*)lds_wave_base, 16, 0, 0); }

template <int WM, int WN, int BROWS = 128, int AROWS = 128>
DI void gemm_mainloop(const Params& p, const u16* __restrict__ A, int ld, const u16* __restrict__ Bt, int  , int K, char* smem, int wm0, int wn0, f32x16 (&acc)[WM][WN]) {
    static_assert((AROWS % 64) == 0 && (BROWS % 64) == 0 && ((AROWS + BROWS) == 384 || (AROWS + BROWS) == 192), "slot shape");
    constexpr int SLOT = (AROWS + BROWS) * G_ROW, NP = (AROWS + BROWS) / 64;
    const int tid = opaque_tid(p), lane = tid & 63, r = lane & 31, half = lane >> 5;
    const int wave = p.wv;
    const unsigned voff = (unsigned)(lane >> 2) * (unsigned)(ld * 2) + (unsigned)(((lane & 3) ^ ((lane >> 4) & 3)) << 4);
    const char* ab = (const char*)A + (size_t)(wave * 16) * ld * 2;
    const char* bb = (const char*)Bt + (size_t)(wave * 16) * ld * 2;
    const size_t pstep = (size_t)64 * ld * 2;
    char* dbase = smem + wave * 1024;
    constexpr int NPA = AROWS / 64, NPB = BROWS / 64;
#define G_ISSUE(kt_, slot_) do { const size_t ko_ = (size_t)(kt_) * 64; char* d_ = dbase + (slot_) * SLOT; \
        _Pragma("unroll") for (int i_ = 0; i_ < NPA; ++i_) dma16(ab + i_ * pstep + ko_, voff, d_ + i_ * 4096); \
        _Pragma("unroll") for (int i_ = 0; i_ < NPB; ++i_) dma16(bb + i_ * pstep + ko_, voff, d_ + (NPA + i_) * 4096); } while (0)
    const int nk = K >> 5;
    asm volatile("s_waitcnt vmcnt(0)\n\ts_barrier" ::: "memory");
    G_ISSUE(0, 0); G_ISSUE(1, 1); G_ISSUE(2, 2);
    const int sw = (r >> 2) & 3;
    const int fo0 = r * G_ROW + ((half ^ sw) << 4), fo1 = r * G_ROW + (((2 + half) ^ sw) << 4);
    int slot = 0;
    for (int kt = 0; kt < nk; ++kt) {
        if constexpr (NP == 6) {
            if (kt + 2 < nk)      asm volatile("s_waitcnt vmcnt(12)\n\ts_barrier" ::: "memory");
            else if (kt + 1 < nk) asm volatile("s_waitcnt vmcnt(6)\n\ts_barrier" ::: "memory");
            else                  asm volatile("s_waitcnt vmcnt(0)\n\ts_barrier" ::: "memory");
        } else {
            if (kt + 2 < nk)      asm volatile("s_waitcnt vmcnt(6)\n\ts_barrier" ::: "memory");
            else if (kt + 1 < nk) asm volatile("s_waitcnt vmcnt(3)\n\ts_barrier" ::: "memory");
            else                  asm volatile("s_waitcnt vmcnt(0)\n\ts_barrier" ::: "memory");
        }
        const char* As = smem + slot * SLOT; const char* Bs = As + AROWS * G_ROW;
        bf16x8 af[2][WM], bfr[2][WN];
#pragma unroll
        for (int ks = 0; ks < 2; ++ks) {
            const int fo = ks ? fo1 : fo0;
#pragma unroll
            for (int i = 0; i < WM; ++i) af[ks][i] = lds_frag(As + (wm0 + 32 * i) * G_ROW + fo);
#pragma unroll
            for (int j = 0; j < WN; ++j) bfr[ks][j] = lds_frag(Bs + (wn0 + 32 * j) * G_ROW + fo);
        }
        asm volatile("s_waitcnt lgkmcnt(0)\n\ts_barrier" ::: "memory");
        if (kt + 3 < nk) G_ISSUE(kt + 3, slot);
#pragma unroll
        for (int ks = 0; ks < 2; ++ks)
#pragma unroll
            for (int i = 0; i < WM; ++i)
#pragma unroll
                for (int j = 0; j < WN; ++j) acc[i][j] = MFMA32(af[ks][i], bfr[ks][j], acc[i][j]);
        slot = (slot == 2) ? 0 : slot + 1;
    }
#undef G_ISSUE
}

enum { EPI_GLA_IN = 0, EPI_RESID = 1, EPI_DIFF_IN = 2 };

template <int EPI, int BN = 256>
DI void gemm_phase(const Params& p, const u16* A, const u16* Bt, int N, const float* resid, char* smem, int bid, int nb) {
    constexpr int TN = BN / 64;
    const int ntn = N / BN, ntm = T_TOK / 128;
    const int tid = opaque_tid(p), wave = tid >> 6, lane = tid & 63, r = lane & 31, half = lane >> 5;
    const int wm0 = (wave >> 1) * 64, wn0 = (wave & 1) * (BN / 2);
    for (int j = 0; j * nb < ntn * ntm; ++j) {
        const int u = xcd_unit(j, bid, nb);
        if (u >= ntn * ntm) continue;
        const int mt = u / ntn, nt = u - mt * ntn;
        const int m0 = mt * 128, n0 = nt * BN;
        f32x16 acc[2][TN];
#pragma unroll
        for (int i = 0; i < 2; ++i)
#pragma unroll
            for (int j = 0; j < TN; ++j) acc[i][j] = zero16();
        gemm_mainloop<2, TN, BN>(p, A + (size_t)m0 * 1024, 1024, Bt + (size_t)n0 * 1024, 1024, 1024, smem, wm0, wn0, acc);
        if constexpr (EPI == EPI_RESID) {
#pragma unroll
            for (int ti = 0; ti < 2; ++ti)
#pragma unroll
                for (int tj0 = 0; tj0 < TN; tj0 += 2) {
                    float rv[2][16];
#pragma unroll
                    for (int tt = 0; tt < 2; ++tt)
#pragma unroll
                        for (int i = 0; i < 16; ++i) rv[tt][i] = resid[(size_t)(m0 + wm0 + 32 * ti + crow(i, half)) * 1024 + n0 + wn0 + 32 * (tj0 + tt) + r];
#pragma unroll
                    for (int tt = 0; tt < 2; ++tt)
#pragma unroll
                        for (int i = 0; i < 16; ++i) p.out[(size_t)(m0 + wm0 + 32 * ti + crow(i, half)) * 1024 + n0 + wn0 + 32 * (tj0 + tt) + r] = rv[tt][i] + acc[ti][tj0 + tt][i];
                }
        } else
#pragma unroll
        for (int ti = 0; ti < 2; ++ti)
#pragma unroll
            for (int tj = 0; tj < TN; ++tj) {
                const int col = n0 + wn0 + 32 * tj + r;
                const int rowb = m0 + wm0 + 32 * ti;
                if constexpr (EPI == EPI_GLA_IN) {
                    u16* o = (u16*)(p.ws + WS_PROJ);
#pragma unroll
                    for (int i = 0; i < 16; ++i) o[(size_t)(rowb + crow(i, half)) * 3072 + col] = f2bf(acc[ti][tj][i]);
                } else if constexpr (EPI == EPI_RESID) {
#pragma unroll
                    for (int i = 0; i < 16; ++i) {
                        const size_t off = (size_t)(rowb + crow(i, half)) * 1024 + col;
                        p.out[off] = resid[off] + acc[ti][tj][i];
                    }
                } else if constexpr (EPI == EPI_DIFF_IN) {
                    if (col < 2048) {
                        const int c64 = col & 63;
                        const float qs = (col < 1024) ? 0.125f * 1.4426950408889634f : 1.0f;
                        const float2* cst = (const float2*)(p.ws + WS_ROPE);
                        u16* o = (u16*)(p.ws + WS_PROJ);
                        const bool rot = ((32 * tj) & 63) == 0;
                        float2 csr[16];
                        if (rot) {
#pragma unroll
                            for (int i = 0; i < 16; ++i) csr[i] = cst[(size_t)(rowb + crow(i, half)) * 8 + (c64 & 7)];
                        }
#pragma unroll
                        for (int i = 0; i < 16; ++i) {
                            const int row = rowb + crow(i, half);
                            float v = acc[ti][tj][i];
                            if (rot) {
                                const float pv = sxf<8>(v, half);
                                const float2 cs = csr[i];
                                if (c64 < 16) v = (c64 < 8) ? (v * cs.x - pv * cs.y) : (v * cs.x + pv * cs.y);
                            }
                            o[(size_t)row * 2048 + col] = f2bf(v * qs);
                        }
                    } else {
                        const int hv = (col - 2048) >> 7, dv = (col - 2048) & 127;
                        const int b = rowb >> 14, s0 = rowb & (SEQ - 1);
                        u16* o = (u16*)(p.ws + WS_VT) + ((size_t)(b * 8 + hv) * 128 + dv) * SEQ + s0;
#pragma unroll
                        for (int g = 0; g < 4; ++g) {
                            u32x2 w = {pk2(acc[ti][tj][4 * g], acc[ti][tj][4 * g + 1]), pk2(acc[ti][tj][4 * g + 2], acc[ti][tj][4 * g + 3])};
                            *(u32x2*)(o + 16 * (g >> 1) + 8 * half + 4 * (g & 1)) = w;
                        }
                    }
                }
            }
    }
}
namespace pg8 {
#define PG8_LAS __attribute__((address_space(3)))
typedef unsigned short bf16_t;
typedef short bf16x8 __attribute__((ext_vector_type(8)));
typedef float f32x4 __attribute__((ext_vector_type(4)));
typedef unsigned u32x4 __attribute__((ext_vector_type(4)));
constexpr int BM = 256, BK = 64, HALF = 128, HTB = HALF * BK * 2  , STAGE_BYTES = 8 * HTB, NXCD = 8, WGM = 8;

__host__ __device__ __forceinline__ int lds_byte(int r, int c) { const int st = (r >> 4) * 2 + (c >> 5), rr = r & 15, cc = c & 31, ob = rr * 64 + cc * 2; return st * 1024 + (ob ^ (((ob >> 9) & 1) << 5)); }
__host__ __device__ __forceinline__ void stage_rc(int b, int& R, int& C) { const int st = b / 1024, sb = b % 1024, swz = sb ^ (((sb >> 9) & 1) << 5); R = (st >> 1) * 16 + swz / 64; C = (st & 1) * 32 + (swz % 64) / 2; }
__host__ __device__ __forceinline__ int perm32(int rho) { const int n = rho >> 4, i = rho & 15; return 8 * (i >> 2) + 4 * n + (i & 3); }

struct Unit { int pm, pn; };
struct Gemm { const bf16_t* A; const bf16_t* Bt; int M, N, K; };

struct StaticOrder {
    int nM, nN, nwg, G, c;
    __host__ __device__ void init(int M, int N, int G_, int c_) { nM = M / BM; nN = N / BM; nwg = nM * nN; G = G_; c = c_; }
    __host__ __device__ bool next(int i, Unit& u) const {
        const long L = (long)i * G + c; if (L >= nwg) return false;
        int wgid = (int)L; { const int q = nwg / NXCD, r = nwg % NXCD, xcd = wgid % NXCD, off = wgid / NXCD; wgid = (xcd < r ? xcd * (q + 1) : r * (q + 1) + (xcd - r) * q) + off; }
        const int nig = WGM * nN, gid = wgid / nig, fm = gid * WGM, gsz = (nM - fm) < WGM ? (nM - fm) : WGM;
        u.pm = fm + ((wgid % nig) % gsz); u.pn = (wgid % nig) / gsz; return true;
    }
    __device__ __forceinline__ void a_ready(const Unit&) const {}
    __device__ __forceinline__ void done(const Unit&) const {}
};
template <class Epi, class Sched>
__device__ __forceinline__ void gemm_phase(PG8_LAS unsigned char* lds, const Gemm g, const Sched& S, const Epi& E, const int tid) {
    const int wid = __builtin_amdgcn_readfirstlane(tid >> 6), lane = tid & 63, wr = wid >> 2, wc = wid & 3, fr = lane & 15, fq = lane >> 4;
    const int K = g.K, nt = K / BK;
    unsigned voffA[2], voffB[2];
#pragma unroll
    for (int i = 0; i < 2; ++i) { int R, C; stage_rc(tid * 16 + i * 8192, R, C); const int Rb = Epi::PERM ? ((R & ~31) + perm32(R & 31)) : R;
        voffA[i] = (unsigned)(R * K + C) * 2u; voffB[i] = (unsigned)(Rb * K + C) * 2u; }
    const size_t kstep = (size_t)(BK * 2);
    const size_t hstep = (size_t)HALF * K * 2;
    const size_t tstep = 2 * hstep;
    const unsigned ldsw = (unsigned)wid * 1024u;
    const int aoff = lds_byte(wr * 64 + fr, fq * 8), boff = lds_byte(wc * 32 + fr, fq * 8);
#define PG8_SA(b, h) (((b) * 2 + (h)) * HTB)
#define PG8_SB(b, h) ((4 + (b) * 2 + (h)) * HTB)
#define PG8_STAGE(bufoff, gbase, voff) do { _Pragma("unroll") for (int _i = 0; _i < 2; ++_i) \
        __builtin_amdgcn_global_load_lds((const unsigned*)((const char*)(gbase) + (voff)[_i]), (PG8_LAS unsigned*)(lds + (bufoff) + ldsw + _i * 8192), 16, 0, 0); } while (0)
#define PG8_LDA(dst, b, h) do { _Pragma("unroll") for (int m = 0; m < 4; ++m) _Pragma("unroll") for (int k = 0; k < 2; ++k) dst[m][k] = *(const PG8_LAS bf16x8*)(lds + PG8_SA(b, h) + aoff + m * 2048 + k * 1024); } while (0)
#define PG8_LDB(dst, b, h) do { _Pragma("unroll") for (int n = 0; n < 2; ++n) _Pragma("unroll") for (int k = 0; k < 2; ++k) dst[n][k] = *(const PG8_LAS bf16x8*)(lds + PG8_SB(b, h) + boff + n * 2048 + k * 1024); } while (0)
#define PG8_MMA(ai, bj, At, Bt) do { __builtin_amdgcn_s_setprio(1); _Pragma("unroll") for (int m = 0; m < 4; ++m) _Pragma("unroll") for (int n = 0; n < 2; ++n) _Pragma("unroll") for (int k = 0; k < 2; ++k) \
        acc[ai][bj][m][n] = __builtin_amdgcn_mfma_f32_16x16x32_bf16(Bt[n][k], At[m][k], acc[ai][bj][m][n], 0, 0, 0); __builtin_amdgcn_s_setprio(0); } while (0)
#define PG8_WAIT_V(n) asm volatile("s_waitcnt vmcnt(" #n ")" ::: "memory")
#define PG8_WAIT_L(n) asm volatile("s_waitcnt lgkmcnt(" #n ")" ::: "memory")
#define PG8_BAR __builtin_amdgcn_s_barrier()
#define PG8_SCHED __builtin_amdgcn_sched_barrier(0)
    Unit cur, nxt; int ui = 0;
    if (!S.next(0, cur)) return;
    f32x4 acc[2][2][4][2];
#pragma unroll
    for (int a = 0; a < 2; ++a)
#pragma unroll
        for (int b = 0; b < 2; ++b)
#pragma unroll
            for (int m = 0; m < 4; ++m)
#pragma unroll
                for (int n = 0; n < 2; ++n) acc[a][b][m][n] = (f32x4){0.f, 0.f, 0.f, 0.f};
    bf16x8 At[4][2], B0[2][2], B1[2][2];
    const char* cA = (const char*)g.A + (size_t)cur.pm * tstep; const char* cB = (const char*)g.Bt + (size_t)cur.pn * tstep;
    S.a_ready(cur);
    PG8_STAGE(PG8_SB(0, 0), cB, voffB); PG8_STAGE(PG8_SA(0, 0), cA, voffA); PG8_STAGE(PG8_SB(0, 1), cB + hstep, voffB); PG8_STAGE(PG8_SA(0, 1), cA + hstep, voffA);
    if (wr == 1) PG8_BAR;
    PG8_WAIT_V(4); PG8_BAR;
    PG8_STAGE(PG8_SB(1, 0), cB + kstep, voffB); PG8_STAGE(PG8_SA(1, 0), cA + kstep, voffA); PG8_STAGE(PG8_SB(1, 1), cB + hstep + kstep, voffB);
    PG8_WAIT_V(6); PG8_BAR;
    for (;;) {
        const bool has_next = S.next(ui + 1, nxt);
        const char* nA = has_next ? (const char*)g.A + (size_t)nxt.pm * tstep : cA; const char* nB = has_next ? (const char*)g.Bt + (size_t)nxt.pn * tstep : cB;
        for (int t = 0; t < nt; t += 2) {
            const bool last = (t == nt - 2);
            const char* a1 = cA + (size_t)(t + 1) * kstep;
            const char* a2 = last ? nA : cA + (size_t)(t + 2) * kstep; const char* b2 = last ? nB : cB + (size_t)(t + 2) * kstep;
            const char* a3 = a2 + kstep; const char* b3 = b2 + kstep;
            if (last && has_next) S.a_ready(nxt);
            PG8_LDB(B0, 0, 0); PG8_SCHED; PG8_LDA(At, 0, 0); PG8_STAGE(PG8_SA(1, 1), a1 + hstep, voffA);
            PG8_WAIT_L(8); PG8_BAR; PG8_WAIT_L(0); PG8_MMA(0, 0, At, B0); PG8_BAR; PG8_SCHED;
            PG8_LDB(B1, 0, 1); PG8_STAGE(PG8_SB(0, 0), b2, voffB);
            PG8_BAR; PG8_WAIT_L(0); PG8_MMA(0, 1, At, B1); PG8_BAR;
            PG8_LDA(At, 0, 1); PG8_STAGE(PG8_SA(0, 0), a2, voffA);
            PG8_BAR; PG8_WAIT_L(0); PG8_MMA(1, 0, At, B0); PG8_BAR; PG8_SCHED;
            PG8_STAGE(PG8_SB(0, 1), b2 + hstep, voffB);
            PG8_WAIT_V(6); PG8_BAR; PG8_MMA(1, 1, At, B1); PG8_BAR;
            PG8_LDB(B0, 1, 0); PG8_SCHED; PG8_LDA(At, 1, 0); PG8_STAGE(PG8_SA(0, 1), a2 + hstep, voffA);
            PG8_WAIT_L(8); PG8_BAR; PG8_WAIT_L(0); PG8_MMA(0, 0, At, B0); PG8_BAR; PG8_SCHED;
            PG8_LDB(B1, 1, 1); PG8_STAGE(PG8_SB(1, 0), b3, voffB);
            PG8_BAR; PG8_WAIT_L(0); PG8_MMA(0, 1, At, B1); PG8_BAR;
            PG8_LDA(At, 1, 1); PG8_STAGE(PG8_SA(1, 0), a3, voffA);
            PG8_BAR; PG8_WAIT_L(0); PG8_MMA(1, 0, At, B0); PG8_BAR; PG8_SCHED;
            PG8_STAGE(PG8_SB(1, 1), b3 + hstep, voffB);
            PG8_WAIT_V(6); PG8_BAR; PG8_MMA(1, 1, At, B1); PG8_BAR;
        }
        if constexpr (!Epi::AFTER_DRAIN) { E(acc, cur, wr, wc, fr, fq); S.done(cur); }
        if (!has_next) break;
#pragma unroll
        for (int a = 0; a < 2; ++a)
#pragma unroll
            for (int b = 0; b < 2; ++b)
#pragma unroll
                for (int m = 0; m < 4; ++m)
#pragma unroll
                    for (int n = 0; n < 2; ++n) acc[a][b][m][n] = (f32x4){0.f, 0.f, 0.f, 0.f};
        cur = nxt; cA = nA; cB = nB; ++ui;
    }
    PG8_WAIT_V(0);
    if (wr == 0) PG8_BAR;
    PG8_BAR;
    if constexpr (Epi::AFTER_DRAIN) { E.fused(acc, cur, wr, wc, fr, fq, lds, wid, lane); S.done(cur); }
#undef PG8_SA
#undef PG8_SB
#undef PG8_STAGE
#undef PG8_LDA
#undef PG8_LDB
#undef PG8_MMA
#undef PG8_WAIT_V
#undef PG8_WAIT_L
#undef PG8_BAR
#undef PG8_SCHED
}
}

DI int opaque_tid8(const Params& p) { int l; asm volatile("v_mbcnt_lo_u32_b32 %0, -1, 0\n\tv_mbcnt_hi_u32_b32 %0, -1, %0" : "=v"(l)); return (p.pad_ << 6) | l; }
struct EpiProjBf16 {
    static constexpr bool PERM = true, AFTER_DRAIN = false;
    u16* O; int ldc;
    DI void operator()(const pg8::f32x4 (&acc)[2][2][4][2], const pg8::Unit& u, int wr, int wc, int fr, int fq) const {
        const int row0 = u.pm * 256 + wr * 64 + fr, col0 = u.pn * 256 + wc * 32 + 8 * fq;
#pragma unroll
        for (int ai = 0; ai < 2; ++ai)
#pragma unroll
            for (int m = 0; m < 4; ++m) {
                u16* rowp = O + (size_t)(row0 + ai * 128 + m * 16) * ldc + col0;
#pragma unroll
                for (int bj = 0; bj < 2; ++bj) {
                    const pg8::f32x4 v0 = acc[ai][bj][m][0], v1 = acc[ai][bj][m][1];
                    *(u32x4*)(rowp + bj * 128) = u32x4{pk2(v0[0], v0[1]), pk2(v0[2], v0[3]), pk2(v1[0], v1[1]), pk2(v1[2], v1[3])};
                }
            }
    }
};
struct EpiResid8 {
    static constexpr bool PERM = false, AFTER_DRAIN = false;
    const float* resid; float* out;
    DI void operator()(const pg8::f32x4 (&acc)[2][2][4][2], const pg8::Unit& u, int wr, int wc, int fr, int fq) const {
        const int row0 = u.pm * 256 + wr * 64 + fr, col0 = u.pn * 256 + wc * 32 + 4 * fq;
#pragma unroll
        for (int ai = 0; ai < 2; ++ai)
#pragma unroll
            for (int mp = 0; mp < 2; ++mp) {
                pg8::f32x4 rv[2][2][2];
#pragma unroll
                for (int mm = 0; mm < 2; ++mm)
#pragma unroll
                    for (int bj = 0; bj < 2; ++bj)
#pragma unroll
                        for (int n = 0; n < 2; ++n) rv[mm][bj][n] = *(const pg8::f32x4*)(resid + (size_t)(row0 + ai * 128 + (2 * mp + mm) * 16) * 1024 + col0 + bj * 128 + n * 16);
#pragma unroll
                for (int mm = 0; mm < 2; ++mm)
#pragma unroll
                    for (int bj = 0; bj < 2; ++bj)
#pragma unroll
                        for (int n = 0; n < 2; ++n) *(pg8::f32x4*)(out + (size_t)(row0 + ai * 128 + (2 * mp + mm) * 16) * 1024 + col0 + bj * 128 + n * 16) = rv[mm][bj][n] + acc[ai][bj][2 * mp + mm][n];
            }
    }
};
struct EpiDiffIn8 {
    static constexpr bool PERM = true, AFTER_DRAIN = false;
    char* ws;
    DI void operator()(const pg8::f32x4 (&acc)[2][2][4][2], const pg8::Unit& u, int wr, int wc, int fr, int fq) const {
        const int row0 = u.pm * 256 + wr * 64 + fr;
        if (u.pn < 8) {
            const float qs = (u.pn < 4) ? 0.125f * 1.4426950408889634f : 1.0f;
            u16* o = (u16*)(ws + WS_PROJ);
            const int col0 = u.pn * 256 + wc * 32 + 8 * fq;
            const bool ropew = (wc & 1) == 0;
            const float sg = (fq == 0) ? -1.f : 1.f; const bool act = fq < 2;
#pragma unroll
            for (int ai = 0; ai < 2; ++ai) {
                pg8::f32x4 cs[4][4];
                if (ropew) {
#pragma unroll
                    for (int m = 0; m < 4; ++m) { const pg8::f32x4* cp = (const pg8::f32x4*)(ws + WS_ROPE) + (size_t)(row0 + ai * 128 + m * 16) * 4;
#pragma unroll
                        for (int k = 0; k < 4; ++k) cs[m][k] = cp[k]; }
                }
#pragma unroll
                for (int m = 0; m < 4; ++m)
#pragma unroll
                    for (int bj = 0; bj < 2; ++bj) {
                        pg8::f32x4 v0 = acc[ai][bj][m][0], v1 = acc[ai][bj][m][1];
                        if (ropew) {
#pragma unroll
                            for (int j = 0; j < 4; ++j) {
                                const float p0 = sxf<16>(v0[j], 0), p1 = sxf<16>(v1[j], 0);
                                const float c0 = cs[m][j >> 1][2 * (j & 1)], s0 = cs[m][j >> 1][2 * (j & 1) + 1];
                                const float c1 = cs[m][2 + (j >> 1)][2 * (j & 1)], s1 = cs[m][2 + (j >> 1)][2 * (j & 1) + 1];
                                const float r0 = v0[j] * c0 + sg * p0 * s0, r1 = v1[j] * c1 + sg * p1 * s1;
                                v0[j] = act ? r0 : v0[j]; v1[j] = act ? r1 : v1[j];
                            }
                        }
                        *(u32x4*)(o + (size_t)(row0 + ai * 128 + m * 16) * 2048 + col0 + bj * 128) =
                            u32x4{pk2(v0[0] * qs, v0[1] * qs), pk2(v0[2] * qs, v0[3] * qs), pk2(v1[0] * qs, v1[1] * qs), pk2(v1[2] * qs, v1[3] * qs)};
                    }
            }
        } else {
            u16* vt = (u16*)(ws + WS_VT);
#pragma unroll
            for (int ai = 0; ai < 2; ++ai)
#pragma unroll
                for (int m = 0; m < 4; ++m) {
                    const int row = row0 + ai * 128 + m * 16, b = row >> 14, sq = row & (SEQ - 1);
                    const int sp = (sq & ~12) | ((sq & 4) << 1) | ((sq & 8) >> 1);
#pragma unroll
                    for (int bj = 0; bj < 2; ++bj) {
                        const int hv = 2 * (u.pn - 8) + bj, dv0 = wc * 32 + 8 * fq;
                        u16* vp = vt + ((size_t)((b * 8 + hv) * 128 + dv0)) * SEQ + sp;
                        const pg8::f32x4 v0 = acc[ai][bj][m][0], v1 = acc[ai][bj][m][1];
#pragma unroll
                        for (int j = 0; j < 4; ++j) { vp[(size_t)j * SEQ] = f2bf(v0[j]); vp[(size_t)(4 + j) * SEQ] = f2bf(v1[j]); }
                    }
                }
        }
    }
};
template <class Epi>
DI void gemm8(const Params& p, const u16* A, const u16* Bt, int N, const Epi& E) {
    extern __shared__ __attribute__((aligned(16))) char dyn_smem_g[];
    pg8::StaticOrder so; so.init(T_TOK, N, (int)gridDim.x, (int)blockIdx.x);
    pg8::Gemm g; g.A = A; g.Bt = Bt; g.M = T_TOK; g.N = N; g.K = 1024;
    pg8::gemm_phase((PG8_LAS unsigned char*)dyn_smem_g, g, so, E, opaque_tid8(p));
}
DI void gla_glr_phase(const Params& p, char* smem, int bid, int nb) {
    const int tid = opaque_tid(p), wave = tid >> 6, lane = tid & 63, r = lane & 31, half = lane >> 5;
    const u16* hn = (const u16*)(p.ws + WS_HN);
    const u16* wg = (const u16*)(p.ws + WS_WGIN) + (size_t)3072 * 1024;
    for (int u = bid; u < T_TOK / 128; u += nb) {
        const int m0 = u * 128;
        f32x16 acc[1][2];
        acc[0][0] = zero16(); acc[0][1] = zero16();
        gemm_mainloop<1, 2, 64, 128>(p, hn + (size_t)m0 * 1024, 1024, wg, 1024, 1024, smem, 32 * wave, 0, acc);
        if (r < 16) {
            float* o = (float*)(p.ws + WS_GLR);
#pragma unroll
            for (int i = 0; i < 16; ++i) o[(size_t)(m0 + 32 * wave + crow(i, half)) * 16 + r] = acc[0][0][i];
        }
    }
}
constexpr int CUM_LD = 129;

DI float log_sigmoid(float z) {
    const float e = __builtin_amdgcn_exp2f(-fabsf(z) * 1.4426950408889634f);
    return fminf(z, 0.f) - __builtin_amdgcn_logf(1.f + e) * 0.6931471805599453f;
}

DI void gla_cum(const Params& p, int tok0, int h, float* cumL, float* glrL) {
    const int tid = opaque_tid(p), d = tid & 127, part = tid >> 7;
    const float* glr = (const float*)(p.ws + WS_GLR) + (size_t)tok0 * 16;
    ((f32x4*)glrL)[tid] = ((const f32x4*)glr)[tid];
    float w[16];
#pragma unroll
    for (int q = 0; q < 16; ++q) w[q] = p.gla_wgu[q * 512 + h * 128 + d];
    const float bias = p.gla_bg[h * 128 + d];
    __syncthreads();
    float run = 0.f;
#pragma unroll 1
    for (int c0 = part * 32; c0 < part * 32 + 32; c0 += 8) {
        float gl[8];
#pragma unroll
        for (int j = 0; j < 8; ++j) {
            const f32x4* gr = (const f32x4*)(glrL + (c0 + j) * 16);
            const f32x4 g0 = gr[0], g1 = gr[1], g2 = gr[2], g3 = gr[3];
            const float p0 = g0.x * w[0] + g0.y * w[1] + g0.z * w[2] + g0.w * w[3];
            const float p1 = g1.x * w[4] + g1.y * w[5] + g1.z * w[6] + g1.w * w[7];
            const float p2 = g2.x * w[8] + g2.y * w[9] + g2.z * w[10] + g2.w * w[11];
            const float p3 = g3.x * w[12] + g3.y * w[13] + g3.z * w[14] + g3.w * w[15];
            gl[j] = log_sigmoid(bias + ((p0 + p1) + (p2 + p3))) * (1.f / 16.f);
        }
#pragma unroll
        for (int j = 0; j < 8; ++j) { run += gl[j]; cumL[(c0 + j) * CUM_LD + d] = run; }
    }
    __syncthreads();
    if (part == 1) {
        const float add = cumL[31 * CUM_LD + d];
#pragma unroll 8
        for (int c = 32; c < 64; ++c) cumL[c * CUM_LD + d] += add;
    }
    __syncthreads();
}

DI void gla_pass1(const Params& p, char* smem, int bid, int nb) {
    const int tid = opaque_tid(p), wave = tid >> 6, lane = tid & 63, r = lane & 31, half = lane >> 5;
    float* cumL = (float*)smem; char* vT = smem; char* kdT = smem + 36864; float* glrL = (float*)(smem + 36864);
    const u16* proj = (const u16*)(p.ws + WS_PROJ);
    for (int u = bid; u < 2048; u += nb) {
        const int bh = u >> 8, n = u & 255, b = bh >> 2, h = bh & 3;
        const int tok0 = b * SEQ + n * 64;
        __syncthreads();
        gla_cum(p, tok0, h, cumL, glrL);
        if (tid < 128) ((float*)(p.ws + WS_DEC))[(size_t)u * 128 + tid] = __expf(cumL[63 * CUM_LD + tid]);
#pragma unroll 1
        for (int it = 0; it < 4; ++it) {
            const int d0 = (wave + 4 * it) * 8;
            const u32x4 kreg = *(const u32x4*)(proj + (size_t)(tok0 + lane) * 3072 + 512 + h * 128 + d0);
            const unsigned wv[4] = {kreg.x, kreg.y, kreg.z, kreg.w};
            const float* cl = cumL + 63 * CUM_LD + d0; const float* cc = cumL + lane * CUM_LD + d0;
            char* dst = kdT + (d0 * 72 + lane) * 2;
#pragma unroll
            for (int i = 0; i < 8; ++i) {
                const float kv = (i & 1) ? bfhi(wv[i >> 1]) : bflo(wv[i >> 1]);
                const float e = __expf(cl[i] - cc[i]);
                *(u16*)(dst + i * 144) = f2bf(kv * e);
            }
        }
        __syncthreads();
#pragma unroll 1
        for (int it = 0; it < 8; ++it) {
            const int v0 = (wave + 4 * it) * 8;
            const u32x4 vr = *(const u32x4*)(proj + (size_t)(tok0 + lane) * 3072 + 1024 + h * 256 + v0);
            const unsigned wv[4] = {vr.x, vr.y, vr.z, vr.w};
            char* dst = vT + (v0 * 72 + lane) * 2;
#pragma unroll
            for (int i = 0; i < 8; ++i) *(u16*)(dst + i * 144) = (u16)((i & 1) ? (wv[i >> 1] >> 16) : (wv[i >> 1] & 0xffffu));
        }
        __syncthreads();
        u16* kvo = (u16*)(p.ws + WS_KV) + (size_t)u * 32768;
#pragma unroll 1
        for (int jh = 0; jh < 2; ++jh) {
            f32x16 acc[2][2];
#pragma unroll
            for (int i = 0; i < 2; ++i)
#pragma unroll
                for (int j = 0; j < 2; ++j) acc[i][j] = zero16();
#pragma unroll
            for (int ks = 0; ks < 4; ++ks) {
                bf16x8 af[2], bfr[2];
#pragma unroll
                for (int i = 0; i < 2; ++i) af[i] = lds_frag(vT + (64 * wave + 32 * i + r) * 144 + ks * 32 + half * 16);
#pragma unroll
                for (int j = 0; j < 2; ++j) bfr[j] = lds_frag(kdT + (64 * jh + 32 * j + r) * 144 + ks * 32 + half * 16);
#pragma unroll
                for (int i = 0; i < 2; ++i)
#pragma unroll
                    for (int j = 0; j < 2; ++j) acc[i][j] = MFMA32(af[i], bfr[j], acc[i][j]);
            }
#pragma unroll
            for (int i = 0; i < 2; ++i)
#pragma unroll
                for (int j = 0; j < 2; ++j)
#pragma unroll
                    for (int q = 0; q < 16; ++q) kvo[(64 * wave + 32 * i + crow(q, half)) * 128 + 64 * jh + 32 * j + r] = f2bf(acc[i][j][q]);
        }
    }
}

DI void gla_scan(const Params& p, int bid, int nb) {
    u16* kv = (u16*)(p.ws + WS_KV);
    const float* dec = (const float*)(p.ws + WS_DEC);
    for (int g = bid * NTHR + opaque_tid(p); g < 32768; g += nb * NTHR) {
        const int bh = g >> 12, rem = g & 4095;
        const int dch = rem & 15;
        float st[8];
#pragma unroll
        for (int i = 0; i < 8; ++i) st[i] = 0.f;
        const size_t base = (size_t)bh * 256 * 32768 + (size_t)rem * 8;
        const float* dbase = dec + (size_t)bh * 256 * 128 + dch * 8;
        for (int n0 = 0; n0 < 256; n0 += 8) {
            u32x4 kk[8]; f32x4 d0[8], d1[8];
#pragma unroll
            for (int j = 0; j < 8; ++j) {
                kk[j] = *(const u32x4*)(kv + base + (size_t)(n0 + j) * 32768);
                d0[j] = *(const f32x4*)(dbase + (size_t)(n0 + j) * 128);
                d1[j] = *(const f32x4*)(dbase + (size_t)(n0 + j) * 128 + 4);
            }
#pragma unroll
            for (int j = 0; j < 8; ++j) {
                const u32x4 o = u32x4{pk2(st[0], st[1]), pk2(st[2], st[3]), pk2(st[4], st[5]), pk2(st[6], st[7])};
                *(u32x4*)(kv + base + (size_t)(n0 + j) * 32768) = o;
                const float dd[8] = {d0[j].x, d0[j].y, d0[j].z, d0[j].w, d1[j].x, d1[j].y, d1[j].z, d1[j].w};
                const unsigned wv[4] = {kk[j].x, kk[j].y, kk[j].z, kk[j].w};
#pragma unroll
                for (int i = 0; i < 8; ++i) st[i] = dd[i] * st[i] + ((i & 1) ? bfhi(wv[i >> 1]) : bflo(wv[i >> 1]));
            }
        }
    }
}

DI void gla_pass3(const Params& p, char* smem, int bid, int nb) {
    const int tid = opaque_tid(p), wave = tid >> 6, lane = tid & 63, r = lane & 31, half = lane >> 5;
    float* cumL = (float*)smem; char* vT = smem; char* aM = smem + 18432; char* qd = smem + 36864; char* kq = smem + 54272; float* glrL = (float*)(smem + 36864);
    float* oL = (float*)smem;
    const u16* proj = (const u16*)(p.ws + WS_PROJ);
    const float scale = 0.08838834764831845f;
    for (int u = bid; u < 2048; u += nb) {
        const int bh = u >> 8, n = u & 255, b = bh >> 2, h = bh & 3;
        const int tok0 = b * SEQ + n * 64;
        const u16* st = (const u16*)(p.ws + WS_KV) + (size_t)u * 32768;
        __syncthreads();
        u32x4 qreg[4], kreg[4];
#pragma unroll
        for (int it = 0; it < 4; ++it) {
            const int id = tid + 256 * it, c = id >> 4, dch = id & 15;
            qreg[it] = *(const u32x4*)(proj + (size_t)(tok0 + c) * 3072 + h * 128 + dch * 8);
            kreg[it] = *(const u32x4*)(proj + (size_t)(tok0 + c) * 3072 + 512 + h * 128 + dch * 8);
        }
        gla_cum(p, tok0, h, cumL, glrL);
        u32x4 vreg[4], sreg[8];
#pragma unroll
        for (int it = 0; it < 4; ++it) {
            const int q = wave + 4 * it, wq = q >> 2, vv0 = (q & 3) * 8;
            vreg[it] = *(const u32x4*)(proj + (size_t)(tok0 + lane) * 3072 + 1024 + h * 256 + 64 * wq + vv0);
        }
#pragma unroll
        for (int ks = 0; ks < 8; ++ks) sreg[ks] = *(const u32x4*)(st + (size_t)(64 * wave + r) * 128 + ks * 16 + half * 8);
#pragma unroll
        for (int it = 0; it < 4; ++it) {
            const int id = tid + 256 * it, c = id >> 4, dch = id & 15;
            const unsigned qw[4] = {qreg[it].x, qreg[it].y, qreg[it].z, qreg[it].w}, kw[4] = {kreg[it].x, kreg[it].y, kreg[it].z, kreg[it].w};
            unsigned qo[4], ko[4];
#pragma unroll
            for (int i = 0; i < 4; ++i) {
                const int d = dch * 8 + 2 * i;
                const float e0 = cumL[c * CUM_LD + d] - cumL[31 * CUM_LD + d], e1 = cumL[c * CUM_LD + d + 1] - cumL[31 * CUM_LD + d + 1];
                qo[i] = pk2(bflo(qw[i]) * scale * __expf(e0), bfhi(qw[i]) * scale * __expf(e1));
                ko[i] = pk2(bflo(kw[i]) * __expf(-e0), bfhi(kw[i]) * __expf(-e1));
            }
            *(u32x4*)(qd + c * 272 + dch * 16) = u32x4{qo[0], qo[1], qo[2], qo[3]};
            *(u32x4*)(kq + c * 272 + dch * 16) = u32x4{ko[0], ko[1], ko[2], ko[3]};
        }
        __syncthreads();
        const int rb = wave >> 1, cb = wave & 1;
        f32x16 aacc = zero16();
        if (cb <= rb) {
#pragma unroll
            for (int ks = 0; ks < 8; ++ks) {
                const bf16x8 af = lds_frag(qd + (32 * rb + r) * 272 + ks * 32 + half * 16);
                const bf16x8 bf = lds_frag(kq + (32 * cb + r) * 272 + ks * 32 + half * 16);
                aacc = MFMA32(af, bf, aacc);
            }
        }
        __syncthreads();
#pragma unroll
        for (int it = 0; it < 4; ++it) {
            const int id = tid + 256 * it, c = id >> 4, dch = id & 15;
            const unsigned qw[4] = {qreg[it].x, qreg[it].y, qreg[it].z, qreg[it].w};
            unsigned qo[4];
#pragma unroll
            for (int i = 0; i < 4; ++i) {
                const int d = dch * 8 + 2 * i;
                qo[i] = pk2(bflo(qw[i]) * scale * __expf(cumL[c * CUM_LD + d]), bfhi(qw[i]) * scale * __expf(cumL[c * CUM_LD + d + 1]));
            }
            *(u32x4*)(kq + c * 272 + dch * 16) = u32x4{qo[0], qo[1], qo[2], qo[3]};
        }
        __syncthreads();
#pragma unroll
        for (int q = 0; q < 16; ++q) {
            const int c = 32 * rb + crow(q, half), j = 32 * cb + r;
            *(u16*)(aM + (c * 72 + j) * 2) = f2bf((j <= c) ? aacc[q] : 0.f);
        }
        f32x16 o[2][2];
#pragma unroll
        for (int i = 0; i < 2; ++i)
#pragma unroll
            for (int j = 0; j < 2; ++j) o[i][j] = zero16();
        u32x2 rreg[16];
#pragma unroll
        for (int ps = 0; ps < 2; ++ps) {
            if (ps == 1) __syncthreads();
#pragma unroll
            for (int it = 0; it < 4; ++it) {
                const int q = wave + 4 * it, wq = q >> 2, vv0 = (q & 3) * 8;
                const unsigned wv[4] = {vreg[it].x, vreg[it].y, vreg[it].z, vreg[it].w};
                char* dst = vT + ((wq * 32 + vv0) * 72 + lane) * 2;
#pragma unroll
                for (int i = 0; i < 8; ++i) *(u16*)(dst + i * 144) = (u16)((i & 1) ? (wv[i >> 1] >> 16) : (wv[i >> 1] & 0xffffu));
            }
            if (ps == 0) {
#pragma unroll
                for (int it = 0; it < 4; ++it) {
                    const int q = wave + 4 * it, wq = q >> 2, vv0 = (q & 3) * 8;
                    vreg[it] = *(const u32x4*)(proj + (size_t)(tok0 + lane) * 3072 + 1024 + h * 256 + 64 * wq + 32 + vv0);
                }
            } else {
                const u16* rrow = proj + (size_t)(tok0 + (tid >> 2)) * 3072 + 2048 + h * 256 + 4 * (tid & 3);
#pragma unroll
                for (int j = 0; j < 16; ++j) rreg[j] = *(const u32x2*)(rrow + 16 * j);
            }
            __syncthreads();
#pragma unroll
            for (int ks = 0; ks < 4; ++ks) {
                const bf16x8 bf = lds_frag(vT + (wave * 32 + r) * 144 + ks * 32 + half * 16);
#pragma unroll
                for (int i = 0; i < 2; ++i) {
                    const bf16x8 af = lds_frag(aM + (32 * i + r) * 144 + ks * 32 + half * 16);
                    o[ps][i] = MFMA32(af, bf, o[ps][i]);
                }
            }
#pragma unroll
            for (int ks = 0; ks < 8; ++ks) {
                const bf16x8 bf = __builtin_bit_cast(bf16x8, sreg[ks]);
#pragma unroll
                for (int i = 0; i < 2; ++i) {
                    const bf16x8 af = lds_frag(kq + (32 * i + r) * 272 + ks * 32 + half * 16);
                    o[ps][i] = MFMA32(af, bf, o[ps][i]);
                }
            }
            if (ps == 0) {
#pragma unroll
                for (int ks = 0; ks < 8; ++ks) sreg[ks] = *(const u32x4*)(st + (size_t)(64 * wave + 32 + r) * 128 + ks * 16 + half * 8);
            }
        }
        __syncthreads();
#pragma unroll
        for (int ps = 0; ps < 2; ++ps)
#pragma unroll
            for (int i = 0; i < 2; ++i)
#pragma unroll
                for (int q = 0; q < 16; ++q) oL[(32 * i + crow(q, half)) * 260 + 64 * wave + 32 * ps + r] = o[ps][i][q];
        __syncthreads();
        {
            const int c = tid >> 2, qq = tid & 3;
            f32x4 vals[16]; float ss = 0.f;
#pragma unroll
            for (int j = 0; j < 16; ++j) {
                vals[j] = *(const f32x4*)(oL + c * 260 + 16 * j + 4 * qq);
                ss += vals[j].x * vals[j].x + vals[j].y * vals[j].y + vals[j].z * vals[j].z + vals[j].w * vals[j].w;
            }
            ss += sxf<1>(ss, 0); ss += sxf<2>(ss, 0);
            const float rinv = rsqrtf(ss * (1.f / 256.f) + 1e-6f);
            const float* gn = p.gla_norm + h * 256;
            u16* orow = (u16*)(p.ws + WS_HN) + (size_t)(tok0 + c) * 1024 + h * 256;
#pragma unroll
            for (int j = 0; j < 16; ++j) {
                const int v0 = 16 * j + 4 * qq;
                const u32x2 rr = rreg[j];
                const f32x4 g4 = *(const f32x4*)(gn + v0);
                const float r0 = bflo(rr.x), r1 = bfhi(rr.x), r2 = bflo(rr.y), r3 = bfhi(rr.y);
                const float o0 = vals[j].x * rinv * g4.x * (r0 / (1.f + __expf(-r0)));
                const float o1 = vals[j].y * rinv * g4.y * (r1 / (1.f + __expf(-r1)));
                const float o2 = vals[j].z * rinv * g4.z * (r2 / (1.f + __expf(-r2)));
                const float o3 = vals[j].w * rinv * g4.w * (r3 / (1.f + __expf(-r3)));
                *(u32x2*)(orow + v0) = u32x2{pk2(o0, o1), pk2(o2, o3)};
            }
        }
    }
}
DI unsigned sortable(float v) { const unsigned u = __float_as_uint(v); return (u & 0x80000000u) ? ~u : (u | 0x80000000u); }
DI float unsortable(unsigned k) { const unsigned u = (k & 0x80000000u) ? (k & 0x7fffffffu) : ~k; return __uint_as_float(u); }
DI void ins16(unsigned (&L)[16], unsigned x) {
#pragma unroll
    for (int i = 0; i < 16; ++i) { const unsigned hi = max(L[i], x); x = min(L[i], x); L[i] = hi; }
}

DI void ce(unsigned& a, unsigned& b) { const unsigned hi = max(a, b), lo = min(a, b); a = hi; b = lo; }
template <int N> DI void bitonic_sort_desc(unsigned (&v)[N]) {
#pragma unroll
    for (int k = 2; k <= N; k <<= 1)
#pragma unroll
        for (int j = k >> 1; j > 0; j >>= 1)
#pragma unroll
            for (int i = 0; i < N; ++i) {
                const int l = i ^ j;
                if (l > i) { if ((i & k) == 0) ce(v[i], v[l]); else ce(v[l], v[i]); }
            }
}
DI void top16_merge(unsigned (&a)[16], const unsigned (&b)[16]) {
#pragma unroll
    for (int i = 0; i < 16; ++i) a[i] = max(a[i], b[15 - i]);
#pragma unroll
    for (int j = 8; j > 0; j >>= 1)
#pragma unroll
        for (int i = 0; i < 16; ++i) { const int l = i ^ j; if (l > i) ce(a[i], a[l]); }
}
constexpr int PQ_LDS_BYTES = G_LDS_BYTES;
DI void peer_query_phase(const Params& p, int layer, char* smem, int bid, int nb) {
    const int tid = opaque_tid(p), wave = tid >> 6, lane = tid & 63, r = lane & 31, half = lane >> 5;
    const u16* hn = (const u16*)(p.ws + WS_HN);
    const u16* wq = (const u16*)(p.ws + WS_WPQ) + (size_t)layer * 2048 * 1024;
    const u16* sk = (const u16*)(p.ws + WS_SK) + (size_t)layer * 8 * 2 * 128 * 128;
    char* Bk = smem;
    for (int j = 0; j * nb < 2048; ++j) {
        const int u = xcd_unit(j, bid, nb);
        if (u >= 2048) continue;
        const int tb = u >> 3, h = u & 7;
        unsigned Lp[2][16];
        __syncthreads();
        f32x16 acc[8][1];
#pragma unroll
        for (int i = 0; i < 8; ++i) acc[i][0] = zero16();
        gemm_mainloop<8, 1, 128, 256>(p, wq + (size_t)(h * 256) * 1024, 1024, hn + (size_t)(tb * 128) * 1024, 1024, 1024, smem, 0, 32 * wave, acc);
        bf16x8 bqa[2][8];
#pragma unroll
        for (int pp = 0; pp < 2; ++pp)
#pragma unroll
            for (int di = 0; di < 4; ++di) { bqa[pp][2 * di] = pack8(acc[4 * pp + di][0], 0); bqa[pp][2 * di + 1] = pack8(acc[4 * pp + di][0], 1); }
#pragma unroll
        for (int pp = 0; pp < 2; ++pp) {
            __syncthreads();
            const u16* skt = sk + (size_t)(h * 2 + pp) * 128 * 128;
            int tidl = tid; asm volatile("" : "+v"(tidl));
            {
                const int n0 = tidl >> 4, ch = tidl & 15;
                u32x4 tmp[8];
#pragma unroll
                for (int it = 0; it < 8; ++it) tmp[it] = *(const u32x4*)(skt + (n0 + 16 * it) * 128 + ch * 8);
#pragma unroll
                for (int it = 0; it < 8; ++it) *(u32x4*)(Bk + (n0 + 16 * it) * 272 + ch * 16) = tmp[it];
            }
            __syncthreads();
            f32x16 sc[4];
#pragma unroll
            for (int i = 0; i < 4; ++i) sc[i] = zero16();
#pragma unroll
            for (int di = 0; di < 4; ++di)
#pragma unroll
                for (int s = 0; s < 2; ++s) {
                    const bf16x8 bq = bqa[pp][2 * di + s];
#pragma unroll
                    for (int kb = 0; kb < 4; ++kb) {
                        const char* rowp = Bk + (32 * kb + r) * 272 + (32 * di + 16 * s + 4 * half) * 2;
                        const bf16x8 ak = lds_frag2(rowp, rowp + 16);
                        sc[kb] = MFMA32(ak, bq, sc[kb]);
                    }
                }
            unsigned L[16];
            {
                unsigned G[4][16];
                int hq4 = 4 * half; asm volatile("" : "+v"(hq4));
#pragma unroll
                for (int kb = 0; kb < 4; ++kb) {
#pragma unroll
                    for (int q = 0; q < 16; ++q) G[kb][q] = (sortable(sc[kb][q]) & 0xffffff80u) | (unsigned)(127 - 32 * kb - crow(q, 0) - hq4);
                    bitonic_sort_desc<16>(G[kb]);
                }
                top16_merge(G[0], G[1]); top16_merge(G[2], G[3]); top16_merge(G[0], G[2]);
#pragma unroll
                for (int i = 0; i < 16; ++i) L[i] = G[0][i];
            }
            {
                unsigned O[16];
#pragma unroll
                for (int i = 0; i < 16; ++i) O[i] = sxu<32>(L[i], half);
                top16_merge(L, O);
            }
#pragma unroll
            for (int i = 0; i < 16; ++i) Lp[pp][i] = L[i];
        }
        float s1[16], s2[16]; int i1[16], i2[16];
#pragma unroll
        for (int i = 0; i < 16; ++i) {
            s1[i] = unsortable(Lp[0][i] & 0xffffff80u); i1[i] = 127 - (int)(Lp[0][i] & 127u);
            s2[i] = unsortable(Lp[1][i] & 0xffffff80u); i2[i] = 127 - (int)(Lp[1][i] & 127u);
        }
        __syncthreads();
        int* tabL = (int*)(smem + wave * 8192);
        if (half == 0) {
#pragma unroll
            for (int i = 0; i < 16; ++i) { tabL[i * 32 + r] = i1[i]; tabL[(16 + i) * 32 + r] = i2[i]; tabL[(32 + i) * 32 + r] = __float_as_int(s1[i]); tabL[(48 + i) * 32 + r] = __float_as_int(s2[i]); }
        }
        unsigned C[16], D[16];
#pragma unroll
        for (int i = 0; i < 16; ++i) { C[i] = 0u; D[i] = 0u; }
#define CANDK(a0, b0, a1, b1) ((sortable(half ? (s1[a1] + s2[b1]) : (s1[a0] + s2[b0])) & 0xffffff00u) | (unsigned)(255 - (half ? (16 * a1 + b1) : (16 * a0 + b0))))
        C[0] = CANDK(0, 0, 0, 1);
        C[1] = CANDK(0, 2, 0, 3);
        C[2] = CANDK(0, 4, 0, 5);
        C[3] = CANDK(0, 6, 0, 7);
        C[4] = CANDK(0, 8, 0, 9);
        C[5] = CANDK(0, 10, 0, 11);
        C[6] = CANDK(0, 12, 0, 13);
        C[7] = CANDK(0, 14, 0, 15);
        C[8] = CANDK(1, 0, 1, 1);
        C[9] = CANDK(1, 2, 1, 3);
        C[10] = CANDK(1, 4, 1, 5);
        C[11] = CANDK(1, 6, 1, 7);
        C[12] = CANDK(2, 0, 2, 1);
        C[13] = CANDK(2, 2, 2, 3);
        C[14] = CANDK(2, 4, 3, 0);
        C[15] = CANDK(3, 1, 3, 2);
        D[0] = CANDK(3, 3, 4, 0);
        D[1] = CANDK(4, 1, 4, 2);
        D[2] = CANDK(5, 0, 5, 1);
        D[3] = CANDK(6, 0, 6, 1);
        D[4] = CANDK(7, 0, 7, 1);
        D[5] = CANDK(8, 0, 9, 0);
        D[6] = CANDK(10, 0, 11, 0);
        D[7] = CANDK(12, 0, 13, 0);
        D[8] = CANDK(14, 0, 15, 0);
#undef CANDK
        bitonic_sort_desc<16>(C); bitonic_sort_desc<16>(D);
        top16_merge(C, D);
        {
            unsigned O[16];
#pragma unroll
            for (int i = 0; i < 16; ++i) O[i] = sxu<32>(C[i], half);
            top16_merge(C, O);
        }
        float bs[16]; int bi[16];
#pragma unroll
        for (int i = 0; i < 16; ++i) {
            const int id = 255 - (int)(C[i] & 255u), a = id >> 4, b = id & 15;
            bi[i] = tabL[a * 32 + r] * 128 + tabL[(16 + b) * 32 + r];
            bs[i] = __int_as_float(tabL[(32 + a) * 32 + r]) + __int_as_float(tabL[(48 + b) * 32 + r]);
        }
        float den = 0.f, ex[16];
#pragma unroll
        for (int i = 0; i < 16; ++i) { ex[i] = __expf(bs[i] - bs[0]); den += ex[i]; }
        const float rden = 1.f / den;
        int rl = r; asm volatile("" : "+v"(rl));
        const int tok = tb * 128 + 32 * wave + rl;
        int* io = (int*)(p.ws + WS_IDX) + (size_t)tok * 128 + h * 16 + 8 * half;
        float* go = (float*)(p.ws + WS_GATE) + (size_t)tok * 128 + h * 16 + 8 * half;
        if (half == 0) {
            *(u32x4*)(io) = u32x4{(unsigned)bi[0], (unsigned)bi[1], (unsigned)bi[2], (unsigned)bi[3]};
            *(u32x4*)(io + 4) = u32x4{(unsigned)bi[4], (unsigned)bi[5], (unsigned)bi[6], (unsigned)bi[7]};
            *(f32x4*)(go) = f32x4{ex[0] * rden, ex[1] * rden, ex[2] * rden, ex[3] * rden};
            *(f32x4*)(go + 4) = f32x4{ex[4] * rden, ex[5] * rden, ex[6] * rden, ex[7] * rden};
        } else {
            *(u32x4*)(io) = u32x4{(unsigned)bi[8], (unsigned)bi[9], (unsigned)bi[10], (unsigned)bi[11]};
            *(u32x4*)(io + 4) = u32x4{(unsigned)bi[12], (unsigned)bi[13], (unsigned)bi[14], (unsigned)bi[15]};
            *(f32x4*)(go) = f32x4{ex[8] * rden, ex[9] * rden, ex[10] * rden, ex[11] * rden};
            *(f32x4*)(go + 4) = f32x4{ex[12] * rden, ex[13] * rden, ex[14] * rden, ex[15] * rden};
        }
    }
}

typedef __attribute__((ext_vector_type(2))) float f32x2;
DI float gelu_exact(float a) { return 0.5f * a * (1.f + erff(a * 0.7071067811865476f)); }
DI void unpack8_fp4(unsigned w, float (&f)[8]) {
    const f32x2 a = __builtin_amdgcn_cvt_scalef32_pk_f32_fp4(w, 1.0f, 0), b = __builtin_amdgcn_cvt_scalef32_pk_f32_fp4(w, 1.0f, 1);
    const f32x2 c = __builtin_amdgcn_cvt_scalef32_pk_f32_fp4(w, 1.0f, 2), d = __builtin_amdgcn_cvt_scalef32_pk_f32_fp4(w, 1.0f, 3);
    f[0] = a.x; f[1] = a.y; f[2] = b.x; f[3] = b.y; f[4] = c.x; f[5] = c.y; f[6] = d.x; f[7] = d.y;
}
constexpr float PG_SX = 21.6f;
constexpr int PG_RING_SLOTS = 16, PG_DEPTH = 14;
constexpr int PG_LDS_BYTES = 4 * PG_RING_SLOTS * 1024 + 4096;
DI void pg_dma(const unsigned char* tab, unsigned e, unsigned lane_off, char* slot) {
    __builtin_amdgcn_global_load_lds((const unsigned*)(tab + (e * 512u + lane_off)), (unsigned*)slot, 16, 0, 0);
}
DI void pg_dma4(const unsigned char* tab, const u32x4 e4, unsigned lane_off, char* ring, int g) {
    pg_dma(tab, e4.x, lane_off, ring + ((4 * g + 0) & 15) * 1024); pg_dma(tab, e4.y, lane_off, ring + ((4 * g + 1) & 15) * 1024);
    pg_dma(tab, e4.z, lane_off, ring + ((4 * g + 2) & 15) * 1024); pg_dma(tab, e4.w, lane_off, ring + ((4 * g + 3) & 15) * 1024);
}
#define PG_WAIT_GROUP(g) do { if ((g) + 3 < 16) asm volatile("s_waitcnt vmcnt(12)" ::: "memory"); else if ((g) == 13) asm volatile("s_waitcnt vmcnt(8)" ::: "memory"); \
                              else if ((g) == 14) asm volatile("s_waitcnt vmcnt(4)" ::: "memory"); else asm volatile("s_waitcnt vmcnt(0)" ::: "memory"); } while (0)
DI void peer_u_phase(const Params& p, int layer, char* smem, int bid, int nb) {
    const int tid = opaque_tid(p), wave = __builtin_amdgcn_readfirstlane(tid >> 6), lane = tid & 63, hh = lane >> 5, li = lane & 31;
    char* ring = smem + wave * (PG_RING_SLOTS * 1024);
    int* idxL = (int*)(smem + 4 * PG_RING_SLOTS * 1024 + wave * 1024); float* cL = (float*)(idxL + 128);
    const unsigned char* tu = (const unsigned char*)(p.ws + WS_TAB) + (size_t)layer * 16 * MB;
    const u16* hn = (const u16*)(p.ws + WS_HN);
    const char* myslot = ring + lane * 16;
    const unsigned lane_off = (unsigned)li * 16u;
    const int* idxH = idxL + hh * 64;
    for (int t = bid * 4 + wave; t < T_TOK; t += nb * 4) {
        const int* ig = (const int*)(p.ws + WS_IDX) + (size_t)t * 128;
        idxL[(lane & 1) * 64 + (lane >> 1)] = ig[lane]; idxL[(lane & 1) * 64 + 32 + (lane >> 1)] = ig[lane + 64];
        unsigned xh[4], xl[4];
        {
            const u16* xr = hn + (size_t)t * 1024 + 32 * li;
            const u32x4 xa = *(const u32x4*)(xr), xb = *(const u32x4*)(xr + 8), xc = *(const u32x4*)(xr + 16), xd = *(const u32x4*)(xr + 24);
            const unsigned xw[16] = {xa.x, xa.y, xa.z, xa.w, xb.x, xb.y, xb.z, xb.w, xc.x, xc.y, xc.z, xc.w, xd.x, xd.y, xd.z, xd.w};
#pragma unroll
            for (int d = 0; d < 4; ++d) {
                unsigned hw = 0, lw = 0;
#pragma unroll
                for (int j = 0; j < 8; ++j) {
                    const unsigned w = xw[4 * d + (j >> 1)];
                    const float xv = (j & 1) ? bfhi(w) : bflo(w);
                    const int q = (int)rintf(fminf(fmaxf(xv * PG_SX, -119.f), 119.f));
                    const int lo = ((q + 8) & 15) - 8, hi = (q - lo) >> 4;
                    hw |= ((unsigned)hi & 15u) << (4 * j); lw |= ((unsigned)lo & 15u) << (4 * j);
                }
                xh[d] = hw; xl[d] = lw;
            }
        }
        asm volatile("s_waitcnt vmcnt(0) lgkmcnt(0)" ::: "memory");
#pragma unroll
        for (int g = 0; g < 3; ++g) pg_dma4(tu, *(const u32x4*)(idxH + 4 * g), lane_off, ring, g);
#pragma unroll 1
        for (int bt = 0; bt < 4; ++bt) {
            float pr[16];
#pragma unroll
            for (int gg = 0; gg < 4; ++gg) {
                const int g = bt * 4 + gg;
                if (g + 3 < 16) pg_dma4(tu, *(const u32x4*)(idxH + 4 * (g + 3)), lane_off, ring, g + 3);
                PG_WAIT_GROUP(g);
                u32x4 w[4];
#pragma unroll
                for (int i = 0; i < 4; ++i) w[i] = *(const u32x4*)(myslot + ((4 * gg + i) & 15) * 1024);
#pragma unroll
                for (int i = 0; i < 4; ++i) {
                    const unsigned ww[4] = {w[i].x, w[i].y, w[i].z, w[i].w};
                    int ah = 0, al = 0;
#pragma unroll
                    for (int c = 0; c < 4; ++c) { ah = __builtin_amdgcn_sdot8((int)ww[c], (int)xh[c], ah, false); al = __builtin_amdgcn_sdot8((int)ww[c], (int)xl[c], al, false); }
                    pr[4 * gg + i] = (float)(16 * ah + al);
                }
            }
            float q8[8], q4[4], q2[2], q1;
            { const bool up = (lane & 1) != 0;
#pragma unroll
              for (int i = 0; i < 8; ++i) { const float send = up ? pr[i] : pr[i + 8]; const float keep = up ? pr[i + 8] : pr[i]; q8[i] = keep + sxf<1>(send, hh); } }
            { const bool up = (lane & 2) != 0;
#pragma unroll
              for (int i = 0; i < 4; ++i) { const float send = up ? q8[i] : q8[i + 4]; const float keep = up ? q8[i + 4] : q8[i]; q4[i] = keep + sxf<2>(send, hh); } }
            { const bool up = (lane & 4) != 0;
#pragma unroll
              for (int i = 0; i < 2; ++i) { const float send = up ? q4[i] : q4[i + 2]; const float keep = up ? q4[i + 2] : q4[i]; q2[i] = keep + sxf<4>(send, hh); } }
            { const bool up = (lane & 8) != 0; const float send = up ? q2[0] : q2[1]; const float keep = up ? q2[1] : q2[0]; q1 = keep + sxf<8>(send, hh); }
            q1 += sxf<16>(q1, hh);
            const int jj = 8 * (lane & 1) + 4 * ((lane >> 1) & 1) + 2 * ((lane >> 2) & 1) + ((lane >> 3) & 1);
            if ((lane & 16) == 0) cL[2 * (bt * 16 + jj) + hh] = q1;
        }
        float* dg = (float*)(p.ws + WS_DOT) + (size_t)t * 128;
        dg[lane] = cL[lane]; dg[lane + 64] = cL[lane + 64];
    }
}
typedef __attribute__((ext_vector_type(2))) _Float16 h2_t;
DI void pg_axpy(h2_t (&o2)[16], const u32x4 w, float cfs) {
    const _Float16 ch = (_Float16)cfs; const h2_t cf2 = {ch, ch};
    const unsigned ww[4] = {w.x, w.y, w.z, w.w};
#pragma unroll
    for (int c = 0; c < 4; ++c) {
        o2[4 * c + 0] = __builtin_amdgcn_cvt_scalef32_pk_f16_fp4(ww[c], 1.0f, 0) * cf2 + o2[4 * c + 0];
        o2[4 * c + 1] = __builtin_amdgcn_cvt_scalef32_pk_f16_fp4(ww[c], 1.0f, 1) * cf2 + o2[4 * c + 1];
        o2[4 * c + 2] = __builtin_amdgcn_cvt_scalef32_pk_f16_fp4(ww[c], 1.0f, 2) * cf2 + o2[4 * c + 2];
        o2[4 * c + 3] = __builtin_amdgcn_cvt_scalef32_pk_f16_fp4(ww[c], 1.0f, 3) * cf2 + o2[4 * c + 3];
    }
}
template <bool FINAL>
DI void peer_v_phase(const Params& p, int layer, const float* gnext, char* smem, int bid, int nb) {
    const int tid = opaque_tid(p), wave = __builtin_amdgcn_readfirstlane(tid >> 6), lane = tid & 63, hh = lane >> 5, li = lane & 31;
    char* ring = smem + wave * (PG_RING_SLOTS * 1024);
    int* idxL = (int*)(smem + 4 * PG_RING_SLOTS * 1024 + wave * 1024); float* cL = (float*)(idxL + 128);
    const unsigned char* tv = (const unsigned char*)(p.ws + WS_TAB) + (size_t)layer * 16 * MB + (size_t)16384 * 512;
    const char* myslot = ring + lane * 16;
    const unsigned lane_off = (unsigned)li * 16u;
    const int* idxH = idxL + hh * 64; const float* cH = cL + hh * 64;
    for (int t = bid * 4 + wave; t < T_TOK; t += nb * 4) {
        const int* ig = (const int*)(p.ws + WS_IDX) + (size_t)t * 128;
        const float* gg = (const float*)(p.ws + WS_GATE) + (size_t)t * 128;
        const float* dg = (const float*)(p.ws + WS_DOT) + (size_t)t * 128;
        const int s0 = (lane & 1) * 64 + (lane >> 1), s1 = s0 + 32;
        idxL[s0] = ig[lane]; idxL[s1] = ig[lane + 64];
        {
            const float d0 = dg[lane] * (1.f / (TAB_SCALE_UI * PG_SX)), d1 = dg[lane + 64] * (1.f / (TAB_SCALE_UI * PG_SX));
            cL[s0] = gg[lane] * gelu_exact(d0) * (1.f / TAB_SCALE_V); cL[s1] = gg[lane + 64] * gelu_exact(d1) * (1.f / TAB_SCALE_V);
        }
        asm volatile("s_waitcnt vmcnt(0) lgkmcnt(0)" ::: "memory");
#pragma unroll
        for (int g = 0; g < 3; ++g) pg_dma4(tv, *(const u32x4*)(idxH + 4 * g), lane_off, ring, g);
        h2_t o2[16];
#pragma unroll
        for (int i = 0; i < 16; ++i) o2[i] = h2_t{(_Float16)0.f, (_Float16)0.f};
#pragma unroll 1
        for (int bt = 0; bt < 4; ++bt) {
#pragma unroll
            for (int gg = 0; gg < 4; ++gg) {
                const int g = bt * 4 + gg;
                if (g + 3 < 16) pg_dma4(tv, *(const u32x4*)(idxH + 4 * (g + 3)), lane_off, ring, g + 3);
                const f32x4 c4 = *(const f32x4*)(cH + 4 * g);
                PG_WAIT_GROUP(g);
                u32x4 w[4];
#pragma unroll
                for (int i = 0; i < 4; ++i) w[i] = *(const u32x4*)(myslot + ((4 * gg + i) & 15) * 1024);
                pg_axpy(o2, w[0], c4.x); pg_axpy(o2, w[1], c4.y); pg_axpy(o2, w[2], c4.z); pg_axpy(o2, w[3], c4.w);
            }
        }
        float r[16];
#pragma unroll
        for (int i = 0; i < 8; ++i) {
            const h2_t send = hh ? o2[i] : o2[i + 8]; const h2_t keep = hh ? o2[i + 8] : o2[i];
            const h2_t got = __builtin_bit_cast(h2_t, sxu<32>(__builtin_bit_cast(unsigned, send), hh));
            r[2 * i] = (float)keep.x + (float)got.x; r[2 * i + 1] = (float)keep.y + (float)got.y;
        }
        float* hr = p.out + (size_t)t * 1024 + 32 * li + 16 * hh;
        f32x4 h0 = *(f32x4*)(hr), h1 = *(f32x4*)(hr + 4), h2 = *(f32x4*)(hr + 8), h3 = *(f32x4*)(hr + 12);
        h0 += f32x4{r[0], r[1], r[2], r[3]}; h1 += f32x4{r[4], r[5], r[6], r[7]};
        h2 += f32x4{r[8], r[9], r[10], r[11]}; h3 += f32x4{r[12], r[13], r[14], r[15]};
        float ss = h0.x * h0.x + h0.y * h0.y + h0.z * h0.z + h0.w * h0.w + h1.x * h1.x + h1.y * h1.y + h1.z * h1.z + h1.w * h1.w
                 + h2.x * h2.x + h2.y * h2.y + h2.z * h2.z + h2.w * h2.w + h3.x * h3.x + h3.y * h3.y + h3.z * h3.z + h3.w * h3.w;
        ss = wave_sum(ss, hh);
        const float rn = rsqrtf(ss * (1.f / 1024.f) + 1e-6f);
        const float* gp = gnext + 32 * li + 16 * hh;
        const f32x4 g0v = *(const f32x4*)(gp), g1v = *(const f32x4*)(gp + 4), g2v = *(const f32x4*)(gp + 8), g3v = *(const f32x4*)(gp + 12);
        if constexpr (FINAL) {
            *(f32x4*)(hr) = h0 * rn * g0v; *(f32x4*)(hr + 4) = h1 * rn * g1v; *(f32x4*)(hr + 8) = h2 * rn * g2v; *(f32x4*)(hr + 12) = h3 * rn * g3v;
        } else {
            *(f32x4*)(hr) = h0; *(f32x4*)(hr + 4) = h1; *(f32x4*)(hr + 8) = h2; *(f32x4*)(hr + 12) = h3;
            const f32x4 n0 = h0 * rn * g0v, n1 = h1 * rn * g1v, n2 = h2 * rn * g2v, n3 = h3 * rn * g3v;
            u16* hno = (u16*)(p.ws + WS_HN) + (size_t)t * 1024 + 32 * li + 16 * hh;
            *(u32x4*)(hno) = u32x4{pk2(n0.x, n0.y), pk2(n0.z, n0.w), pk2(n1.x, n1.y), pk2(n1.z, n1.w)};
            *(u32x4*)(hno + 8) = u32x4{pk2(n2.x, n2.y), pk2(n2.z, n2.w), pk2(n3.x, n3.y), pk2(n3.z, n3.w)};
        }
    }
}
constexpr int AT_LDS_BYTES = 65536;
constexpr float LAMBDA_INIT = 0.35550906759096927f;
constexpr float AT_THR = 8.f;


DI float max16(const f32x16& S) {
    float t0, t1, t2, t3, t4;
    asm volatile("s_nop 15\n\tv_max3_f32 %0, %5, %6, %7\n\tv_max3_f32 %1, %8, %9, %10\n\tv_max3_f32 %2, %11, %12, %13\n\tv_max3_f32 %3, %14, %15, %16\n\t"
                 "v_max3_f32 %4, %17, %18, %19\n\tv_max3_f32 %0, %0, %1, %20\n\tv_max3_f32 %2, %2, %3, %4\n\tv_max_f32 %0, %0, %2"
                 : "=&v"(t0), "=&v"(t1), "=&v"(t2), "=&v"(t3), "=&v"(t4)
                 : "v"(S[0]), "v"(S[1]), "v"(S[2]), "v"(S[3]), "v"(S[4]), "v"(S[5]), "v"(S[6]), "v"(S[7]), "v"(S[8]), "v"(S[9]), "v"(S[10]), "v"(S[11]),
                   "v"(S[12]), "v"(S[13]), "v"(S[14]), "v"(S[15]));
    return t0;
}
DI void attn_tile(const char* Kb, const char* Vb, const char* Qw, f32x16 (&O1)[4], f32x16 (&O2)[4], float& m1, float& l1, float& m2, float& l2,
                  bool diag, bool first, int k0, int qidx, int r, int half) {
    const int ksw = (r >> 1) & 7;
    const char* krow = Kb + r * 128;
    f32x16 S0, S1;
#pragma unroll
    for (int i = 0; i < 16; ++i) { S0[i] = -m1; S1[i] = -m2; }
    __builtin_amdgcn_s_setprio(1);
    {
        bf16x8 kf[4], qf[4];
#pragma unroll
        for (int ks = 0; ks < 4; ++ks) { kf[ks] = lds_frag(krow + (((2 * ks + half) ^ ksw) << 4)); qf[ks] = lds_frag(Qw + ks * 1024); }
#pragma unroll
        for (int ks = 0; ks < 4; ++ks) S0 = MFMA32(kf[ks], qf[ks], S0);
    }
    {
        bf16x8 kf[4], qf[4];
#pragma unroll
        for (int ks = 0; ks < 4; ++ks) { kf[ks] = lds_frag(krow + 4096 + (((2 * ks + half) ^ ksw) << 4)); qf[ks] = lds_frag(Qw + (4 + ks) * 1024); }
#pragma unroll
        for (int ks = 0; ks < 4; ++ks) S1 = MFMA32(kf[ks], qf[ks], S1);
    }
    __builtin_amdgcn_s_setprio(0);
    const int vsw = (r >> 2) & 3;
    const char* vrow = Vb + r * 64;
    const int vo0 = ((0 + half) ^ vsw) << 4, vo1 = ((2 + half) ^ vsw) << 4;
    __builtin_amdgcn_sched_barrier(0);
    if (diag) {
#pragma unroll
        for (int i = 0; i < 16; ++i) if (k0 + crow(i, half) > qidx) { S0[i] = -INFINITY; S1[i] = -INFINITY; }
    }
    float mx0 = max16(S0), mx1 = max16(S1);
    mx0 = fmaxf(mx0, sxf<32>(mx0, half)); mx1 = fmaxf(mx1, sxf<32>(mx1, half));
    if (first || !__all((mx0 <= AT_THR) && (mx1 <= AT_THR))) {
        const float d1 = fmaxf(mx0, 0.f), d2 = fmaxf(mx1, 0.f);
        const float e1 = first ? mx0 : d1, e2 = first ? mx1 : d2;
#pragma unroll
        for (int i = 0; i < 16; ++i) { S0[i] -= e1; S1[i] -= e2; }
        if (!first) {
            const float a1 = __builtin_amdgcn_exp2f(-d1), a2 = __builtin_amdgcn_exp2f(-d2);
#pragma unroll
            for (int d = 0; d < 4; ++d) { O1[d] *= a1; O2[d] *= a2; }
            l1 *= a1; l2 *= a2;
        }
        m1 += e1; m2 += e2;
    }
    __builtin_amdgcn_sched_barrier(0);
    bf16x8 vf[8];
#pragma unroll
    for (int d = 0; d < 4; ++d) { vf[2 * d] = lds_frag(vrow + d * 2048 + vo0); vf[2 * d + 1] = lds_frag(vrow + d * 2048 + vo1); }
    float ps0 = 0.f;
#pragma unroll
    for (int i = 0; i < 16; ++i) { const float pv = __builtin_amdgcn_exp2f(S0[i]); S0[i] = pv; ps0 += pv; }
    l1 += ps0;
    const bf16x8 P00 = pack8(S0, 0), P01 = pack8(S0, 1);
    __builtin_amdgcn_sched_barrier(0);
    __builtin_amdgcn_s_setprio(1);
#pragma unroll
    for (int d = 0; d < 4; ++d) { O1[d] = MFMA32(vf[2 * d], P00, O1[d]); O1[d] = MFMA32(vf[2 * d + 1], P01, O1[d]); }
    float ps1 = 0.f;
#pragma unroll
    for (int i = 0; i < 16; ++i) { const float pv = __builtin_amdgcn_exp2f(S1[i]); S1[i] = pv; ps1 += pv; }
    l2 += ps1;
    const bf16x8 P10 = pack8(S1, 0), P11 = pack8(S1, 1);
#pragma unroll
    for (int g = 0; g < 8; ++g) { __builtin_amdgcn_sched_group_barrier(0x8, 1, 0); __builtin_amdgcn_sched_group_barrier(0x2, 8, 0); }
    __builtin_amdgcn_sched_barrier(0);
#pragma unroll
    for (int d = 0; d < 4; ++d) { O2[d] = MFMA32(vf[2 * d], P10, O2[d]); O2[d] = MFMA32(vf[2 * d + 1], P11, O2[d]); }
    __builtin_amdgcn_s_setprio(0);
    __builtin_amdgcn_sched_barrier(0);
}

DI void attn_phase(const Params& p, char* smem, int bid, int nb) {
    const int tid = opaque_tid(p), wave = __builtin_amdgcn_readfirstlane(tid >> 6), lane = tid & 63, r = lane & 31, half = lane >> 5;
    char* Qs = smem; char* Kbuf = smem + 32768; char* Vbuf = smem + 49152;
    const u16* qk = (const u16*)(p.ws + WS_PROJ);
    const u16* vt = (const u16*)(p.ws + WS_VT);
    const float lam = __uint_as_float(__builtin_amdgcn_readfirstlane(__float_as_uint(
        __expf(wave_sum(p.lq1[lane] * p.lk1[lane], half)) - __expf(wave_sum(p.lq2[lane] * p.lk2[lane], half)) + LAMBDA_INIT)));
    const unsigned q_off = (unsigned)(lane & 31) * 4096u + (unsigned)(lane >> 5) * 16u;
    const unsigned kx = (unsigned)((lane & 7) ^ (lane >> 4));
    const unsigned k_off0 = (unsigned)(lane >> 3) * 4096u + (kx << 4), k_off1 = (unsigned)(lane >> 3) * 4096u + ((kx ^ 4u) << 4);
    const unsigned v_off = (unsigned)(lane >> 2) * (unsigned)(SEQ * 2) + (unsigned)(((lane & 3) ^ ((lane >> 4) & 3)) << 4);
    const int nrounds = (2048 + nb - 1) / nb;
    for (int j = 0; j < nrounds; ++j) {
        const int rank = j * nb + ((j & 1) ? (nb - 1 - bid) : bid);
        if (rank >= 2048) continue;
        const int qb = 127 - (rank >> 4), bh = rank & 15, b = bh >> 3, h = bh & 7;
        const int q0 = qb * 128, tokbase = b * SEQ, qlo = q0 + 32 * wave, qidx = qlo + r;
        const u16* kbase = qk + (size_t)tokbase * 2048 + 1024 + h * 128;
        const u16* vbase = vt + (size_t)(b * 8 + h) * 128 * SEQ;
        const int nkt = 4 * (qb + 1);
        __syncthreads();
        {
            const char* qsrc = (const char*)(qk + (size_t)(tokbase + q0 + wave * 32) * 2048 + h * 128);
#pragma unroll
            for (int i = 0; i < 8; ++i) dma16(qsrc + i * 32, q_off, Qs + (wave * 8 + i) * 1024);
        }
        const char* ksrc = (const char*)(kbase + (size_t)(16 * (wave & 1)) * 2048 + (wave >> 1) * 64);
        const char* vsrc = (const char*)(vbase + (size_t)(wave * 32) * SEQ);
        dma16(ksrc, k_off0, Kbuf + (wave * 2) * 1024);
        dma16(ksrc + 8 * 4096, k_off1, Kbuf + (wave * 2 + 1) * 1024);
        dma16(vsrc, v_off, Vbuf + (wave * 2) * 1024);
        dma16(vsrc + 16 * SEQ * 2, v_off, Vbuf + (wave * 2 + 1) * 1024);
        f32x16 O1[4], O2[4];
#pragma unroll
        for (int d = 0; d < 4; ++d) { O1[d] = zero16(); O2[d] = zero16(); }
        float m1 = 0.f, m2 = 0.f, l1 = 0.f, l2 = 0.f;
        const char* Qw = Qs + wave * 8192 + lane * 16;
        for (int kt = 0; kt < nkt; ++kt) {
            const int k0 = kt * 32, buf = kt & 1;
            asm volatile("s_waitcnt vmcnt(0)" ::: "memory");
            __syncthreads();
            if (kt + 1 < nkt) {
                const char* kn = ksrc + (size_t)(k0 + 32) * 4096; const char* vn = vsrc + (k0 + 32) * 2;
                char* kd = Kbuf + (buf ^ 1) * 8192 + (wave * 2) * 1024; char* vd = Vbuf + (buf ^ 1) * 8192 + (wave * 2) * 1024;
                dma16(kn, k_off0, kd);
                dma16(kn + 8 * 4096, k_off1, kd + 1024);
                dma16(vn, v_off, vd);
                dma16(vn + 16 * SEQ * 2, v_off, vd + 1024);
            }
            if (k0 <= qlo + 31) {
                const bool diag = (k0 + 31 > qlo);
                const char* Kb = Kbuf + buf * 8192; const char* Vb = Vbuf + buf * 8192;
                attn_tile(Kb, Vb, Qw, O1, O2, m1, l1, m2, l2, diag, kt == 0, k0, qidx, r, half);
            }
        }
        l1 += sxf<32>(l1, half); l2 += sxf<32>(l2, half);
        const float i1 = __builtin_amdgcn_rcpf(l1), i2 = lam * __builtin_amdgcn_rcpf(l2);
        float ss = 0.f;
#pragma unroll
        for (int d = 0; d < 4; ++d)
#pragma unroll
            for (int i = 0; i < 16; ++i) { const float v = O1[d][i] * i1 - O2[d][i] * i2; O1[d][i] = v; ss += v * v; }
        ss += sxf<32>(ss, half);
        const float rn = rsqrtf(ss * (1.f / 128.f) + 1e-6f) * (1.f - LAMBDA_INIT);
        u16* orow = (u16*)(p.ws + WS_HN) + (size_t)(tokbase + qidx) * 1024 + h * 128;
        const float* gn = p.diff_norm + h * 128;
        int half_e = half; asm volatile("" : "+v"(half_e));
        f32x4 gv[16];
#pragma unroll
        for (int i = 0; i < 16; ++i) gv[i] = *(const f32x4*)(gn + 32 * (i >> 2) + 8 * (i & 3) + 4 * half_e);
#pragma unroll
        for (int d = 0; d < 4; ++d)
#pragma unroll
            for (int g = 0; g < 4; ++g) {
                const int c0 = 32 * d + 8 * g + 4 * half_e;
                const f32x4 gq = gv[4 * d + g];
                *(u32x2*)(orow + c0) = u32x2{pk2(O1[d][4 * g] * rn * gq.x, O1[d][4 * g + 1] * rn * gq.y), pk2(O1[d][4 * g + 2] * rn * gq.z, O1[d][4 * g + 3] * rn * gq.w)};
            }
    }
}
extern __shared__ __attribute__((aligned(16))) char dyn_smem[];
constexpr int SUB_LDS = 73728;
constexpr int MEGA_LDS_WORK = 2 * SUB_LDS;
constexpr int MEGA_LDS_BYTES = MEGA_LDS_WORK + 16;

__global__ void __launch_bounds__(512, 2) mega_fwd(Params pk) {
    Params p = pk; const int w8 = __builtin_amdgcn_readfirstlane((int)(threadIdx.x >> 6));
    p.wv = w8 & 3; p.pad_ = w8; const int sub = w8 >> 2;
    volatile LAS unsigned* st = (volatile LAS unsigned*)(dyn_smem + MEGA_LDS_WORK);
    if (threadIdx.x == 0) { st[0] = 0u; st[1] = 0u; st[2] = 0u; st[3] = 0u; }
    __syncthreads();
    XcdBarrier bar = xcd_barrier_post((unsigned*)(p.ws + WS_BAR), st, threadIdx.x == 0);
#define XBAR() xcd_barrier(bar, (opaque_tid(p) | sub) == 0)
    char* smem = dyn_smem + sub * SUB_LDS;
    const int nb = 2 * (int)gridDim.x, bid = (int)blockIdx.x + sub * (int)gridDim.x;
    const int bidp = 2 * (int)blockIdx.x + sub;
    const u16* hn = (const u16*)(p.ws + WS_HN);
    phase_prep_a(p, bid, nb);
    asm volatile("; PHASE_END 1");
    XBAR();
    gemm8(p, hn, (const u16*)(p.ws + WS_WGIN), 3072, EpiProjBf16{(u16*)(p.ws + WS_PROJ), 3072});
    gla_glr_phase(p, smem, (int)blockIdx.x, (int)gridDim.x);
    asm volatile("; PHASE_END 2");
    XBAR();
    gla_pass1(p, smem, bid, nb);
    asm volatile("; PHASE_END 3");
    XBAR();
    if (nb >= 256) { if (bid < 128) gla_scan(p, bid, 128); else { phase_prep_b(p, bid - 128, nb - 128); phase_tabconv(p, 0, bid - 128, nb - 128); phase_tabconv(p, 1, bid - 128, nb - 128); } }
    else { gla_scan(p, bid, nb); phase_prep_b(p, bid, nb); phase_tabconv(p, 0, bid, nb); phase_tabconv(p, 1, bid, nb); }
    asm volatile("; PHASE_END 4");
    XBAR();
    gla_pass3(p, smem, bid, nb);
    asm volatile("; PHASE_END 5");
    XBAR();
    gemm8(p, hn, (const u16*)(p.ws + WS_WGOUT), 1024, EpiResid8{p.x, p.out});
    asm volatile("; PHASE_END 6");
    XBAR();
    phase_rmsnorm(p, p.norm_ffn, bid, nb);
    asm volatile("; PHASE_END 7");
    XBAR();
    peer_query_phase(p, 0, smem, bid, nb);
    asm volatile("; PHASE_END 8");
    XBAR();
    peer_u_phase(p, 0, smem, bid, nb);
    XBAR();
    peer_v_phase<false>(p, 0, p.norm_mix + 1024, smem, bid, nb);
    asm volatile("; PHASE_END 9");
    XBAR();
    gemm8(p, hn, (const u16*)(p.ws + WS_WDIN), 3072, EpiDiffIn8{p.ws});
    asm volatile("; PHASE_END 10");
    XBAR();
    attn_phase(p, smem, bidp, nb);
    asm volatile("; PHASE_END 11");
    XBAR();
    gemm8(p, hn, (const u16*)(p.ws + WS_WDOUT), 1024, EpiResid8{p.out, p.out});
    asm volatile("; PHASE_END 12");
    XBAR();
    phase_rmsnorm(p, p.norm_ffn + 1024, bid, nb);
    asm volatile("; PHASE_END 13");
    XBAR();
    peer_query_phase(p, 1, smem, bid, nb);
    asm volatile("; PHASE_END 14");
    XBAR();
    peer_u_phase(p, 1, smem, bid, nb);
    XBAR();
    peer_v_phase<true>(p, 1, p.norm_final, smem, bid, nb);
}

extern "C" void kernel_launch(void* const* d_in, const int* in_sizes, int n_in, void* d_out, int out_size, void* d_ws, size_t ws_size, hipStream_t stream) {
    Params p{};
    p.x = (const float*)d_in[0]; p.pos = (const int*)d_in[1]; p.norm_mix = (const float*)d_in[2]; p.norm_ffn = (const float*)d_in[3]; p.norm_final = (const float*)d_in[4];
    p.gla_w_in = (const float*)d_in[5]; p.gla_wgu = (const float*)d_in[6]; p.gla_bg = (const float*)d_in[7]; p.gla_norm = (const float*)d_in[8]; p.gla_w_out = (const float*)d_in[9];
    p.diff_w_in = (const float*)d_in[10]; p.lq1 = (const float*)d_in[11]; p.lk1 = (const float*)d_in[12]; p.lq2 = (const float*)d_in[13]; p.lk2 = (const float*)d_in[14];
    p.diff_norm = (const float*)d_in[15]; p.diff_w_out = (const float*)d_in[16];
    p.peer_wq = (const float*)d_in[17]; p.peer_sk = (const float*)d_in[18]; p.peer_u = (const float*)d_in[19]; p.peer_v = (const float*)d_in[20];
    p.out = (float*)d_out; p.ws = (char*)d_ws;
    static int grid = 0;
    if (grid == 0) {
        int dev = 0, cus = 0, per_cu = 0;
        hipGetDevice(&dev);
        hipDeviceGetAttribute(&cus, hipDeviceAttributeMultiprocessorCount, dev);
        hipFuncSetAttribute((const void*)mega_fwd, hipFuncAttributeMaxDynamicSharedMemorySize, MEGA_LDS_BYTES);
        hipOccupancyMaxActiveBlocksPerMultiprocessor(&per_cu, (const void*)mega_fwd, 512, MEGA_LDS_BYTES);
        (void)hipGetLastError();
        if (per_cu < 1) per_cu = 1;
        if (cus < 1) cus = 256;
        grid = cus * (per_cu < 1 ? per_cu : 1);
    }
    hipMemsetAsync((char*)d_ws + WS_BAR, 0, XCD_BAR_WORDS * sizeof(unsigned), stream);
    mega_fwd<<<grid, 512, MEGA_LDS_BYTES, stream>>>(p);
}
```

```cpp
#include <hip/hip_runtime.h>
#include <stdint.h>

#define DI __device__ __forceinline__
typedef unsigned short u16;
typedef __attribute__((ext_vector_type(8))) short bf16x8;
typedef __attribute__((ext_vector_type(16))) float f32x16;
typedef __attribute__((ext_vector_type(2))) __bf16 bf2_t;
typedef __attribute__((ext_vector_type(4))) unsigned u32x4;
typedef __attribute__((ext_vector_type(2))) unsigned u32x2;
typedef __attribute__((ext_vector_type(4))) float f32x4;
#define MFMA32(a, b, c) __builtin_amdgcn_mfma_f32_32x32x16_bf16((a), (b), (c), 0, 0, 0)

constexpr int T_TOK = 32768, SEQ = 16384, DM = 1024;
constexpr int GLA_NPAD = 3328;
constexpr int NTHR = 256;

constexpr size_t MB = 1024ull * 1024ull;
constexpr size_t WS_BAR    = 0;
constexpr size_t WS_ROPE   = 64 * 1024;
constexpr size_t WS_WGIN   = WS_ROPE + 2 * MB;
constexpr size_t WS_WGOUT  = WS_WGIN + (size_t)GLA_NPAD * 1024 * 2;
constexpr size_t WS_WDIN   = WS_WGOUT + 2 * MB;
constexpr size_t WS_WDOUT  = WS_WDIN + 6 * MB;
constexpr size_t WS_WPQ    = WS_WDOUT + 2 * MB;
constexpr size_t WS_SK     = WS_WPQ + 8 * MB;
constexpr size_t WS_GLR    = WS_SK + 1 * MB;
constexpr size_t WS_DEC    = WS_GLR + 2 * MB;
constexpr size_t WS_TAB    = WS_DEC + 1 * MB;
constexpr size_t WS_HN     = WS_TAB + 64 * MB;
constexpr size_t WS_PROJ   = WS_HN + 64 * MB;
constexpr size_t WS_KV     = WS_PROJ + 192 * MB;
constexpr size_t WS_END    = WS_KV + 128 * MB;
static_assert(WS_END <= 512 * MB, "workspace overflow");
constexpr size_t WS_VT     = WS_PROJ + 128 * MB;
constexpr size_t WS_IDX    = WS_KV;
constexpr size_t WS_GATE   = WS_KV + 16 * MB;
constexpr size_t WS_DOT    = WS_KV + 32 * MB;

struct Params {
    const float* x; const int* pos; const float* norm_mix; const float* norm_ffn; const float* norm_final;
    const float* gla_w_in; const float* gla_wgu; const float* gla_bg; const float* gla_norm; const float* gla_w_out;
    const float* diff_w_in; const float* lq1; const float* lk1; const float* lq2; const float* lk2;
    const float* diff_norm; const float* diff_w_out;
    const float* peer_wq; const float* peer_sk; const float* peer_u; const float* peer_v;
    float* out; char* ws;
    int wv; int pad_;
};

DI int opaque_tid(const Params& p) { int l; asm volatile("v_mbcnt_lo_u32_b32 %0, -1, 0\n\tv_mbcnt_hi_u32_b32 %0, -1, %0" : "=v"(l)); return (p.wv << 6) | l; }
DI int opaque_tid8(const Params& p) { int l; asm volatile("v_mbcnt_lo_u32_b32 %0, -1, 0\n\tv_mbcnt_hi_u32_b32 %0, -1, %0" : "=v"(l)); return (p.pad_ << 6) | l; }
DI unsigned pk2(float a, float b) { bf2_t v = {(__bf16)a, (__bf16)b}; return __builtin_bit_cast(unsigned, v); }
DI u16 f2bf(float a) { return (u16)(pk2(a, 0.f) & 0xffffu); }
DI float bflo(unsigned w) { return __uint_as_float(w << 16); }
DI float bfhi(unsigned w) { return __uint_as_float(w & 0xffff0000u); }
DI float bf2f(u16 h) { return __uint_as_float(((unsigned)h) << 16); }
DI int xcd_unit(int j, int bid, int nb) { return ((nb & 7) == 0) ? j * nb + (bid & 7) * (nb >> 3) + (bid >> 3) : j * nb + bid; }
DI int crow(int i, int half) { return (i & 3) + 8 * (i >> 2) + 4 * half; }
template <int MASK> DI unsigned sxu(unsigned v, int half) {
    if constexpr (MASK < 32) return (unsigned)__builtin_amdgcn_ds_swizzle((int)v, (MASK << 10) | 0x1f);
    else { auto r = __builtin_amdgcn_permlane32_swap(v, v, false, false); return half ? r[0] : r[1]; }
}
template <int MASK> DI float sxf(float v, int half) { return __uint_as_float(sxu<MASK>(__float_as_uint(v), half)); }
template <int MASK> DI int sxi(int v, int half) { return (int)sxu<MASK>((unsigned)v, half); }
DI float wave_sum(float v, int half) { v += sxf<32>(v, half); v += sxf<16>(v, half); v += sxf<8>(v, half); v += sxf<4>(v, half); v += sxf<2>(v, half); v += sxf<1>(v, half); return v; }
DI f32x16 zero16() { f32x16 z; for (int i = 0; i < 16; ++i) z[i] = 0.f; return z; }
DI bf16x8 lds_frag(const char* p) { return *(const bf16x8*)p; }
DI bf16x8 lds_frag2(const char* p0, const char* p1) {
    u32x2 a = *(const u32x2*)p0, b = *(const u32x2*)p1; u32x4 r = {a.x, a.y, b.x, b.y}; return __builtin_bit_cast(bf16x8, r);
}
DI bf16x8 pack8(const f32x16& x, int s) {
    u32x4 r = {pk2(x[8 * s], x[8 * s + 1]), pk2(x[8 * s + 2], x[8 * s + 3]), pk2(x[8 * s + 4], x[8 * s + 5]), pk2(x[8 * s + 6], x[8 * s + 7])};
    return __builtin_bit_cast(bf16x8, r);
}
#define XB_TMO      128
#define XB_XCNT(j)  (256  + 64 * (j))
#define XB_XSUB(j)  (1280 + 64 * (j))
#define XB_XGEN(j)  (2304 + 64 * (j))
#define XB_TOP      3328
#define XB_TOPGEN   3392
#define XCD_BAR_WORDS 3456
#define XB_SPIN_CAP (1u << 18)
#define LAS __attribute__((address_space(3)))

__device__ __forceinline__ unsigned xb_ld(unsigned* p)              { return __hip_atomic_load(p, __ATOMIC_RELAXED, __HIP_MEMORY_SCOPE_AGENT); }
__device__ __forceinline__ unsigned xb_add(unsigned* p, unsigned v) { return __hip_atomic_fetch_add(p, v, __ATOMIC_RELAXED, __HIP_MEMORY_SCOPE_AGENT); }
__device__ __forceinline__ unsigned xb_xcc_id() { return (unsigned)__builtin_amdgcn_s_getreg((3 << 11) | 20) & 0xFu; }
#define XB_SPIN(cond, bar) do { unsigned _sp = 0; while (cond) { __builtin_amdgcn_s_sleep(1); \
    if ((++_sp & 255u) == 0u) { if (xb_ld(&(bar)[XB_TMO])) break; if (_sp > XB_SPIN_CAP) { atomicAdd(&(bar)[XB_TMO], 1u); break; } } } } while (0)

struct XcdBarrier {
    unsigned* bar; unsigned x;
    volatile LAS unsigned* st;
};

__device__ __forceinline__ XcdBarrier xcd_barrier_post(unsigned* bar, volatile LAS unsigned* st, bool t0) {
    XcdBarrier b; b.bar = bar; b.x = xb_xcc_id(); b.st = st;
    if (t0) (void)xb_add(&bar[XB_XCNT(b.x)], 1u);
    return b;
}
__device__ __forceinline__ void xcd_barrier_complete(unsigned* bar, unsigned x, unsigned& nloc, unsigned& nx) {
    const unsigned G = gridDim.x * gridDim.y * gridDim.z;
    unsigned sum, cnt, mine, sp = 0u;
    for (;;) {
        sum = 0u; cnt = 0u; mine = 0u;
#pragma unroll
        for (unsigned j = 0; j < 16; ++j) { const unsigned c = xb_ld(&bar[XB_XCNT(j)]); sum += c; cnt += (c > 0u) ? 1u : 0u; mine = (j == x) ? c : mine; }
        if (sum == G) break;
        __builtin_amdgcn_s_sleep(1);
        if ((++sp & 255u) == 0u) { if (xb_ld(&bar[XB_TMO])) break; if (sp > XB_SPIN_CAP) { atomicAdd(&bar[XB_TMO], 1u); break; } }
    }
    nloc = mine > 0u ? mine : 1u; nx = cnt > 0u ? cnt : 1u;
}

__device__ __forceinline__ void xcd_barrier(const XcdBarrier& b, bool t0) {
    asm volatile("s_waitcnt vmcnt(0)" ::: "memory");
    __syncthreads();
    if (t0) {
        unsigned* bar = b.bar;
        __builtin_amdgcn_s_waitcnt(0);
        unsigned nloc = b.st[0], nx = b.st[1];
        if (nloc == 0u) { xcd_barrier_complete(bar, b.x, nloc, nx); b.st[0] = nloc; b.st[1] = nx; }
        const unsigned old = xb_add(&bar[XB_XSUB(b.x)], 1u);
        const unsigned gen = old / nloc;
        if (old + 1u == (gen + 1u) * nloc) {
            __builtin_amdgcn_fence(__ATOMIC_RELEASE, "agent");
            asm volatile("s_waitcnt vmcnt(0)" ::: "memory");
            const unsigned og = xb_add(&bar[XB_TOP], 1u);
            const unsigned tg = og / nx;
            if (og + 1u == (tg + 1u) * nx) xb_add(&bar[XB_TOPGEN], 1u);
            else XB_SPIN(xb_ld(&bar[XB_TOPGEN]) == tg, bar);
            __builtin_amdgcn_fence(__ATOMIC_ACQUIRE, "agent");
            xb_add(&bar[XB_XGEN(b.x)], 1u);
            asm volatile("s_waitcnt vmcnt(0)" ::: "memory");
        } else {
            XB_SPIN(xb_ld(&bar[XB_XGEN(b.x)]) == gen, bar);
            __builtin_amdgcn_fence(__ATOMIC_ACQUIRE, "agent");
            asm volatile("s_waitcnt vmcnt(0)" ::: "memory");
        }
    }
    __syncthreads();
}
DI void rmsnorm_row_bf16(const float* __restrict__ src, const float* __restrict__ g, u16* __restrict__ dst, int lane) {
    const f32x4* xr = (const f32x4*)src;
    f32x4 a0 = xr[lane * 2], a1 = xr[lane * 2 + 1], b0 = xr[128 + lane * 2], b1 = xr[128 + lane * 2 + 1];
    float ss = a0.x * a0.x + a0.y * a0.y + a0.z * a0.z + a0.w * a0.w + a1.x * a1.x + a1.y * a1.y + a1.z * a1.z + a1.w * a1.w
             + b0.x * b0.x + b0.y * b0.y + b0.z * b0.z + b0.w * b0.w + b1.x * b1.x + b1.y * b1.y + b1.z * b1.z + b1.w * b1.w;
    ss = wave_sum(ss, lane >> 5);
    const float r = rsqrtf(ss * (1.f / 1024.f) + 1e-6f);
    const f32x4* gr = (const f32x4*)g;
    f32x4 g0 = gr[lane * 2], g1 = gr[lane * 2 + 1], g2 = gr[128 + lane * 2], g3 = gr[128 + lane * 2 + 1];
    u32x4 o0 = u32x4{pk2(a0.x * r * g0.x, a0.y * r * g0.y), pk2(a0.z * r * g0.z, a0.w * r * g0.w), pk2(a1.x * r * g1.x, a1.y * r * g1.y), pk2(a1.z * r * g1.z, a1.w * r * g1.w)};
    u32x4 o1 = u32x4{pk2(b0.x * r * g2.x, b0.y * r * g2.y), pk2(b0.z * r * g2.z, b0.w * r * g2.w), pk2(b1.x * r * g3.x, b1.y * r * g3.y), pk2(b1.z * r * g3.z, b1.w * r * g3.w)};
    ((u32x4*)dst)[lane] = o0;
    ((u32x4*)dst)[64 + lane] = o1;
}

DI void tconv_item(const float* __restrict__ src, u16* __restrict__ dst, int K, int N, int item, int lane) {
    const int kgroups = K >> 3;
    const int ng = item / kgroups, kg = item - ng * kgroups;
    const int n = ng * 64 + lane, k0 = kg * 8;
    float v[8];
#pragma unroll
    for (int i = 0; i < 8; ++i) v[i] = (n < N) ? src[(size_t)(k0 + i) * N + n] : 0.f;
    u32x4 o = u32x4{pk2(v[0], v[1]), pk2(v[2], v[3]), pk2(v[4], v[5]), pk2(v[6], v[7])};
    *(u32x4*)(dst + (size_t)n * K + k0) = o;
}

DI void conv8(const float* __restrict__ src, u16* __restrict__ dst, size_t i8) {
    const f32x4* s = (const f32x4*)(src + i8 * 8);
    f32x4 a = s[0], b = s[1];
    *(u32x4*)(dst + i8 * 8) = u32x4{pk2(a.x, a.y), pk2(a.z, a.w), pk2(b.x, b.y), pk2(b.z, b.w)};
}

DI void phase_prep_a(const Params& p, int bid, int nb) {
    const int wave = opaque_tid(p) >> 6, lane = opaque_tid(p) & 63;
    const int gw = bid * 4 + wave, nw = nb * 4;
    char* ws = p.ws;
    for (int t = gw; t < T_TOK; t += nw) rmsnorm_row_bf16(p.x + (size_t)t * DM, p.norm_mix, (u16*)(ws + WS_HN) + (size_t)t * DM, lane);
    const int n0 = (GLA_NPAD / 64) * 128, n1 = n0 + 16 * 128;
    for (int it = gw; it < n1; it += nw) {
        if (it < n0) tconv_item(p.gla_w_in, (u16*)(ws + WS_WGIN), 1024, 3088, it, lane);
        else         tconv_item(p.gla_w_out, (u16*)(ws + WS_WGOUT), 1024, 1024, it - n0, lane);
    }
}
DI void phase_prep_b(const Params& p, int bid, int nb) {
    const int wave = opaque_tid(p) >> 6, lane = opaque_tid(p) & 63;
    const int gw = bid * 4 + wave, nw = nb * 4;
    char* ws = p.ws;
    {
        const int n2 = 48 * 128, n3 = n2 + 16 * 128, n4 = n3 + 32 * 128, n5 = n4 + 32 * 128;
        for (int it = gw; it < n5; it += nw) {
            if (it < n2)      tconv_item(p.diff_w_in, (u16*)(ws + WS_WDIN), 1024, 3072, it, lane);
            else if (it < n3) tconv_item(p.diff_w_out, (u16*)(ws + WS_WDOUT), 1024, 1024, it - n2, lane);
            else if (it < n4) tconv_item(p.peer_wq, (u16*)(ws + WS_WPQ), 1024, 2048, it - n3, lane);
            else              tconv_item(p.peer_wq + (size_t)1024 * 2048, (u16*)(ws + WS_WPQ) + (size_t)2048 * 1024, 1024, 2048, it - n4, lane);
        }
    }
    for (int i = gw * 64 + lane; i < 65536; i += nw * 64) conv8(p.peer_sk, (u16*)(ws + WS_SK), (size_t)i);
    for (int i = gw * 64 + lane; i < T_TOK * 8; i += nw * 64) {
        const int t = i >> 3, f = i & 7;
        const float inv = exp2f(-(float)f * (18.931568569324174f / 8.f));
        const float ang = (float)p.pos[t] * inv;
        float sn, cs; sincosf(ang, &sn, &cs);
        ((float2*)(ws + WS_ROPE))[i] = make_float2(cs, sn);
    }
}

constexpr float TAB_SCALE_U = 64.f, TAB_SCALE_V = 6.f;
DI float clamp6(float a) { return fminf(fmaxf(a, -6.f), 6.f); }
DI unsigned pk8_fp4(f32x4 a, f32x4 b, float s) {
    unsigned w = 0;
    w = __builtin_amdgcn_cvt_scalef32_pk_fp4_f32(w, clamp6(a.x * s), clamp6(a.y * s), 1.0f, 0);
    w = __builtin_amdgcn_cvt_scalef32_pk_fp4_f32(w, clamp6(a.z * s), clamp6(a.w * s), 1.0f, 1);
    w = __builtin_amdgcn_cvt_scalef32_pk_fp4_f32(w, clamp6(b.x * s), clamp6(b.y * s), 1.0f, 2);
    w = __builtin_amdgcn_cvt_scalef32_pk_fp4_f32(w, clamp6(b.z * s), clamp6(b.w * s), 1.0f, 3);
    return w;
}
constexpr float TAB_SCALE_UI = 90.f;
DI unsigned pk8_i4(f32x4 a, f32x4 b, float s) {
    const float f[8] = {a.x, a.y, a.z, a.w, b.x, b.y, b.z, b.w};
    unsigned w = 0;
#pragma unroll
    for (int j = 0; j < 8; ++j) { const int q = (int)rintf(fminf(fmaxf(f[j] * s, -7.f), 7.f)); w |= ((unsigned)q & 15u) << (4 * j); }
    return w;
}
DI void phase_tabconv(const Params& p, int layer, int bid, int nb) {
    const size_t n16 = (size_t)16384 * 1024 / 16;
    const float* su = p.peer_u + (size_t)layer * 16384 * 1024;
    const float* sv = p.peer_v + (size_t)layer * 16384 * 1024;
    unsigned char* du = (unsigned char*)(p.ws + WS_TAB) + (size_t)layer * 16 * MB; unsigned char* dv = du + (size_t)16384 * 512;
    for (size_t i = (size_t)bid * NTHR + opaque_tid(p); i < n16; i += (size_t)nb * NTHR) {
        const f32x4* a = (const f32x4*)(su + i * 16); const f32x4* b = (const f32x4*)(sv + i * 16);
        const f32x4 a0 = __builtin_nontemporal_load(a), a1 = __builtin_nontemporal_load(a + 1), a2 = __builtin_nontemporal_load(a + 2), a3 = __builtin_nontemporal_load(a + 3);
        const f32x4 b0 = __builtin_nontemporal_load(b), b1 = __builtin_nontemporal_load(b + 1), b2 = __builtin_nontemporal_load(b + 2), b3 = __builtin_nontemporal_load(b + 3);
        *(u32x2*)(du + i * 8) = u32x2{pk8_i4(a0, a1, TAB_SCALE_UI), pk8_i4(a2, a3, TAB_SCALE_UI)};
        *(u32x2*)(dv + i * 8) = u32x2{pk8_fp4(b0, b1, TAB_SCALE_V), pk8_fp4(b2, b3, TAB_SCALE_V)};
    }
}

DI void phase_rmsnorm(const Params& p, const float* g, int bid, int nb) {
    const int wave = opaque_tid(p) >> 6, lane = opaque_tid(p) & 63;
    for (int t = bid * 4 + wave; t < T_TOK; t += nb * 4) rmsnorm_row_bf16(p.out + (size_t)t * DM, g, (u16*)(p.ws + WS_HN) + (size_t)t * DM, lane);
}
constexpr int G_ROW = 64;
constexpr int G_SLOT = 384 * G_ROW;
constexpr int G_LDS_BYTES = 3 * G_SLOT;
DI const char* uni_ptr(const char* p) {
    const unsigned long long v = (unsigned long long)p;
    const unsigned lo = __builtin_amdgcn_readfirstlane((unsigned)v), hi = __builtin_amdgcn_readfirstlane((unsigned)(v >> 32));
    return (const char*)(((unsigned long long)hi << 32) | lo);
}
DI void dma16(const char* ubase, unsigned voff, char* lds_wave_base) { __builtin_amdgcn_global_load_lds((const unsigned*)(uni_ptr(ubase) + voff), (unsigned*)lds_wave_base, 16, 0, 0); }

template <int WM, int WN, int BROWS = 128, int AROWS = 128, int NW = 4>
DI void gemm_mainloop(const Params& p, const u16* __restrict__ A, int ld, const u16* __restrict__ Bt, int  , int K, char* smem, int wm0, int wn0, f32x16 (&acc)[WM][WN], int wave_in = -1) {
    static_assert((AROWS % (16 * NW)) == 0 && (BROWS % (16 * NW)) == 0, "slot shape");
    constexpr int SLOT = (AROWS + BROWS) * G_ROW, NP = (AROWS + BROWS) / (16 * NW);
    static_assert(NP == 6 || NP == 3 || NP == 4, "counted waits below");
    const int tid = opaque_tid(p), lane = tid & 63, r = lane & 31, half = lane >> 5;
    const int wave = (wave_in < 0) ? p.wv : wave_in;
    const unsigned voff = (unsigned)(lane >> 2) * (unsigned)(ld * 2) + (unsigned)(((lane & 3) ^ ((lane >> 4) & 3)) << 4);
    const char* ab = (const char*)A + (size_t)(wave * 16) * ld * 2;
    const char* bb = (const char*)Bt + (size_t)(wave * 16) * ld * 2;
    const size_t pstep = (size_t)(16 * NW) * ld * 2;
    char* dbase = smem + wave * 1024;
    constexpr int NPA = AROWS / (16 * NW), NPB = BROWS / (16 * NW);
#define G_ISSUE(kt_, slot_) do { const size_t ko_ = (size_t)(kt_) * 64; char* d_ = dbase + (slot_) * SLOT; \
        _Pragma("unroll") for (int i_ = 0; i_ < NPA; ++i_) dma16(ab + i_ * pstep + ko_, voff, d_ + i_ * (NW * 1024)); \
        _Pragma("unroll") for (int i_ = 0; i_ < NPB; ++i_) dma16(bb + i_ * pstep + ko_, voff, d_ + AROWS * G_ROW + i_ * (NW * 1024)); } while (0)
    const int nk = K >> 5;
    asm volatile("s_waitcnt vmcnt(0)\n\ts_barrier" ::: "memory");
    G_ISSUE(0, 0); G_ISSUE(1, 1); G_ISSUE(2, 2);
    const int sw = (r >> 2) & 3;
    const int fo0 = r * G_ROW + ((half ^ sw) << 4), fo1 = r * G_ROW + (((2 + half) ^ sw) << 4);
    int slot = 0;
    for (int kt = 0; kt < nk; ++kt) {
        if constexpr (NP == 6) {
            if (kt + 2 < nk)      asm volatile("s_waitcnt vmcnt(12)\n\ts_barrier" ::: "memory");
            else if (kt + 1 < nk) asm volatile("s_waitcnt vmcnt(6)\n\ts_barrier" ::: "memory");
            else                  asm volatile("s_waitcnt vmcnt(0)\n\ts_barrier" ::: "memory");
        } else if constexpr (NP == 4) {
            if (kt + 2 < nk)      asm volatile("s_waitcnt vmcnt(8)\n\ts_barrier" ::: "memory");
            else if (kt + 1 < nk) asm volatile("s_waitcnt vmcnt(4)\n\ts_barrier" ::: "memory");
            else                  asm volatile("s_waitcnt vmcnt(0)\n\ts_barrier" ::: "memory");
        } else {
            if (kt + 2 < nk)      asm volatile("s_waitcnt vmcnt(6)\n\ts_barrier" ::: "memory");
            else if (kt + 1 < nk) asm volatile("s_waitcnt vmcnt(3)\n\ts_barrier" ::: "memory");
            else                  asm volatile("s_waitcnt vmcnt(0)\n\ts_barrier" ::: "memory");
        }
        const char* As = smem + slot * SLOT; const char* Bs = As + AROWS * G_ROW;
        bf16x8 af[2][WM], bfr[2][WN];
#pragma unroll
        for (int ks = 0; ks < 2; ++ks) {
            const int fo = ks ? fo1 : fo0;
#pragma unroll
            for (int i = 0; i < WM; ++i) af[ks][i] = lds_frag(As + (wm0 + 32 * i) * G_ROW + fo);
#pragma unroll
            for (int j = 0; j < WN; ++j) bfr[ks][j] = lds_frag(Bs + (wn0 + 32 * j) * G_ROW + fo);
        }
        asm volatile("s_waitcnt lgkmcnt(0)\n\ts_barrier" ::: "memory");
        if (kt + 3 < nk) G_ISSUE(kt + 3, slot);
#pragma unroll
        for (int ks = 0; ks < 2; ++ks)
#pragma unroll
            for (int i = 0; i < WM; ++i)
#pragma unroll
                for (int j = 0; j < WN; ++j) acc[i][j] = MFMA32(af[ks][i], bfr[ks][j], acc[i][j]);
        slot = (slot == 2) ? 0 : slot + 1;
    }
#undef G_ISSUE
}

enum { EPI_GLA_IN = 0, EPI_RESID = 1, EPI_DIFF_IN = 2 };

template <int EPI, int BN = 256>
DI void gemm_phase(const Params& p, const u16* A, const u16* Bt, int N, const float* resid, char* smem, int bid, int nb) {
    constexpr int TN = BN / 64;
    const int ntn = N / BN, ntm = T_TOK / 128;
    const int tid = opaque_tid(p), wave = tid >> 6, lane = tid & 63, r = lane & 31, half = lane >> 5;
    const int wm0 = (wave >> 1) * 64, wn0 = (wave & 1) * (BN / 2);
    for (int j = 0; j * nb < ntn * ntm; ++j) {
        const int u = xcd_unit(j, bid, nb);
        if (u >= ntn * ntm) continue;
        const int mt = u / ntn, nt = u - mt * ntn;
        const int m0 = mt * 128, n0 = nt * BN;
        f32x16 acc[2][TN];
#pragma unroll
        for (int i = 0; i < 2; ++i)
#pragma unroll
            for (int j = 0; j < TN; ++j) acc[i][j] = zero16();
        gemm_mainloop<2, TN, BN>(p, A + (size_t)m0 * 1024, 1024, Bt + (size_t)n0 * 1024, 1024, 1024, smem, wm0, wn0, acc);
        if constexpr (EPI == EPI_RESID) {
#pragma unroll
            for (int ti = 0; ti < 2; ++ti)
#pragma unroll
                for (int tj0 = 0; tj0 < TN; tj0 += 2) {
                    float rv[2][16];
#pragma unroll
                    for (int tt = 0; tt < 2; ++tt)
#pragma unroll
                        for (int i = 0; i < 16; ++i) rv[tt][i] = resid[(size_t)(m0 + wm0 + 32 * ti + crow(i, half)) * 1024 + n0 + wn0 + 32 * (tj0 + tt) + r];
#pragma unroll
                    for (int tt = 0; tt < 2; ++tt)
#pragma unroll
                        for (int i = 0; i < 16; ++i) p.out[(size_t)(m0 + wm0 + 32 * ti + crow(i, half)) * 1024 + n0 + wn0 + 32 * (tj0 + tt) + r] = rv[tt][i] + acc[ti][tj0 + tt][i];
                }
        } else
#pragma unroll
        for (int ti = 0; ti < 2; ++ti)
#pragma unroll
            for (int tj = 0; tj < TN; ++tj) {
                const int col = n0 + wn0 + 32 * tj + r;
                const int rowb = m0 + wm0 + 32 * ti;
                if constexpr (EPI == EPI_GLA_IN) {
                    u16* o = (u16*)(p.ws + WS_PROJ);
#pragma unroll
                    for (int i = 0; i < 16; ++i) o[(size_t)(rowb + crow(i, half)) * 3072 + col] = f2bf(acc[ti][tj][i]);
                } else if constexpr (EPI == EPI_RESID) {
#pragma unroll
                    for (int i = 0; i < 16; ++i) {
                        const size_t off = (size_t)(rowb + crow(i, half)) * 1024 + col;
                        p.out[off] = resid[off] + acc[ti][tj][i];
                    }
                } else if constexpr (EPI == EPI_DIFF_IN) {
                    if (col < 2048) {
                        const int c64 = col & 63;
                        const float qs = (col < 1024) ? 0.125f * 1.4426950408889634f : 1.0f;
                        const float2* cst = (const float2*)(p.ws + WS_ROPE);
                        u16* o = (u16*)(p.ws + WS_PROJ);
                        const bool rot = ((32 * tj) & 63) == 0;
                        float2 csr[16];
                        if (rot) {
#pragma unroll
                            for (int i = 0; i < 16; ++i) csr[i] = cst[(size_t)(rowb + crow(i, half)) * 8 + (c64 & 7)];
                        }
#pragma unroll
                        for (int i = 0; i < 16; ++i) {
                            const int row = rowb + crow(i, half);
                            float v = acc[ti][tj][i];
                            if (rot) {
                                const float pv = sxf<8>(v, half);
                                const float2 cs = csr[i];
                                if (c64 < 16) v = (c64 < 8) ? (v * cs.x - pv * cs.y) : (v * cs.x + pv * cs.y);
                            }
                            o[(size_t)row * 2048 + col] = f2bf(v * qs);
                        }
                    } else {
                        const int hv = (col - 2048) >> 7, dv = (col - 2048) & 127;
                        const int b = rowb >> 14, s0 = rowb & (SEQ - 1);
                        u16* o = (u16*)(p.ws + WS_VT) + ((size_t)(b * 8 + hv) * 128 + dv) * SEQ + s0;
#pragma unroll
                        for (int g = 0; g < 4; ++g) {
                            u32x2 w = {pk2(acc[ti][tj][4 * g], acc[ti][tj][4 * g + 1]), pk2(acc[ti][tj][4 * g + 2], acc[ti][tj][4 * g + 3])};
                            *(u32x2*)(o + 16 * (g >> 1) + 8 * half + 4 * (g & 1)) = w;
                        }
                    }
                }
            }
    }
}
namespace pg8 {
#define PG8_LAS __attribute__((address_space(3)))
typedef unsigned short bf16_t;
typedef short bf16x8 __attribute__((ext_vector_type(8)));
typedef float f32x4 __attribute__((ext_vector_type(4)));
typedef unsigned u32x4 __attribute__((ext_vector_type(4)));
constexpr int BM = 256, BK = 64, HALF = 128, HTB = HALF * BK * 2  , STAGE_BYTES = 8 * HTB, NXCD = 8, WGM = 8;

__host__ __device__ __forceinline__ int lds_byte(int r, int c) { const int st = (r >> 4) * 2 + (c >> 5), rr = r & 15, cc = c & 31, ob = rr * 64 + cc * 2; return st * 1024 + (ob ^ (((ob >> 9) & 1) << 5)); }
__host__ __device__ __forceinline__ void stage_rc(int b, int& R, int& C) { const int st = b / 1024, sb = b % 1024, swz = sb ^ (((sb >> 9) & 1) << 5); R = (st >> 1) * 16 + swz / 64; C = (st & 1) * 32 + (swz % 64) / 2; }
__host__ __device__ __forceinline__ int perm32(int rho) { const int n = rho >> 4, i = rho & 15; return 8 * (i >> 2) + 4 * n + (i & 3); }

struct Unit { int pm, pn; };
struct Gemm { const bf16_t* A; const bf16_t* Bt; int M, N, K; };

struct StaticOrder {
    int nM, nN, nwg, G, c;
    __host__ __device__ void init(int M, int N, int G_, int c_) { nM = M / BM; nN = N / BM; nwg = nM * nN; G = G_; c = c_; }
    __host__ __device__ bool next(int i, Unit& u) const {
        const long L = (long)i * G + c; if (L >= nwg) return false;
        int wgid = (int)L; { const int q = nwg / NXCD, r = nwg % NXCD, xcd = wgid % NXCD, off = wgid / NXCD; wgid = (xcd < r ? xcd * (q + 1) : r * (q + 1) + (xcd - r) * q) + off; }
        const int nig = WGM * nN, gid = wgid / nig, fm = gid * WGM, gsz = (nM - fm) < WGM ? (nM - fm) : WGM;
        u.pm = fm + ((wgid % nig) % gsz); u.pn = (wgid % nig) / gsz; return true;
    }
    __device__ __forceinline__ void a_ready(const Unit&) const {}
    __device__ __forceinline__ void done(const Unit&) const {}
};
template <class Epi, class Sched>
__device__ __forceinline__ void gemm_phase(PG8_LAS unsigned char* lds, const Gemm g, const Sched& S, const Epi& E, const int tid) {
    const int wid = __builtin_amdgcn_readfirstlane(tid >> 6), lane = tid & 63, wr = wid >> 2, wc = wid & 3, fr = lane & 15, fq = lane >> 4;
    const int K = g.K, nt = K / BK;
    unsigned voffA[2], voffB[2];
#pragma unroll
    for (int i = 0; i < 2; ++i) { int R, C; stage_rc(tid * 16 + i * 8192, R, C); const int Rb = Epi::PERM ? ((R & ~31) + perm32(R & 31)) : R;
        voffA[i] = (unsigned)(R * K + C) * 2u; voffB[i] = (unsigned)(Rb * K + C) * 2u; }
    const size_t kstep = (size_t)(BK * 2);
    const size_t hstep = (size_t)HALF * K * 2;
    const size_t tstep = 2 * hstep;
    const unsigned ldsw = (unsigned)wid * 1024u;
    const int aoff = lds_byte(wr * 64 + fr, fq * 8), boff = lds_byte(wc * 32 + fr, fq * 8);
#define PG8_SA(b, h) (((b) * 2 + (h)) * HTB)
#define PG8_SB(b, h) ((4 + (b) * 2 + (h)) * HTB)
#define PG8_STAGE(bufoff, gbase, voff) do { _Pragma("unroll") for (int _i = 0; _i < 2; ++_i) \
        __builtin_amdgcn_global_load_lds((const unsigned*)((const char*)(gbase) + (voff)[_i]), (PG8_LAS unsigned*)(lds + (bufoff) + ldsw + _i * 8192), 16, 0, 0); } while (0)
#define PG8_LDA(dst, b, h) do { _Pragma("unroll") for (int m = 0; m < 4; ++m) _Pragma("unroll") for (int k = 0; k < 2; ++k) dst[m][k] = *(const PG8_LAS bf16x8*)(lds + PG8_SA(b, h) + aoff + m * 2048 + k * 1024); } while (0)
#define PG8_LDB(dst, b, h) do { _Pragma("unroll") for (int n = 0; n < 2; ++n) _Pragma("unroll") for (int k = 0; k < 2; ++k) dst[n][k] = *(const PG8_LAS bf16x8*)(lds + PG8_SB(b, h) + boff + n * 2048 + k * 1024); } while (0)
#define PG8_MMA(ai, bj, At, Bt) do { __builtin_amdgcn_s_setprio(1); _Pragma("unroll") for (int m = 0; m < 4; ++m) _Pragma("unroll") for (int n = 0; n < 2; ++n) _Pragma("unroll") for (int k = 0; k < 2; ++k) \
        acc[ai][bj][m][n] = __builtin_amdgcn_mfma_f32_16x16x32_bf16(Bt[n][k], At[m][k], acc[ai][bj][m][n], 0, 0, 0); __builtin_amdgcn_s_setprio(0); } while (0)
#define PG8_WAIT_V(n) asm volatile("s_waitcnt vmcnt(" #n ")" ::: "memory")
#define PG8_WAIT_L(n) asm volatile("s_waitcnt lgkmcnt(" #n ")" ::: "memory")
#define PG8_BAR __builtin_amdgcn_s_barrier()
#define PG8_SCHED __builtin_amdgcn_sched_barrier(0)
    Unit cur, nxt; int ui = 0;
    if (!S.next(0, cur)) return;
    f32x4 acc[2][2][4][2];
#pragma unroll
    for (int a = 0; a < 2; ++a)
#pragma unroll
        for (int b = 0; b < 2; ++b)
#pragma unroll
            for (int m = 0; m < 4; ++m)
#pragma unroll
                for (int n = 0; n < 2; ++n) acc[a][b][m][n] = (f32x4){0.f, 0.f, 0.f, 0.f};
    bf16x8 At[4][2], B0[2][2], B1[2][2];
    const char* cA = (const char*)g.A + (size_t)cur.pm * tstep; const char* cB = (const char*)g.Bt + (size_t)cur.pn * tstep;
    S.a_ready(cur);
    PG8_STAGE(PG8_SB(0, 0), cB, voffB); PG8_STAGE(PG8_SA(0, 0), cA, voffA); PG8_STAGE(PG8_SB(0, 1), cB + hstep, voffB); PG8_STAGE(PG8_SA(0, 1), cA + hstep, voffA);
    if (wr == 1) PG8_BAR;
    PG8_WAIT_V(4); PG8_BAR;
    PG8_STAGE(PG8_SB(1, 0), cB + kstep, voffB); PG8_STAGE(PG8_SA(1, 0), cA + kstep, voffA); PG8_STAGE(PG8_SB(1, 1), cB + hstep + kstep, voffB);
    PG8_WAIT_V(6); PG8_BAR;
    for (;;) {
        const bool has_next = S.next(ui + 1, nxt);
        const char* nA = has_next ? (const char*)g.A + (size_t)nxt.pm * tstep : cA; const char* nB = has_next ? (const char*)g.Bt + (size_t)nxt.pn * tstep : cB;
        for (int t = 0; t < nt; t += 2) {
            const bool last = (t == nt - 2);
            const char* a1 = cA + (size_t)(t + 1) * kstep;
            const char* a2 = last ? nA : cA + (size_t)(t + 2) * kstep; const char* b2 = last ? nB : cB + (size_t)(t + 2) * kstep;
            const char* a3 = a2 + kstep; const char* b3 = b2 + kstep;
            if (last && has_next) S.a_ready(nxt);
            PG8_LDB(B0, 0, 0); PG8_SCHED; PG8_LDA(At, 0, 0); PG8_STAGE(PG8_SA(1, 1), a1 + hstep, voffA);
            PG8_WAIT_L(8); PG8_BAR; PG8_WAIT_L(0); PG8_MMA(0, 0, At, B0); PG8_BAR; PG8_SCHED;
            PG8_LDB(B1, 0, 1); PG8_STAGE(PG8_SB(0, 0), b2, voffB);
            PG8_BAR; PG8_WAIT_L(0); PG8_MMA(0, 1, At, B1); PG8_BAR;
            PG8_LDA(At, 0, 1); PG8_STAGE(PG8_SA(0, 0), a2, voffA);
            PG8_BAR; PG8_WAIT_L(0); PG8_MMA(1, 0, At, B0); PG8_BAR; PG8_SCHED;
            PG8_STAGE(PG8_SB(0, 1), b2 + hstep, voffB);
            PG8_WAIT_V(6); PG8_BAR; PG8_MMA(1, 1, At, B1); PG8_BAR;
            PG8_LDB(B0, 1, 0); PG8_SCHED; PG8_LDA(At, 1, 0); PG8_STAGE(PG8_SA(0, 1), a2 + hstep, voffA);
            PG8_WAIT_L(8); PG8_BAR; PG8_WAIT_L(0); PG8_MMA(0, 0, At, B0); PG8_BAR; PG8_SCHED;
            PG8_LDB(B1, 1, 1); PG8_STAGE(PG8_SB(1, 0), b3, voffB);
            PG8_BAR; PG8_WAIT_L(0); PG8_MMA(0, 1, At, B1); PG8_BAR;
            PG8_LDA(At, 1, 1); PG8_STAGE(PG8_SA(1, 0), a3, voffA);
            PG8_BAR; PG8_WAIT_L(0); PG8_MMA(1, 0, At, B0); PG8_BAR; PG8_SCHED;
            PG8_STAGE(PG8_SB(1, 1), b3 + hstep, voffB);
            PG8_WAIT_V(6); PG8_BAR; PG8_MMA(1, 1, At, B1); PG8_BAR;
        }
        if constexpr (!Epi::AFTER_DRAIN) { E(acc, cur, wr, wc, fr, fq); S.done(cur); }
        if (!has_next) break;
#pragma unroll
        for (int a = 0; a < 2; ++a)
#pragma unroll
            for (int b = 0; b < 2; ++b)
#pragma unroll
                for (int m = 0; m < 4; ++m)
#pragma unroll
                    for (int n = 0; n < 2; ++n) acc[a][b][m][n] = (f32x4){0.f, 0.f, 0.f, 0.f};
        cur = nxt; cA = nA; cB = nB; ++ui;
    }
    PG8_WAIT_V(0);
    if (wr == 0) PG8_BAR;
    PG8_BAR;
    if constexpr (Epi::AFTER_DRAIN) { E.fused(acc, cur, wr, wc, fr, fq, lds, wid, lane); S.done(cur); }
#undef PG8_SA
#undef PG8_SB
#undef PG8_STAGE
#undef PG8_LDA
#undef PG8_LDB
#undef PG8_MMA
#undef PG8_WAIT_V
#undef PG8_WAIT_L
#undef PG8_BAR
#undef PG8_SCHED
}
}

struct EpiProjBf16 {
    static constexpr bool PERM = true, AFTER_DRAIN = false;
    u16* O; int ldc;
    DI void operator()(const pg8::f32x4 (&acc)[2][2][4][2], const pg8::Unit& u, int wr, int wc, int fr, int fq) const {
        const int row0 = u.pm * 256 + wr * 64 + fr, col0 = u.pn * 256 + wc * 32 + 8 * fq;
#pragma unroll
        for (int ai = 0; ai < 2; ++ai)
#pragma unroll
            for (int m = 0; m < 4; ++m) {
                u16* rowp = O + (size_t)(row0 + ai * 128 + m * 16) * ldc + col0;
#pragma unroll
                for (int bj = 0; bj < 2; ++bj) {
                    const pg8::f32x4 v0 = acc[ai][bj][m][0], v1 = acc[ai][bj][m][1];
                    *(u32x4*)(rowp + bj * 128) = u32x4{pk2(v0[0], v0[1]), pk2(v0[2], v0[3]), pk2(v1[0], v1[1]), pk2(v1[2], v1[3])};
                }
            }
    }
};
struct EpiResid8 {
    static constexpr bool PERM = false, AFTER_DRAIN = false;
    const float* resid; float* out;
    DI void operator()(const pg8::f32x4 (&acc)[2][2][4][2], const pg8::Unit& u, int wr, int wc, int fr, int fq) const {
        const int row0 = u.pm * 256 + wr * 64 + fr, col0 = u.pn * 256 + wc * 32 + 4 * fq;
#pragma unroll
        for (int ai = 0; ai < 2; ++ai)
#pragma unroll
            for (int mp = 0; mp < 2; ++mp) {
                pg8::f32x4 rv[2][2][2];
#pragma unroll
                for (int mm = 0; mm < 2; ++mm)
#pragma unroll
                    for (int bj = 0; bj < 2; ++bj)
#pragma unroll
                        for (int n = 0; n < 2; ++n) rv[mm][bj][n] = *(const pg8::f32x4*)(resid + (size_t)(row0 + ai * 128 + (2 * mp + mm) * 16) * 1024 + col0 + bj * 128 + n * 16);
#pragma unroll
                for (int mm = 0; mm < 2; ++mm)
#pragma unroll
                    for (int bj = 0; bj < 2; ++bj)
#pragma unroll
                        for (int n = 0; n < 2; ++n) *(pg8::f32x4*)(out + (size_t)(row0 + ai * 128 + (2 * mp + mm) * 16) * 1024 + col0 + bj * 128 + n * 16) = rv[mm][bj][n] + acc[ai][bj][2 * mp + mm][n];
            }
    }
};
struct EpiDiffIn8 {
    static constexpr bool PERM = true, AFTER_DRAIN = false;
    char* ws;
    DI void operator()(const pg8::f32x4 (&acc)[2][2][4][2], const pg8::Unit& u, int wr, int wc, int fr, int fq) const {
        const int row0 = u.pm * 256 + wr * 64 + fr;
        if (u.pn < 8) {
            const float qs = (u.pn < 4) ? 0.125f * 1.4426950408889634f : 1.0f;
            u16* o = (u16*)(ws + WS_PROJ);
            const int col0 = u.pn * 256 + wc * 32 + 8 * fq;
            const bool ropew = (wc & 1) == 0;
            const float sg = (fq == 0) ? -1.f : 1.f; const bool act = fq < 2;
#pragma unroll
            for (int ai = 0; ai < 2; ++ai) {
                pg8::f32x4 cs[4][4];
                if (ropew) {
#pragma unroll
                    for (int m = 0; m < 4; ++m) { const pg8::f32x4* cp = (const pg8::f32x4*)(ws + WS_ROPE) + (size_t)(row0 + ai * 128 + m * 16) * 4;
#pragma unroll
                        for (int k = 0; k < 4; ++k) cs[m][k] = cp[k]; }
                }
#pragma unroll
                for (int m = 0; m < 4; ++m)
#pragma unroll
                    for (int bj = 0; bj < 2; ++bj) {
                        pg8::f32x4 v0 = acc[ai][bj][m][0], v1 = acc[ai][bj][m][1];
                        if (ropew) {
#pragma unroll
                            for (int j = 0; j < 4; ++j) {
                                const float p0 = sxf<16>(v0[j], 0), p1 = sxf<16>(v1[j], 0);
                                const float c0 = cs[m][j >> 1][2 * (j & 1)], s0 = cs[m][j >> 1][2 * (j & 1) + 1];
                                const float c1 = cs[m][2 + (j >> 1)][2 * (j & 1)], s1 = cs[m][2 + (j >> 1)][2 * (j & 1) + 1];
                                const float r0 = v0[j] * c0 + sg * p0 * s0, r1 = v1[j] * c1 + sg * p1 * s1;
                                v0[j] = act ? r0 : v0[j]; v1[j] = act ? r1 : v1[j];
                            }
                        }
                        *(u32x4*)(o + (size_t)(row0 + ai * 128 + m * 16) * 2048 + col0 + bj * 128) =
                            u32x4{pk2(v0[0] * qs, v0[1] * qs), pk2(v0[2] * qs, v0[3] * qs), pk2(v1[0] * qs, v1[1] * qs), pk2(v1[2] * qs, v1[3] * qs)};
                    }
            }
        } else {
            u16* vt = (u16*)(ws + WS_VT);
#pragma unroll
            for (int ai = 0; ai < 2; ++ai)
#pragma unroll
                for (int m = 0; m < 4; ++m) {
                    const int row = row0 + ai * 128 + m * 16, b = row >> 14, sq = row & (SEQ - 1);
                    const int sp = (sq & ~12) | ((sq & 4) << 1) | ((sq & 8) >> 1);
#pragma unroll
                    for (int bj = 0; bj < 2; ++bj) {
                        const int hv = 2 * (u.pn - 8) + bj, dv0 = wc * 32 + 8 * fq;
                        u16* vp = vt + ((size_t)((b * 8 + hv) * 128 + dv0)) * SEQ + sp;
                        const pg8::f32x4 v0 = acc[ai][bj][m][0], v1 = acc[ai][bj][m][1];
#pragma unroll
                        for (int j = 0; j < 4; ++j) { vp[(size_t)j * SEQ] = f2bf(v0[j]); vp[(size_t)(4 + j) * SEQ] = f2bf(v1[j]); }
                    }
                }
        }
    }
};
template <class Epi>
DI void gemm8(const Params& p, const u16* A, const u16* Bt, int N, const Epi& E) {
    extern __shared__ __attribute__((aligned(16))) char dyn_smem_g[];
    pg8::StaticOrder so; so.init(T_TOK, N, (int)gridDim.x, (int)blockIdx.x);
    pg8::Gemm g; g.A = A; g.Bt = Bt; g.M = T_TOK; g.N = N; g.K = 1024;
    pg8::gemm_phase((PG8_LAS unsigned char*)dyn_smem_g, g, so, E, opaque_tid8(p));
}
DI void gla_glr_phase(const Params& p, char* smem, int bid, int nb) {
    const int tid = opaque_tid(p), wave = tid >> 6, lane = tid & 63, r = lane & 31, half = lane >> 5;
    const u16* hn = (const u16*)(p.ws + WS_HN);
    const u16* wg = (const u16*)(p.ws + WS_WGIN) + (size_t)3072 * 1024;
    for (int u = bid; u < T_TOK / 128; u += nb) {
        const int m0 = u * 128;
        f32x16 acc[1][2];
        acc[0][0] = zero16(); acc[0][1] = zero16();
        gemm_mainloop<1, 2, 64, 128>(p, hn + (size_t)m0 * 1024, 1024, wg, 1024, 1024, smem, 32 * wave, 0, acc);
        if (r < 16) {
            float* o = (float*)(p.ws + WS_GLR);
#pragma unroll
            for (int i = 0; i < 16; ++i) o[(size_t)(m0 + 32 * wave + crow(i, half)) * 16 + r] = acc[0][0][i];
        }
    }
}
constexpr int CUM_LD = 129;

DI float log_sigmoid(float z) {
    const float e = __builtin_amdgcn_exp2f(-fabsf(z) * 1.4426950408889634f);
    return fminf(z, 0.f) - __builtin_amdgcn_logf(1.f + e) * 0.6931471805599453f;
}

DI void gla_cum(const Params& p, int tok0, int h, float* cumL, float* glrL) {
    const int tid = opaque_tid(p), d = tid & 127, part = tid >> 7;
    const float* glr = (const float*)(p.ws + WS_GLR) + (size_t)tok0 * 16;
    ((f32x4*)glrL)[tid] = ((const f32x4*)glr)[tid];
    float w[16];
#pragma unroll
    for (int q = 0; q < 16; ++q) w[q] = p.gla_wgu[q * 512 + h * 128 + d];
    const float bias = p.gla_bg[h * 128 + d];
    __syncthreads();
    float run = 0.f;
#pragma unroll 1
    for (int c0 = part * 32; c0 < part * 32 + 32; c0 += 8) {
        float gl[8];
#pragma unroll
        for (int j = 0; j < 8; ++j) {
            const f32x4* gr = (const f32x4*)(glrL + (c0 + j) * 16);
            const f32x4 g0 = gr[0], g1 = gr[1], g2 = gr[2], g3 = gr[3];
            const float p0 = g0.x * w[0] + g0.y * w[1] + g0.z * w[2] + g0.w * w[3];
            const float p1 = g1.x * w[4] + g1.y * w[5] + g1.z * w[6] + g1.w * w[7];
            const float p2 = g2.x * w[8] + g2.y * w[9] + g2.z * w[10] + g2.w * w[11];
            const float p3 = g3.x * w[12] + g3.y * w[13] + g3.z * w[14] + g3.w * w[15];
            gl[j] = log_sigmoid(bias + ((p0 + p1) + (p2 + p3))) * (1.f / 16.f);
        }
#pragma unroll
        for (int j = 0; j < 8; ++j) { run += gl[j]; cumL[(c0 + j) * CUM_LD + d] = run; }
    }
    __syncthreads();
    if (part == 1) {
        const float add = cumL[31 * CUM_LD + d];
#pragma unroll 8
        for (int c = 32; c < 64; ++c) cumL[c * CUM_LD + d] += add;
    }
    __syncthreads();
}

DI void gla_pass1(const Params& p, char* smem, int bid, int nb) {
    const int tid = opaque_tid(p), wave = tid >> 6, lane = tid & 63, r = lane & 31, half = lane >> 5;
    float* cumL = (float*)smem; char* vT = smem; char* kdT = smem + 36864; float* glrL = (float*)(smem + 36864);
    const u16* proj = (const u16*)(p.ws + WS_PROJ);
    for (int u = bid; u < 2048; u += nb) {
        const int bh = u >> 8, n = u & 255, b = bh >> 2, h = bh & 3;
        const int tok0 = b * SEQ + n * 64;
        __syncthreads();
        gla_cum(p, tok0, h, cumL, glrL);
        if (tid < 128) ((float*)(p.ws + WS_DEC))[(size_t)u * 128 + tid] = __expf(cumL[63 * CUM_LD + tid]);
#pragma unroll 1
        for (int it = 0; it < 4; ++it) {
            const int d0 = (wave + 4 * it) * 8;
            const u32x4 kreg = *(const u32x4*)(proj + (size_t)(tok0 + lane) * 3072 + 512 + h * 128 + d0);
            const unsigned wv[4] = {kreg.x, kreg.y, kreg.z, kreg.w};
            const float* cl = cumL + 63 * CUM_LD + d0; const float* cc = cumL + lane * CUM_LD + d0;
            char* dst = kdT + (d0 * 72 + lane) * 2;
#pragma unroll
            for (int i = 0; i < 8; ++i) {
                const float kv = (i & 1) ? bfhi(wv[i >> 1]) : bflo(wv[i >> 1]);
                const float e = __expf(cl[i] - cc[i]);
                *(u16*)(dst + i * 144) = f2bf(kv * e);
            }
        }
        __syncthreads();
#pragma unroll 1
        for (int it = 0; it < 8; ++it) {
            const int v0 = (wave + 4 * it) * 8;
            const u32x4 vr = *(const u32x4*)(proj + (size_t)(tok0 + lane) * 3072 + 1024 + h * 256 + v0);
            const unsigned wv[4] = {vr.x, vr.y, vr.z, vr.w};
            char* dst = vT + (v0 * 72 + lane) * 2;
#pragma unroll
            for (int i = 0; i < 8; ++i) *(u16*)(dst + i * 144) = (u16)((i & 1) ? (wv[i >> 1] >> 16) : (wv[i >> 1] & 0xffffu));
        }
        __syncthreads();
        u16* kvo = (u16*)(p.ws + WS_KV) + (size_t)u * 32768;
#pragma unroll 1
        for (int jh = 0; jh < 2; ++jh) {
            f32x16 acc[2][2];
#pragma unroll
            for (int i = 0; i < 2; ++i)
#pragma unroll
                for (int j = 0; j < 2; ++j) acc[i][j] = zero16();
#pragma unroll
            for (int ks = 0; ks < 4; ++ks) {
                bf16x8 af[2], bfr[2];
#pragma unroll
                for (int i = 0; i < 2; ++i) af[i] = lds_frag(vT + (64 * wave + 32 * i + r) * 144 + ks * 32 + half * 16);
#pragma unroll
                for (int j = 0; j < 2; ++j) bfr[j] = lds_frag(kdT + (64 * jh + 32 * j + r) * 144 + ks * 32 + half * 16);
#pragma unroll
                for (int i = 0; i < 2; ++i)
#pragma unroll
                    for (int j = 0; j < 2; ++j) acc[i][j] = MFMA32(af[i], bfr[j], acc[i][j]);
            }
#pragma unroll
            for (int i = 0; i < 2; ++i)
#pragma unroll
                for (int j = 0; j < 2; ++j)
#pragma unroll
                    for (int q = 0; q < 16; ++q) kvo[(64 * wave + 32 * i + crow(q, half)) * 128 + 64 * jh + 32 * j + r] = f2bf(acc[i][j][q]);
        }
    }
}

DI void gla_scan(const Params& p, int bid, int nb) {
    u16* kv = (u16*)(p.ws + WS_KV);
    const float* dec = (const float*)(p.ws + WS_DEC);
    for (int g = bid * NTHR + opaque_tid(p); g < 32768; g += nb * NTHR) {
        const int bh = g >> 12, rem = g & 4095;
        const int dch = rem & 15;
        float st[8];
#pragma unroll
        for (int i = 0; i < 8; ++i) st[i] = 0.f;
        const size_t base = (size_t)bh * 256 * 32768 + (size_t)rem * 8;
        const float* dbase = dec + (size_t)bh * 256 * 128 + dch * 8;
        for (int n0 = 0; n0 < 256; n0 += 8) {
            u32x4 kk[8]; f32x4 d0[8], d1[8];
#pragma unroll
            for (int j = 0; j < 8; ++j) {
                kk[j] = *(const u32x4*)(kv + base + (size_t)(n0 + j) * 32768);
                d0[j] = *(const f32x4*)(dbase + (size_t)(n0 + j) * 128);
                d1[j] = *(const f32x4*)(dbase + (size_t)(n0 + j) * 128 + 4);
            }
#pragma unroll
            for (int j = 0; j < 8; ++j) {
                const u32x4 o = u32x4{pk2(st[0], st[1]), pk2(st[2], st[3]), pk2(st[4], st[5]), pk2(st[6], st[7])};
                *(u32x4*)(kv + base + (size_t)(n0 + j) * 32768) = o;
                const float dd[8] = {d0[j].x, d0[j].y, d0[j].z, d0[j].w, d1[j].x, d1[j].y, d1[j].z, d1[j].w};
                const unsigned wv[4] = {kk[j].x, kk[j].y, kk[j].z, kk[j].w};
#pragma unroll
                for (int i = 0; i < 8; ++i) st[i] = dd[i] * st[i] + ((i & 1) ? bfhi(wv[i >> 1]) : bflo(wv[i >> 1]));
            }
        }
    }
}

DI void gla_pass3(const Params& p, char* smem, int bid, int nb) {
    const int tid = opaque_tid(p), wave = tid >> 6, lane = tid & 63, r = lane & 31, half = lane >> 5;
    float* cumL = (float*)smem; char* vT = smem; char* aM = smem + 18432; char* qd = smem + 36864; char* kq = smem + 54272; float* glrL = (float*)(smem + 36864);
    float* oL = (float*)smem;
    const u16* proj = (const u16*)(p.ws + WS_PROJ);
    const float scale = 0.08838834764831845f;
    for (int u = bid; u < 2048; u += nb) {
        const int bh = u >> 8, n = u & 255, b = bh >> 2, h = bh & 3;
        const int tok0 = b * SEQ + n * 64;
        const u16* st = (const u16*)(p.ws + WS_KV) + (size_t)u * 32768;
        __syncthreads();
        u32x4 qreg[4], kreg[4];
#pragma unroll
        for (int it = 0; it < 4; ++it) {
            const int id = tid + 256 * it, c = id >> 4, dch = id & 15;
            qreg[it] = *(const u32x4*)(proj + (size_t)(tok0 + c) * 3072 + h * 128 + dch * 8);
            kreg[it] = *(const u32x4*)(proj + (size_t)(tok0 + c) * 3072 + 512 + h * 128 + dch * 8);
        }
        gla_cum(p, tok0, h, cumL, glrL);
        u32x4 vreg[4], sreg[8];
#pragma unroll
        for (int it = 0; it < 4; ++it) {
            const int q = wave + 4 * it, wq = q >> 2, vv0 = (q & 3) * 8;
            vreg[it] = *(const u32x4*)(proj + (size_t)(tok0 + lane) * 3072 + 1024 + h * 256 + 64 * wq + vv0);
        }
#pragma unroll
        for (int ks = 0; ks < 8; ++ks) sreg[ks] = *(const u32x4*)(st + (size_t)(64 * wave + r) * 128 + ks * 16 + half * 8);
#pragma unroll
        for (int it = 0; it < 4; ++it) {
            const int id = tid + 256 * it, c = id >> 4, dch = id & 15;
            const unsigned qw[4] = {qreg[it].x, qreg[it].y, qreg[it].z, qreg[it].w}, kw[4] = {kreg[it].x, kreg[it].y, kreg[it].z, kreg[it].w};
            unsigned qo[4], ko[4];
#pragma unroll
            for (int i = 0; i < 4; ++i) {
                const int d = dch * 8 + 2 * i;
                const float e0 = cumL[c * CUM_LD + d] - cumL[31 * CUM_LD + d], e1 = cumL[c * CUM_LD + d + 1] - cumL[31 * CUM_LD + d + 1];
                qo[i] = pk2(bflo(qw[i]) * scale * __expf(e0), bfhi(qw[i]) * scale * __expf(e1));
                ko[i] = pk2(bflo(kw[i]) * __expf(-e0), bfhi(kw[i]) * __expf(-e1));
            }
            *(u32x4*)(qd + c * 272 + dch * 16) = u32x4{qo[0], qo[1], qo[2], qo[3]};
            *(u32x4*)(kq + c * 272 + dch * 16) = u32x4{ko[0], ko[1], ko[2], ko[3]};
        }
        __syncthreads();
        const int rb = wave >> 1, cb = wave & 1;
        f32x16 aacc = zero16();
        if (cb <= rb) {
#pragma unroll
            for (int ks = 0; ks < 8; ++ks) {
                const bf16x8 af = lds_frag(qd + (32 * rb + r) * 272 + ks * 32 + half * 16);
                const bf16x8 bf = lds_frag(kq + (32 * cb + r) * 272 + ks * 32 + half * 16);
                aacc = MFMA32(af, bf, aacc);
            }
        }
        __syncthreads();
#pragma unroll
        for (int it = 0; it < 4; ++it) {
            const int id = tid + 256 * it, c = id >> 4, dch = id & 15;
            const unsigned qw[4] = {qreg[it].x, qreg[it].y, qreg[it].z, qreg[it].w};
            unsigned qo[4];
#pragma unroll
            for (int i = 0; i < 4; ++i) {
                const int d = dch * 8 + 2 * i;
                qo[i] = pk2(bflo(qw[i]) * scale * __expf(cumL[c * CUM_LD + d]), bfhi(qw[i]) * scale * __expf(cumL[c * CUM_LD + d + 1]));
            }
            *(u32x4*)(kq + c * 272 + dch * 16) = u32x4{qo[0], qo[1], qo[2], qo[3]};
        }
        __syncthreads();
#pragma unroll
        for (int q = 0; q < 16; ++q) {
            const int c = 32 * rb + crow(q, half), j = 32 * cb + r;
            *(u16*)(aM + (c * 72 + j) * 2) = f2bf((j <= c) ? aacc[q] : 0.f);
        }
        f32x16 o[2][2];
#pragma unroll
        for (int i = 0; i < 2; ++i)
#pragma unroll
            for (int j = 0; j < 2; ++j) o[i][j] = zero16();
        u32x2 rreg[16];
#pragma unroll
        for (int ps = 0; ps < 2; ++ps) {
            if (ps == 1) __syncthreads();
#pragma unroll
            for (int it = 0; it < 4; ++it) {
                const int q = wave + 4 * it, wq = q >> 2, vv0 = (q & 3) * 8;
                const unsigned wv[4] = {vreg[it].x, vreg[it].y, vreg[it].z, vreg[it].w};
                char* dst = vT + ((wq * 32 + vv0) * 72 + lane) * 2;
#pragma unroll
                for (int i = 0; i < 8; ++i) *(u16*)(dst + i * 144) = (u16)((i & 1) ? (wv[i >> 1] >> 16) : (wv[i >> 1] & 0xffffu));
            }
            if (ps == 0) {
#pragma unroll
                for (int it = 0; it < 4; ++it) {
                    const int q = wave + 4 * it, wq = q >> 2, vv0 = (q & 3) * 8;
                    vreg[it] = *(const u32x4*)(proj + (size_t)(tok0 + lane) * 3072 + 1024 + h * 256 + 64 * wq + 32 + vv0);
                }
            } else {
                const u16* rrow = proj + (size_t)(tok0 + (tid >> 2)) * 3072 + 2048 + h * 256 + 4 * (tid & 3);
#pragma unroll
                for (int j = 0; j < 16; ++j) rreg[j] = *(const u32x2*)(rrow + 16 * j);
            }
            __syncthreads();
#pragma unroll
            for (int ks = 0; ks < 4; ++ks) {
                const bf16x8 bf = lds_frag(vT + (wave * 32 + r) * 144 + ks * 32 + half * 16);
#pragma unroll
                for (int i = 0; i < 2; ++i) {
                    const bf16x8 af = lds_frag(aM + (32 * i + r) * 144 + ks * 32 + half * 16);
                    o[ps][i] = MFMA32(af, bf, o[ps][i]);
                }
            }
#pragma unroll
            for (int ks = 0; ks < 8; ++ks) {
                const bf16x8 bf = __builtin_bit_cast(bf16x8, sreg[ks]);
#pragma unroll
                for (int i = 0; i < 2; ++i) {
                    const bf16x8 af = lds_frag(kq + (32 * i + r) * 272 + ks * 32 + half * 16);
                    o[ps][i] = MFMA32(af, bf, o[ps][i]);
                }
            }
            if (ps == 0) {
#pragma unroll
                for (int ks = 0; ks < 8; ++ks) sreg[ks] = *(const u32x4*)(st + (size_t)(64 * wave + 32 + r) * 128 + ks * 16 + half * 8);
            }
        }
        __syncthreads();
#pragma unroll
        for (int ps = 0; ps < 2; ++ps)
#pragma unroll
            for (int i = 0; i < 2; ++i)
#pragma unroll
                for (int q = 0; q < 16; ++q) oL[(32 * i + crow(q, half)) * 260 + 64 * wave + 32 * ps + r] = o[ps][i][q];
        __syncthreads();
        {
            const int c = tid >> 2, qq = tid & 3;
            f32x4 vals[16]; float ss = 0.f;
#pragma unroll
            for (int j = 0; j < 16; ++j) {
                vals[j] = *(const f32x4*)(oL + c * 260 + 16 * j + 4 * qq);
                ss += vals[j].x * vals[j].x + vals[j].y * vals[j].y + vals[j].z * vals[j].z + vals[j].w * vals[j].w;
            }
            ss += sxf<1>(ss, 0); ss += sxf<2>(ss, 0);
            const float rinv = rsqrtf(ss * (1.f / 256.f) + 1e-6f);
            const float* gn = p.gla_norm + h * 256;
            u16* orow = (u16*)(p.ws + WS_HN) + (size_t)(tok0 + c) * 1024 + h * 256;
#pragma unroll
            for (int j = 0; j < 16; ++j) {
                const int v0 = 16 * j + 4 * qq;
                const u32x2 rr = rreg[j];
                const f32x4 g4 = *(const f32x4*)(gn + v0);
                const float r0 = bflo(rr.x), r1 = bfhi(rr.x), r2 = bflo(rr.y), r3 = bfhi(rr.y);
                const float o0 = vals[j].x * rinv * g4.x * (r0 / (1.f + __expf(-r0)));
                const float o1 = vals[j].y * rinv * g4.y * (r1 / (1.f + __expf(-r1)));
                const float o2 = vals[j].z * rinv * g4.z * (r2 / (1.f + __expf(-r2)));
                const float o3 = vals[j].w * rinv * g4.w * (r3 / (1.f + __expf(-r3)));
                *(u32x2*)(orow + v0) = u32x2{pk2(o0, o1), pk2(o2, o3)};
            }
        }
    }
}
DI unsigned sortable(float v) { const unsigned u = __float_as_uint(v); return (u & 0x80000000u) ? ~u : (u | 0x80000000u); }
DI float unsortable(unsigned k) { const unsigned u = (k & 0x80000000u) ? (k & 0x7fffffffu) : ~k; return __uint_as_float(u); }
DI void ins16(unsigned (&L)[16], unsigned x) {
#pragma unroll
    for (int i = 0; i < 16; ++i) { const unsigned hi = max(L[i], x); x = min(L[i], x); L[i] = hi; }
}

DI void ce(unsigned& a, unsigned& b) { const unsigned hi = max(a, b), lo = min(a, b); a = hi; b = lo; }
template <int N> DI void bitonic_sort_desc(unsigned (&v)[N]) {
#pragma unroll
    for (int k = 2; k <= N; k <<= 1)
#pragma unroll
        for (int j = k >> 1; j > 0; j >>= 1)
#pragma unroll
            for (int i = 0; i < N; ++i) {
                const int l = i ^ j;
                if (l > i) { if ((i & k) == 0) ce(v[i], v[l]); else ce(v[l], v[i]); }
            }
}
DI void top16_merge(unsigned (&a)[16], const unsigned (&b)[16]) {
#pragma unroll
    for (int i = 0; i < 16; ++i) a[i] = max(a[i], b[15 - i]);
#pragma unroll
    for (int j = 8; j > 0; j >>= 1)
#pragma unroll
        for (int i = 0; i < 16; ++i) { const int l = i ^ j; if (l > i) ce(a[i], a[l]); }
}
constexpr int PQ_LDS_BYTES = G_LDS_BYTES;
DI void peer_query_phase(const Params& p, int layer, char* smem, int bid, int nb) {
    const int tid = opaque_tid(p), wave = tid >> 6, lane = tid & 63, r = lane & 31, half = lane >> 5;
    const u16* hn = (const u16*)(p.ws + WS_HN);
    const u16* wq = (const u16*)(p.ws + WS_WPQ) + (size_t)layer * 2048 * 1024;
    const u16* sk = (const u16*)(p.ws + WS_SK) + (size_t)layer * 8 * 2 * 128 * 128;
    char* Bk = smem;
    for (int j = 0; j * nb < 2048; ++j) {
        const int u = xcd_unit(j, bid, nb);
        if (u >= 2048) continue;
        const int tb = u >> 3, h = u & 7;
        unsigned Lp[2][16];
        __syncthreads();
        f32x16 acc[8][1];
#pragma unroll
        for (int i = 0; i < 8; ++i) acc[i][0] = zero16();
        gemm_mainloop<8, 1, 128, 256>(p, wq + (size_t)(h * 256) * 1024, 1024, hn + (size_t)(tb * 128) * 1024, 1024, 1024, smem, 0, 32 * wave, acc);
        bf16x8 bqa[2][8];
#pragma unroll
        for (int pp = 0; pp < 2; ++pp)
#pragma unroll
            for (int di = 0; di < 4; ++di) { bqa[pp][2 * di] = pack8(acc[4 * pp + di][0], 0); bqa[pp][2 * di + 1] = pack8(acc[4 * pp + di][0], 1); }
#pragma unroll
        for (int pp = 0; pp < 2; ++pp) {
            __syncthreads();
            const u16* skt = sk + (size_t)(h * 2 + pp) * 128 * 128;
            int tidl = tid; asm volatile("" : "+v"(tidl));
            {
                const int n0 = tidl >> 4, ch = tidl & 15;
                u32x4 tmp[8];
#pragma unroll
                for (int it = 0; it < 8; ++it) tmp[it] = *(const u32x4*)(skt + (n0 + 16 * it) * 128 + ch * 8);
#pragma unroll
                for (int it = 0; it < 8; ++it) *(u32x4*)(Bk + (n0 + 16 * it) * 272 + ch * 16) = tmp[it];
            }
            __syncthreads();
            f32x16 sc[4];
#pragma unroll
            for (int i = 0; i < 4; ++i) sc[i] = zero16();
#pragma unroll
            for (int di = 0; di < 4; ++di)
#pragma unroll
                for (int s = 0; s < 2; ++s) {
                    const bf16x8 bq = bqa[pp][2 * di + s];
#pragma unroll
                    for (int kb = 0; kb < 4; ++kb) {
                        const char* rowp = Bk + (32 * kb + r) * 272 + (32 * di + 16 * s + 4 * half) * 2;
                        const bf16x8 ak = lds_frag2(rowp, rowp + 16);
                        sc[kb] = MFMA32(ak, bq, sc[kb]);
                    }
                }
            unsigned L[16];
            {
                unsigned G[4][16];
                int hq4 = 4 * half; asm volatile("" : "+v"(hq4));
#pragma unroll
                for (int kb = 0; kb < 4; ++kb) {
#pragma unroll
                    for (int q = 0; q < 16; ++q) G[kb][q] = (sortable(sc[kb][q]) & 0xffffff80u) | (unsigned)(127 - 32 * kb - crow(q, 0) - hq4);
                    bitonic_sort_desc<16>(G[kb]);
                }
                top16_merge(G[0], G[1]); top16_merge(G[2], G[3]); top16_merge(G[0], G[2]);
#pragma unroll
                for (int i = 0; i < 16; ++i) L[i] = G[0][i];
            }
            {
                unsigned O[16];
#pragma unroll
                for (int i = 0; i < 16; ++i) O[i] = sxu<32>(L[i], half);
                top16_merge(L, O);
            }
#pragma unroll
            for (int i = 0; i < 16; ++i) Lp[pp][i] = L[i];
        }
        float s1[16], s2[16]; int i1[16], i2[16];
#pragma unroll
        for (int i = 0; i < 16; ++i) {
            s1[i] = unsortable(Lp[0][i] & 0xffffff80u); i1[i] = 127 - (int)(Lp[0][i] & 127u);
            s2[i] = unsortable(Lp[1][i] & 0xffffff80u); i2[i] = 127 - (int)(Lp[1][i] & 127u);
        }
        __syncthreads();
        int* tabL = (int*)(smem + wave * 8192);
        if (half == 0) {
#pragma unroll
            for (int i = 0; i < 16; ++i) { tabL[i * 32 + r] = i1[i]; tabL[(16 + i) * 32 + r] = i2[i]; tabL[(32 + i) * 32 + r] = __float_as_int(s1[i]); tabL[(48 + i) * 32 + r] = __float_as_int(s2[i]); }
        }
        unsigned C[16], D[16];
#pragma unroll
        for (int i = 0; i < 16; ++i) { C[i] = 0u; D[i] = 0u; }
#define CANDK(a0, b0, a1, b1) ((sortable(half ? (s1[a1] + s2[b1]) : (s1[a0] + s2[b0])) & 0xffffff00u) | (unsigned)(255 - (half ? (16 * a1 + b1) : (16 * a0 + b0))))
        C[0] = CANDK(0, 0, 0, 1);
        C[1] = CANDK(0, 2, 0, 3);
        C[2] = CANDK(0, 4, 0, 5);
        C[3] = CANDK(0, 6, 0, 7);
        C[4] = CANDK(0, 8, 0, 9);
        C[5] = CANDK(0, 10, 0, 11);
        C[6] = CANDK(0, 12, 0, 13);
        C[7] = CANDK(0, 14, 0, 15);
        C[8] = CANDK(1, 0, 1, 1);
        C[9] = CANDK(1, 2, 1, 3);
        C[10] = CANDK(1, 4, 1, 5);
        C[11] = CANDK(1, 6, 1, 7);
        C[12] = CANDK(2, 0, 2, 1);
        C[13] = CANDK(2, 2, 2, 3);
        C[14] = CANDK(2, 4, 3, 0);
        C[15] = CANDK(3, 1, 3, 2);
        D[0] = CANDK(3, 3, 4, 0);
        D[1] = CANDK(4, 1, 4, 2);
        D[2] = CANDK(5, 0, 5, 1);
        D[3] = CANDK(6, 0, 6, 1);
        D[4] = CANDK(7, 0, 7, 1);
        D[5] = CANDK(8, 0, 9, 0);
        D[6] = CANDK(10, 0, 11, 0);
        D[7] = CANDK(12, 0, 13, 0);
        D[8] = CANDK(14, 0, 15, 0);
#undef CANDK
        bitonic_sort_desc<16>(C); bitonic_sort_desc<16>(D);
        top16_merge(C, D);
        {
            unsigned O[16];
#pragma unroll
            for (int i = 0; i < 16; ++i) O[i] = sxu<32>(C[i], half);
            top16_merge(C, O);
        }
        float bs[16]; int bi[16];
#pragma unroll
        for (int i = 0; i < 16; ++i) {
            const int id = 255 - (int)(C[i] & 255u), a = id >> 4, b = id & 15;
            bi[i] = tabL[a * 32 + r] * 128 + tabL[(16 + b) * 32 + r];
            bs[i] = __int_as_float(tabL[(32 + a) * 32 + r]) + __int_as_float(tabL[(48 + b) * 32 + r]);
        }
        float den = 0.f, ex[16];
#pragma unroll
        for (int i = 0; i < 16; ++i) { ex[i] = __expf(bs[i] - bs[0]); den += ex[i]; }
        const float rden = 1.f / den;
        int rl = r; asm volatile("" : "+v"(rl));
        const int tok = tb * 128 + 32 * wave + rl;
        int* io = (int*)(p.ws + WS_IDX) + (size_t)tok * 128 + h * 16 + 8 * half;
        float* go = (float*)(p.ws + WS_GATE) + (size_t)tok * 128 + h * 16 + 8 * half;
        if (half == 0) {
            *(u32x4*)(io) = u32x4{(unsigned)bi[0], (unsigned)bi[1], (unsigned)bi[2], (unsigned)bi[3]};
            *(u32x4*)(io + 4) = u32x4{(unsigned)bi[4], (unsigned)bi[5], (unsigned)bi[6], (unsigned)bi[7]};
            *(f32x4*)(go) = f32x4{ex[0] * rden, ex[1] * rden, ex[2] * rden, ex[3] * rden};
            *(f32x4*)(go + 4) = f32x4{ex[4] * rden, ex[5] * rden, ex[6] * rden, ex[7] * rden};
        } else {
            *(u32x4*)(io) = u32x4{(unsigned)bi[8], (unsigned)bi[9], (unsigned)bi[10], (unsigned)bi[11]};
            *(u32x4*)(io + 4) = u32x4{(unsigned)bi[12], (unsigned)bi[13], (unsigned)bi[14], (unsigned)bi[15]};
            *(f32x4*)(go) = f32x4{ex[8] * rden, ex[9] * rden, ex[10] * rden, ex[11] * rden};
            *(f32x4*)(go + 4) = f32x4{ex[12] * rden, ex[13] * rden, ex[14] * rden, ex[15] * rden};
        }
    }
}

DI void peer_query_phase8(const Params& p, int layer, char* smem, int bid, int nb) {
    const int tid = opaque_tid8(p), wave = tid >> 6, lane = tid & 63, r = lane & 31, half = lane >> 5;
    const u16* hn = (const u16*)(p.ws + WS_HN);
    const u16* wq = (const u16*)(p.ws + WS_WPQ) + (size_t)layer * 2048 * 1024;
    const u16* sk = (const u16*)(p.ws + WS_SK) + (size_t)layer * 8 * 2 * 128 * 128;
    char* Bk = smem;
    for (int j = 0; j * nb < 1024; ++j) {
        const int u = xcd_unit(j, bid, nb);
        if (u >= 1024) continue;
        const int tb = u >> 3, h = u & 7;
        unsigned Lp[2][16];
        __syncthreads();
        f32x16 acc[8][1];
#pragma unroll
        for (int i = 0; i < 8; ++i) acc[i][0] = zero16();
        gemm_mainloop<8, 1, 256, 256, 8>(p, wq + (size_t)(h * 256) * 1024, 1024, hn + (size_t)(tb * 256) * 1024, 1024, 1024, smem, 0, 32 * wave, acc, p.pad_);
        bf16x8 bqa[2][8];
#pragma unroll
        for (int pp = 0; pp < 2; ++pp)
#pragma unroll
            for (int di = 0; di < 4; ++di) { bqa[pp][2 * di] = pack8(acc[4 * pp + di][0], 0); bqa[pp][2 * di + 1] = pack8(acc[4 * pp + di][0], 1); }
#pragma unroll
        for (int pp = 0; pp < 2; ++pp) {
            __syncthreads();
            const u16* skt = sk + (size_t)(h * 2 + pp) * 128 * 128;
            int tidl = tid; asm volatile("" : "+v"(tidl));
            {
                const int n0 = tidl >> 4, ch = tidl & 15;
                u32x4 tmp[4];
#pragma unroll
                for (int it = 0; it < 4; ++it) tmp[it] = *(const u32x4*)(skt + (n0 + 32 * it) * 128 + ch * 8);
#pragma unroll
                for (int it = 0; it < 4; ++it) *(u32x4*)(Bk + (n0 + 32 * it) * 272 + ch * 16) = tmp[it];
            }
            __syncthreads();
            f32x16 sc[4];
#pragma unroll
            for (int i = 0; i < 4; ++i) sc[i] = zero16();
#pragma unroll
            for (int di = 0; di < 4; ++di)
#pragma unroll
                for (int s = 0; s < 2; ++s) {
                    const bf16x8 bq = bqa[pp][2 * di + s];
#pragma unroll
                    for (int kb = 0; kb < 4; ++kb) {
                        const char* rowp = Bk + (32 * kb + r) * 272 + (32 * di + 16 * s + 4 * half) * 2;
                        const bf16x8 ak = lds_frag2(rowp, rowp + 16);
                        sc[kb] = MFMA32(ak, bq, sc[kb]);
                    }
                }
            unsigned L[16];
            {
                unsigned G[4][16];
                int hq4 = 4 * half; asm volatile("" : "+v"(hq4));
#pragma unroll
                for (int kb = 0; kb < 4; ++kb) {
#pragma unroll
                    for (int q = 0; q < 16; ++q) G[kb][q] = (sortable(sc[kb][q]) & 0xffffff80u) | (unsigned)(127 - 32 * kb - crow(q, 0) - hq4);
                    bitonic_sort_desc<16>(G[kb]);
                }
                top16_merge(G[0], G[1]); top16_merge(G[2], G[3]); top16_merge(G[0], G[2]);
#pragma unroll
                for (int i = 0; i < 16; ++i) L[i] = G[0][i];
            }
            {
                unsigned O[16];
#pragma unroll
                for (int i = 0; i < 16; ++i) O[i] = sxu<32>(L[i], half);
                top16_merge(L, O);
            }
#pragma unroll
            for (int i = 0; i < 16; ++i) Lp[pp][i] = L[i];
        }
        float s1[16], s2[16]; int i1[16], i2[16];
#pragma unroll
        for (int i = 0; i < 16; ++i) {
            s1[i] = unsortable(Lp[0][i] & 0xffffff80u); i1[i] = 127 - (int)(Lp[0][i] & 127u);
            s2[i] = unsortable(Lp[1][i] & 0xffffff80u); i2[i] = 127 - (int)(Lp[1][i] & 127u);
        }
        __syncthreads();
        int* tabL = (int*)(smem + wave * 8192);
        if (half == 0) {
#pragma unroll
            for (int i = 0; i < 16; ++i) { tabL[i * 32 + r] = i1[i]; tabL[(16 + i) * 32 + r] = i2[i]; tabL[(32 + i) * 32 + r] = __float_as_int(s1[i]); tabL[(48 + i) * 32 + r] = __float_as_int(s2[i]); }
        }
        unsigned C[16], D[16];
#pragma unroll
        for (int i = 0; i < 16; ++i) { C[i] = 0u; D[i] = 0u; }
#define CANDK(a0, b0, a1, b1) ((sortable(half ? (s1[a1] + s2[b1]) : (s1[a0] + s2[b0])) & 0xffffff00u) | (unsigned)(255 - (half ? (16 * a1 + b1) : (16 * a0 + b0))))
        C[0] = CANDK(0, 0, 0, 1);
        C[1] = CANDK(0, 2, 0, 3);
        C[2] = CANDK(0, 4, 0, 5);
        C[3] = CANDK(0, 6, 0, 7);
        C[4] = CANDK(0, 8, 0, 9);
        C[5] = CANDK(0, 10, 0, 11);
        C[6] = CANDK(0, 12, 0, 13);
        C[7] = CANDK(0, 14, 0, 15);
        C[8] = CANDK(1, 0, 1, 1);
        C[9] = CANDK(1, 2, 1, 3);
        C[10] = CANDK(1, 4, 1, 5);
        C[11] = CANDK(1, 6, 1, 7);
        C[12] = CANDK(2, 0, 2, 1);
        C[13] = CANDK(2, 2, 2, 3);
        C[14] = CANDK(2, 4, 3, 0);
        C[15] = CANDK(3, 1, 3, 2);
        D[0] = CANDK(3, 3, 4, 0);
        D[1] = CANDK(4, 1, 4, 2);
        D[2] = CANDK(5, 0, 5, 1);
        D[3] = CANDK(6, 0, 6, 1);
        D[4] = CANDK(7, 0, 7, 1);
        D[5] = CANDK(8, 0, 9, 0);
        D[6] = CANDK(10, 0, 11, 0);
        D[7] = CANDK(12, 0, 13, 0);
        D[8] = CANDK(14, 0, 15, 0);
#undef CANDK
        bitonic_sort_desc<16>(C); bitonic_sort_desc<16>(D);
        top16_merge(C, D);
        {
            unsigned O[16];
#pragma unroll
            for (int i = 0; i < 16; ++i) O[i] = sxu<32>(C[i], half);
            top16_merge(C, O);
        }
        float bs[16]; int bi[16];
#pragma unroll
        for (int i = 0; i < 16; ++i) {
            const int id = 255 - (int)(C[i] & 255u), a = id >> 4, b = id & 15;
            bi[i] = tabL[a * 32 + r] * 128 + tabL[(16 + b) * 32 + r];
            bs[i] = __int_as_float(tabL[(32 + a) * 32 + r]) + __int_as_float(tabL[(48 + b) * 32 + r]);
        }
        float den = 0.f, ex[16];
#pragma unroll
        for (int i = 0; i < 16; ++i) { ex[i] = __expf(bs[i] - bs[0]); den += ex[i]; }
        const float rden = 1.f / den;
        int rl = r; asm volatile("" : "+v"(rl));
        const int tok = tb * 256 + 32 * wave + rl;
        int* io = (int*)(p.ws + WS_IDX) + (size_t)tok * 128 + h * 16 + 8 * half;
        float* go = (float*)(p.ws + WS_GATE) + (size_t)tok * 128 + h * 16 + 8 * half;
        if (half == 0) {
            *(u32x4*)(io) = u32x4{(unsigned)bi[0], (unsigned)bi[1], (unsigned)bi[2], (unsigned)bi[3]};
            *(u32x4*)(io + 4) = u32x4{(unsigned)bi[4], (unsigned)bi[5], (unsigned)bi[6], (unsigned)bi[7]};
            *(f32x4*)(go) = f32x4{ex[0] * rden, ex[1] * rden, ex[2] * rden, ex[3] * rden};
            *(f32x4*)(go + 4) = f32x4{ex[4] * rden, ex[5] * rden, ex[6] * rden, ex[7] * rden};
        } else {
            *(u32x4*)(io) = u32x4{(unsigned)bi[8], (unsigned)bi[9], (unsigned)bi[10], (unsigned)bi[11]};
            *(u32x4*)(io + 4) = u32x4{(unsigned)bi[12], (unsigned)bi[13], (unsigned)bi[14], (unsigned)bi[15]};
            *(f32x4*)(go) = f32x4{ex[8] * rden, ex[9] * rden, ex[10] * rden, ex[11] * rden};
            *(f32x4*)(go + 4) = f32x4{ex[12] * rden, ex[13] * rden, ex[14] * rden, ex[15] * rden};
        }
    }
}

typedef __attribute__((ext_vector_type(2))) float f32x2;
DI float gelu_exact(float a) { return 0.5f * a * (1.f + erff(a * 0.7071067811865476f)); }
DI void unpack8_fp4(unsigned w, float (&f)[8]) {
    const f32x2 a = __builtin_amdgcn_cvt_scalef32_pk_f32_fp4(w, 1.0f, 0), b = __builtin_amdgcn_cvt_scalef32_pk_f32_fp4(w, 1.0f, 1);
    const f32x2 c = __builtin_amdgcn_cvt_scalef32_pk_f32_fp4(w, 1.0f, 2), d = __builtin_amdgcn_cvt_scalef32_pk_f32_fp4(w, 1.0f, 3);
    f[0] = a.x; f[1] = a.y; f[2] = b.x; f[3] = b.y; f[4] = c.x; f[5] = c.y; f[6] = d.x; f[7] = d.y;
}
constexpr float PG_SX = 21.6f;
constexpr int PG_RING_SLOTS = 16, PG_DEPTH = 14;
constexpr int PG_LDS_BYTES = 4 * PG_RING_SLOTS * 1024 + 4096;
DI void pg_dma(const unsigned char* tab, unsigned e, unsigned lane_off, char* slot) {
    __builtin_amdgcn_global_load_lds((const unsigned*)(tab + (e * 512u + lane_off)), (unsigned*)slot, 16, 0, 0);
}
DI void pg_dma4(const unsigned char* tab, const u32x4 e4, unsigned lane_off, char* ring, int g) {
    pg_dma(tab, e4.x, lane_off, ring + ((4 * g + 0) & 15) * 1024); pg_dma(tab, e4.y, lane_off, ring + ((4 * g + 1) & 15) * 1024);
    pg_dma(tab, e4.z, lane_off, ring + ((4 * g + 2) & 15) * 1024); pg_dma(tab, e4.w, lane_off, ring + ((4 * g + 3) & 15) * 1024);
}
#define PG_WAIT_GROUP(g) do { if ((g) + 3 < 16) asm volatile("s_waitcnt vmcnt(12)" ::: "memory"); else if ((g) == 13) asm volatile("s_waitcnt vmcnt(8)" ::: "memory"); \
                              else if ((g) == 14) asm volatile("s_waitcnt vmcnt(4)" ::: "memory"); else asm volatile("s_waitcnt vmcnt(0)" ::: "memory"); } while (0)
DI void peer_u_phase(const Params& p, int layer, char* smem, int bid, int nb) {
    const int tid = opaque_tid(p), wave = __builtin_amdgcn_readfirstlane(tid >> 6), lane = tid & 63, hh = lane >> 5, li = lane & 31;
    char* ring = smem + wave * (PG_RING_SLOTS * 1024);
    int* idxL = (int*)(smem + 4 * PG_RING_SLOTS * 1024 + wave * 1024); float* cL = (float*)(idxL + 128);
    const unsigned char* tu = (const unsigned char*)(p.ws + WS_TAB) + (size_t)layer * 16 * MB;
    const u16* hn = (const u16*)(p.ws + WS_HN);
    const char* myslot = ring + lane * 16;
    const unsigned lane_off = (unsigned)li * 16u;
    const int* idxH = idxL + hh * 64;
    for (int t = bid * 4 + wave; t < T_TOK; t += nb * 4) {
        const int* ig = (const int*)(p.ws + WS_IDX) + (size_t)t * 128;
        idxL[(lane & 1) * 64 + (lane >> 1)] = ig[lane]; idxL[(lane & 1) * 64 + 32 + (lane >> 1)] = ig[lane + 64];
        unsigned xh[4], xl[4];
        {
            const u16* xr = hn + (size_t)t * 1024 + 32 * li;
            const u32x4 xa = *(const u32x4*)(xr), xb = *(const u32x4*)(xr + 8), xc = *(const u32x4*)(xr + 16), xd = *(const u32x4*)(xr + 24);
            const unsigned xw[16] = {xa.x, xa.y, xa.z, xa.w, xb.x, xb.y, xb.z, xb.w, xc.x, xc.y, xc.z, xc.w, xd.x, xd.y, xd.z, xd.w};
#pragma unroll
            for (int d = 0; d < 4; ++d) {
                unsigned hw = 0, lw = 0;
#pragma unroll
                for (int j = 0; j < 8; ++j) {
                    const unsigned w = xw[4 * d + (j >> 1)];
                    const float xv = (j & 1) ? bfhi(w) : bflo(w);
                    const int q = (int)rintf(fminf(fmaxf(xv * PG_SX, -119.f), 119.f));
                    const int lo = ((q + 8) & 15) - 8, hi = (q - lo) >> 4;
                    hw |= ((unsigned)hi & 15u) << (4 * j); lw |= ((unsigned)lo & 15u) << (4 * j);
                }
                xh[d] = hw; xl[d] = lw;
            }
        }
        asm volatile("s_waitcnt vmcnt(0) lgkmcnt(0)" ::: "memory");
#pragma unroll
        for (int g = 0; g < 3; ++g) pg_dma4(tu, *(const u32x4*)(idxH + 4 * g), lane_off, ring, g);
#pragma unroll 1
        for (int bt = 0; bt < 4; ++bt) {
            float pr[16];
#pragma unroll
            for (int gg = 0; gg < 4; ++gg) {
                const int g = bt * 4 + gg;
                if (g + 3 < 16) pg_dma4(tu, *(const u32x4*)(idxH + 4 * (g + 3)), lane_off, ring, g + 3);
                PG_WAIT_GROUP(g);
                u32x4 w[4];
#pragma unroll
                for (int i = 0; i < 4; ++i) w[i] = *(const u32x4*)(myslot + ((4 * gg + i) & 15) * 1024);
#pragma unroll
                for (int i = 0; i < 4; ++i) {
                    const unsigned ww[4] = {w[i].x, w[i].y, w[i].z, w[i].w};
                    int ah = 0, al = 0;
#pragma unroll
                    for (int c = 0; c < 4; ++c) { ah = __builtin_amdgcn_sdot8((int)ww[c], (int)xh[c], ah, false); al = __builtin_amdgcn_sdot8((int)ww[c], (int)xl[c], al, false); }
                    pr[4 * gg + i] = (float)(16 * ah + al);
                }
            }
            float q8[8], q4[4], q2[2], q1;
            { const bool up = (lane & 1) != 0;
#pragma unroll
              for (int i = 0; i < 8; ++i) { const float send = up ? pr[i] : pr[i + 8]; const float keep = up ? pr[i + 8] : pr[i]; q8[i] = keep + sxf<1>(send, hh); } }
            { const bool up = (lane & 2) != 0;
#pragma unroll
              for (int i = 0; i < 4; ++i) { const float send = up ? q8[i] : q8[i + 4]; const float keep = up ? q8[i + 4] : q8[i]; q4[i] = keep + sxf<2>(send, hh); } }
            { const bool up = (lane & 4) != 0;
#pragma unroll
              for (int i = 0; i < 2; ++i) { const float send = up ? q4[i] : q4[i + 2]; const float keep = up ? q4[i + 2] : q4[i]; q2[i] = keep + sxf<4>(send, hh); } }
            { const bool up = (lane & 8) != 0; const float send = up ? q2[0] : q2[1]; const float keep = up ? q2[1] : q2[0]; q1 = keep + sxf<8>(send, hh); }
            q1 += sxf<16>(q1, hh);
            const int jj = 8 * (lane & 1) + 4 * ((lane >> 1) & 1) + 2 * ((lane >> 2) & 1) + ((lane >> 3) & 1);
            if ((lane & 16) == 0) cL[2 * (bt * 16 + jj) + hh] = q1;
        }
        float* dg = (float*)(p.ws + WS_DOT) + (size_t)t * 128;
        dg[lane] = cL[lane]; dg[lane + 64] = cL[lane + 64];
    }
}
typedef __attribute__((ext_vector_type(2))) _Float16 h2_t;
DI void pg_axpy(h2_t (&o2)[16], const u32x4 w, float cfs) {
    const _Float16 ch = (_Float16)cfs; const h2_t cf2 = {ch, ch};
    const unsigned ww[4] = {w.x, w.y, w.z, w.w};
#pragma unroll
    for (int c = 0; c < 4; ++c) {
        o2[4 * c + 0] = __builtin_amdgcn_cvt_scalef32_pk_f16_fp4(ww[c], 1.0f, 0) * cf2 + o2[4 * c + 0];
        o2[4 * c + 1] = __builtin_amdgcn_cvt_scalef32_pk_f16_fp4(ww[c], 1.0f, 1) * cf2 + o2[4 * c + 1];
        o2[4 * c + 2] = __builtin_amdgcn_cvt_scalef32_pk_f16_fp4(ww[c], 1.0f, 2) * cf2 + o2[4 * c + 2];
        o2[4 * c + 3] = __builtin_amdgcn_cvt_scalef32_pk_f16_fp4(ww[c], 1.0f, 3) * cf2 + o2[4 * c + 3];
    }
}
template <bool FINAL>
DI void peer_v_phase(const Params& p, int layer, const float* gnext, char* smem, int bid, int nb) {
    const int tid = opaque_tid(p), wave = __builtin_amdgcn_readfirstlane(tid >> 6), lane = tid & 63, hh = lane >> 5, li = lane & 31;
    char* ring = smem + wave * (PG_RING_SLOTS * 1024);
    int* idxL = (int*)(smem + 4 * PG_RING_SLOTS * 1024 + wave * 1024); float* cL = (float*)(idxL + 128);
    const unsigned char* tv = (const unsigned char*)(p.ws + WS_TAB) + (size_t)layer * 16 * MB + (size_t)16384 * 512;
    const char* myslot = ring + lane * 16;
    const unsigned lane_off = (unsigned)li * 16u;
    const int* idxH = idxL + hh * 64; const float* cH = cL + hh * 64;
    for (int t = bid * 4 + wave; t < T_TOK; t += nb * 4) {
        const int* ig = (const int*)(p.ws + WS_IDX) + (size_t)t * 128;
        const float* gg = (const float*)(p.ws + WS_GATE) + (size_t)t * 128;
        const float* dg = (const float*)(p.ws + WS_DOT) + (size_t)t * 128;
        const int s0 = (lane & 1) * 64 + (lane >> 1), s1 = s0 + 32;
        idxL[s0] = ig[lane]; idxL[s1] = ig[lane + 64];
        {
            const float d0 = dg[lane] * (1.f / (TAB_SCALE_UI * PG_SX)), d1 = dg[lane + 64] * (1.f / (TAB_SCALE_UI * PG_SX));
            cL[s0] = gg[lane] * gelu_exact(d0) * (1.f / TAB_SCALE_V); cL[s1] = gg[lane + 64] * gelu_exact(d1) * (1.f / TAB_SCALE_V);
        }
        asm volatile("s_waitcnt vmcnt(0) lgkmcnt(0)" ::: "memory");
#pragma unroll
        for (int g = 0; g < 3; ++g) pg_dma4(tv, *(const u32x4*)(idxH + 4 * g), lane_off, ring, g);
        h2_t o2[16];
#pragma unroll
        for (int i = 0; i < 16; ++i) o2[i] = h2_t{(_Float16)0.f, (_Float16)0.f};
#pragma unroll 1
        for (int bt = 0; bt < 4; ++bt) {
#pragma unroll
            for (int gg = 0; gg < 4; ++gg) {
                const int g = bt * 4 + gg;
                if (g + 3 < 16) pg_dma4(tv, *(const u32x4*)(idxH + 4 * (g + 3)), lane_off, ring, g + 3);
                const f32x4 c4 = *(const f32x4*)(cH + 4 * g);
                PG_WAIT_GROUP(g);
                u32x4 w[4];
#pragma unroll
                for (int i = 0; i < 4; ++i) w[i] = *(const u32x4*)(myslot + ((4 * gg + i) & 15) * 1024);
                pg_axpy(o2, w[0], c4.x); pg_axpy(o2, w[1], c4.y); pg_axpy(o2, w[2], c4.z); pg_axpy(o2, w[3], c4.w);
            }
        }
        float r[16];
#pragma unroll
        for (int i = 0; i < 8; ++i) {
            const h2_t send = hh ? o2[i] : o2[i + 8]; const h2_t keep = hh ? o2[i + 8] : o2[i];
            const h2_t got = __builtin_bit_cast(h2_t, sxu<32>(__builtin_bit_cast(unsigned, send), hh));
            r[2 * i] = (float)keep.x + (float)got.x; r[2 * i + 1] = (float)keep.y + (float)got.y;
        }
        float* hr = p.out + (size_t)t * 1024 + 32 * li + 16 * hh;
        f32x4 h0 = *(f32x4*)(hr), h1 = *(f32x4*)(hr + 4), h2 = *(f32x4*)(hr + 8), h3 = *(f32x4*)(hr + 12);
        h0 += f32x4{r[0], r[1], r[2], r[3]}; h1 += f32x4{r[4], r[5], r[6], r[7]};
        h2 += f32x4{r[8], r[9], r[10], r[11]}; h3 += f32x4{r[12], r[13], r[14], r[15]};
        float ss = h0.x * h0.x + h0.y * h0.y + h0.z * h0.z + h0.w * h0.w + h1.x * h1.x + h1.y * h1.y + h1.z * h1.z + h1.w * h1.w
                 + h2.x * h2.x + h2.y * h2.y + h2.z * h2.z + h2.w * h2.w + h3.x * h3.x + h3.y * h3.y + h3.z * h3.z + h3.w * h3.w;
        ss = wave_sum(ss, hh);
        const float rn = rsqrtf(ss * (1.f / 1024.f) + 1e-6f);
        const float* gp = gnext + 32 * li + 16 * hh;
        const f32x4 g0v = *(const f32x4*)(gp), g1v = *(const f32x4*)(gp + 4), g2v = *(const f32x4*)(gp + 8), g3v = *(const f32x4*)(gp + 12);
        if constexpr (FINAL) {
            *(f32x4*)(hr) = h0 * rn * g0v; *(f32x4*)(hr + 4) = h1 * rn * g1v; *(f32x4*)(hr + 8) = h2 * rn * g2v; *(f32x4*)(hr + 12) = h3 * rn * g3v;
        } else {
            *(f32x4*)(hr) = h0; *(f32x4*)(hr + 4) = h1; *(f32x4*)(hr + 8) = h2; *(f32x4*)(hr + 12) = h3;
            const f32x4 n0 = h0 * rn * g0v, n1 = h1 * rn * g1v, n2 = h2 * rn * g2v, n3 = h3 * rn * g3v;
            u16* hno = (u16*)(p.ws + WS_HN) + (size_t)t * 1024 + 32 * li + 16 * hh;
            *(u32x4*)(hno) = u32x4{pk2(n0.x, n0.y), pk2(n0.z, n0.w), pk2(n1.x, n1.y), pk2(n1.z, n1.w)};
            *(u32x4*)(hno + 8) = u32x4{pk2(n2.x, n2.y), pk2(n2.z, n2.w), pk2(n3.x, n3.y), pk2(n3.z, n3.w)};
        }
    }
}
constexpr int AT_LDS_BYTES = 65536;
constexpr float LAMBDA_INIT = 0.35550906759096927f;
constexpr float AT_THR = 8.f;


DI float max16(const f32x16& S) {
    float t0, t1, t2, t3, t4;
    asm volatile("s_nop 15\n\tv_max3_f32 %0, %5, %6, %7\n\tv_max3_f32 %1, %8, %9, %10\n\tv_max3_f32 %2, %11, %12, %13\n\tv_max3_f32 %3, %14, %15, %16\n\t"
                 "v_max3_f32 %4, %17, %18, %19\n\tv_max3_f32 %0, %0, %1, %20\n\tv_max3_f32 %2, %2, %3, %4\n\tv_max_f32 %0, %0, %2"
                 : "=&v"(t0), "=&v"(t1), "=&v"(t2), "=&v"(t3), "=&v"(t4)
                 : "v"(S[0]), "v"(S[1]), "v"(S[2]), "v"(S[3]), "v"(S[4]), "v"(S[5]), "v"(S[6]), "v"(S[7]), "v"(S[8]), "v"(S[9]), "v"(S[10]), "v"(S[11]),
                   "v"(S[12]), "v"(S[13]), "v"(S[14]), "v"(S[15]));
    return t0;
}
DI void attn_tile(const char* Kb, const char* Vb, const char* Qw, f32x16 (&O1)[4], f32x16 (&O2)[4], float& m1, float& l1, float& m2, float& l2,
                  bool diag, bool first, int k0, int qidx, int r, int half) {
    const int ksw = (r >> 1) & 7;
    const char* krow = Kb + r * 128;
    f32x16 S0, S1;
#pragma unroll
    for (int i = 0; i < 16; ++i) { S0[i] = -m1; S1[i] = -m2; }
    __builtin_amdgcn_s_setprio(1);
    {
        bf16x8 kf[4], qf[4];
#pragma unroll
        for (int ks = 0; ks < 4; ++ks) { kf[ks] = lds_frag(krow + (((2 * ks + half) ^ ksw) << 4)); qf[ks] = lds_frag(Qw + ks * 1024); }
#pragma unroll
        for (int ks = 0; ks < 4; ++ks) S0 = MFMA32(kf[ks], qf[ks], S0);
    }
    {
        bf16x8 kf[4], qf[4];
#pragma unroll
        for (int ks = 0; ks < 4; ++ks) { kf[ks] = lds_frag(krow + 4096 + (((2 * ks + half) ^ ksw) << 4)); qf[ks] = lds_frag(Qw + (4 + ks) * 1024); }
#pragma unroll
        for (int ks = 0; ks < 4; ++ks) S1 = MFMA32(kf[ks], qf[ks], S1);
    }
    __builtin_amdgcn_s_setprio(0);
    const int vsw = (r >> 2) & 3;
    const char* vrow = Vb + r * 64;
    const int vo0 = ((0 + half) ^ vsw) << 4, vo1 = ((2 + half) ^ vsw) << 4;
    __builtin_amdgcn_sched_barrier(0);
    if (diag) {
#pragma unroll
        for (int i = 0; i < 16; ++i) if (k0 + crow(i, half) > qidx) { S0[i] = -INFINITY; S1[i] = -INFINITY; }
    }
    float mx0 = max16(S0), mx1 = max16(S1);
    mx0 = fmaxf(mx0, sxf<32>(mx0, half)); mx1 = fmaxf(mx1, sxf<32>(mx1, half));
    if (first || !__all((mx0 <= AT_THR) && (mx1 <= AT_THR))) {
        const float d1 = fmaxf(mx0, 0.f), d2 = fmaxf(mx1, 0.f);
        const float e1 = first ? mx0 : d1, e2 = first ? mx1 : d2;
#pragma unroll
        for (int i = 0; i < 16; ++i) { S0[i] -= e1; S1[i] -= e2; }
        if (!first) {
            const float a1 = __builtin_amdgcn_exp2f(-d1), a2 = __builtin_amdgcn_exp2f(-d2);
#pragma unroll
            for (int d = 0; d < 4; ++d) { O1[d] *= a1; O2[d] *= a2; }
            l1 *= a1; l2 *= a2;
        }
        m1 += e1; m2 += e2;
    }
    __builtin_amdgcn_sched_barrier(0);
    bf16x8 vf[8];
#pragma unroll
    for (int d = 0; d < 4; ++d) { vf[2 * d] = lds_frag(vrow + d * 2048 + vo0); vf[2 * d + 1] = lds_frag(vrow + d * 2048 + vo1); }
    float ps0 = 0.f;
#pragma unroll
    for (int i = 0; i < 16; ++i) { const float pv = __builtin_amdgcn_exp2f(S0[i]); S0[i] = pv; ps0 += pv; }
    l1 += ps0;
    const bf16x8 P00 = pack8(S0, 0), P01 = pack8(S0, 1);
    __builtin_amdgcn_sched_barrier(0);
    __builtin_amdgcn_s_setprio(1);
#pragma unroll
    for (int d = 0; d < 4; ++d) { O1[d] = MFMA32(vf[2 * d], P00, O1[d]); O1[d] = MFMA32(vf[2 * d + 1], P01, O1[d]); }
    float ps1 = 0.f;
#pragma unroll
    for (int i = 0; i < 16; ++i) { const float pv = __builtin_amdgcn_exp2f(S1[i]); S1[i] = pv; ps1 += pv; }
    l2 += ps1;
    const bf16x8 P10 = pack8(S1, 0), P11 = pack8(S1, 1);
#pragma unroll
    for (int g = 0; g < 8; ++g) { __builtin_amdgcn_sched_group_barrier(0x8, 1, 0); __builtin_amdgcn_sched_group_barrier(0x2, 8, 0); }
    __builtin_amdgcn_sched_barrier(0);
#pragma unroll
    for (int d = 0; d < 4; ++d) { O2[d] = MFMA32(vf[2 * d], P10, O2[d]); O2[d] = MFMA32(vf[2 * d + 1], P11, O2[d]); }
    __builtin_amdgcn_s_setprio(0);
    __builtin_amdgcn_sched_barrier(0);
}

DI void attn_phase(const Params& p, char* smem, int bid, int nb) {
    const int tid = opaque_tid8(p), wave = p.pad_, lane = tid & 63, r = lane & 31, half = lane >> 5;
    char* Qs = smem; char* Kbuf = smem + 65536; char* Vbuf = smem + 81920;
    const u16* qk = (const u16*)(p.ws + WS_PROJ);
    const u16* vt = (const u16*)(p.ws + WS_VT);
    const float lam = __uint_as_float(__builtin_amdgcn_readfirstlane(__float_as_uint(
        __expf(wave_sum(p.lq1[lane] * p.lk1[lane], half)) - __expf(wave_sum(p.lq2[lane] * p.lk2[lane], half)) + LAMBDA_INIT)));
    const unsigned q_off = (unsigned)(lane & 31) * 4096u + (unsigned)(lane >> 5) * 16u;
    const unsigned kx = (unsigned)((lane & 7) ^ (lane >> 4));
    const unsigned k_off0 = (unsigned)(lane >> 3) * 4096u + (kx << 4), k_off1 = (unsigned)(lane >> 3) * 4096u + ((kx ^ 4u) << 4);
    const unsigned v_off = (unsigned)(lane >> 2) * (unsigned)(SEQ * 2) + (unsigned)(((lane & 3) ^ ((lane >> 4) & 3)) << 4);
    const int nrounds = (1024 + nb - 1) / nb;
    for (int j = 0; j < nrounds; ++j) {
        const int rank = j * nb + ((j & 1) ? (nb - 1 - bid) : bid);
        if (rank >= 1024) continue;
        const int qb = 63 - (rank >> 4), bh = rank & 15, b = bh >> 3, h = bh & 7;
        const int q0 = qb * 256, tokbase = b * SEQ, qlo = q0 + 32 * wave, qidx = qlo + r;
        const u16* kbase = qk + (size_t)tokbase * 2048 + 1024 + h * 128;
        const u16* vbase = vt + (size_t)(b * 8 + h) * 128 * SEQ;
        const int nkt = 8 * (qb + 1);
        __syncthreads();
        {
            const char* qsrc = (const char*)(qk + (size_t)(tokbase + q0 + wave * 32) * 2048 + h * 128);
#pragma unroll
            for (int i = 0; i < 8; ++i) dma16(qsrc + i * 32, q_off, Qs + (wave * 8 + i) * 1024);
        }
        const char* ksrc = (const char*)(kbase + (size_t)(8 * (wave & 3)) * 2048 + (wave >> 2) * 64);
        const char* vsrc = (const char*)(vbase + (size_t)(wave * 16) * SEQ);
        const unsigned k_off = (wave & 1) ? k_off1 : k_off0;
        dma16(ksrc, k_off, Kbuf + wave * 1024);
        dma16(vsrc, v_off, Vbuf + wave * 1024);
        f32x16 O1[4], O2[4];
#pragma unroll
        for (int d = 0; d < 4; ++d) { O1[d] = zero16(); O2[d] = zero16(); }
        float m1 = 0.f, m2 = 0.f, l1 = 0.f, l2 = 0.f;
        const char* Qw = Qs + wave * 8192 + lane * 16;
        for (int kt = 0; kt < nkt; ++kt) {
            const int k0 = kt * 32, buf = kt & 1;
            asm volatile("s_waitcnt vmcnt(0)" ::: "memory");
            __syncthreads();
            if (kt + 1 < nkt) {
                const char* kn = ksrc + (size_t)(k0 + 32) * 4096; const char* vn = vsrc + (k0 + 32) * 2;
                dma16(kn, k_off, Kbuf + (buf ^ 1) * 8192 + wave * 1024);
                dma16(vn, v_off, Vbuf + (buf ^ 1) * 8192 + wave * 1024);
            }
            if (k0 <= qlo + 31) {
                const bool diag = (k0 + 31 > qlo);
                const char* Kb = Kbuf + buf * 8192; const char* Vb = Vbuf + buf * 8192;
                attn_tile(Kb, Vb, Qw, O1, O2, m1, l1, m2, l2, diag, kt == 0, k0, qidx, r, half);
            }
        }
        l1 += sxf<32>(l1, half); l2 += sxf<32>(l2, half);
        const float i1 = __builtin_amdgcn_rcpf(l1), i2 = lam * __builtin_amdgcn_rcpf(l2);
        float ss = 0.f;
#pragma unroll
        for (int d = 0; d < 4; ++d)
#pragma unroll
            for (int i = 0; i < 16; ++i) { const float v = O1[d][i] * i1 - O2[d][i] * i2; O1[d][i] = v; ss += v * v; }
        ss += sxf<32>(ss, half);
        const float rn = rsqrtf(ss * (1.f / 128.f) + 1e-6f) * (1.f - LAMBDA_INIT);
        u16* orow = (u16*)(p.ws + WS_HN) + (size_t)(tokbase + qidx) * 1024 + h * 128;
        const float* gn = p.diff_norm + h * 128;
        int half_e = half; asm volatile("" : "+v"(half_e));
        f32x4 gv[16];
#pragma unroll
        for (int i = 0; i < 16; ++i) gv[i] = *(const f32x4*)(gn + 32 * (i >> 2) + 8 * (i & 3) + 4 * half_e);
#pragma unroll
        for (int d = 0; d < 4; ++d)
#pragma unroll
            for (int g = 0; g < 4; ++g) {
                const int c0 = 32 * d + 8 * g + 4 * half_e;
                const f32x4 gq = gv[4 * d + g];
                *(u32x2*)(orow + c0) = u32x2{pk2(O1[d][4 * g] * rn * gq.x, O1[d][4 * g + 1] * rn * gq.y), pk2(O1[d][4 * g + 2] * rn * gq.z, O1[d][4 * g + 3] * rn * gq.w)};
            }
    }
}
extern __shared__ __attribute__((aligned(16))) char dyn_smem[];
constexpr int SUB_LDS = 73728;
constexpr int MEGA_LDS_WORK = 2 * SUB_LDS;
constexpr int MEGA_LDS_BYTES = MEGA_LDS_WORK + 16;

__global__ void __launch_bounds__(512, 2) mega_fwd(Params pk) {
    Params p = pk; const int w8 = __builtin_amdgcn_readfirstlane((int)(threadIdx.x >> 6));
    p.wv = w8 & 3; p.pad_ = w8; const int sub = w8 >> 2;
    volatile LAS unsigned* st = (volatile LAS unsigned*)(dyn_smem + MEGA_LDS_WORK);
    if (threadIdx.x == 0) { st[0] = 0u; st[1] = 0u; st[2] = 0u; st[3] = 0u; }
    __syncthreads();
    XcdBarrier bar = xcd_barrier_post((unsigned*)(p.ws + WS_BAR), st, threadIdx.x == 0);
#define XBAR() xcd_barrier(bar, (opaque_tid(p) | sub) == 0)
    char* smem = dyn_smem + sub * SUB_LDS;
    const int nb = 2 * (int)gridDim.x, bid = (int)blockIdx.x + sub * (int)gridDim.x;
    const int bidp = 2 * (int)blockIdx.x + sub;
    const u16* hn = (const u16*)(p.ws + WS_HN);
    phase_prep_a(p, bid, nb);
    asm volatile("; PHASE_END 1");
    XBAR();
    gemm8(p, hn, (const u16*)(p.ws + WS_WGIN), 3072, EpiProjBf16{(u16*)(p.ws + WS_PROJ), 3072});
    gla_glr_phase(p, smem, (int)blockIdx.x, (int)gridDim.x);
    asm volatile("; PHASE_END 2");
    XBAR();
    gla_pass1(p, smem, bid, nb);
    asm volatile("; PHASE_END 3");
    XBAR();
    if (nb >= 256) { if (bid < 128) gla_scan(p, bid, 128); else { phase_prep_b(p, bid - 128, nb - 128); phase_tabconv(p, 0, bid - 128, nb - 128); phase_tabconv(p, 1, bid - 128, nb - 128); } }
    else { gla_scan(p, bid, nb); phase_prep_b(p, bid, nb); phase_tabconv(p, 0, bid, nb); phase_tabconv(p, 1, bid, nb); }
    asm volatile("; PHASE_END 4");
    XBAR();
    gla_pass3(p, smem, bid, nb);
    asm volatile("; PHASE_END 5");
    XBAR();
    gemm8(p, hn, (const u16*)(p.ws + WS_WGOUT), 1024, EpiResid8{p.x, p.out});
    asm volatile("; PHASE_END 6");
    XBAR();
    phase_rmsnorm(p, p.norm_ffn, bid, nb);
    asm volatile("; PHASE_END 7");
    XBAR();
    peer_query_phase8(p, 0, dyn_smem, (int)blockIdx.x, (int)gridDim.x);
    asm volatile("; PHASE_END 8");
    XBAR();
    peer_u_phase(p, 0, smem, bid, nb);
    XBAR();
    peer_v_phase<false>(p, 0, p.norm_mix + 1024, smem, bid, nb);
    asm volatile("; PHASE_END 9");
    XBAR();
    gemm8(p, hn, (const u16*)(p.ws + WS_WDIN), 3072, EpiDiffIn8{p.ws});
    asm volatile("; PHASE_END 10");
    XBAR();
    attn_phase(p, dyn_smem, (int)blockIdx.x, (int)gridDim.x);
    asm volatile("; PHASE_END 11");
    XBAR();
    gemm8(p, hn, (const u16*)(p.ws + WS_WDOUT), 1024, EpiResid8{p.out, p.out});
    asm volatile("; PHASE_END 12");
    XBAR();
    phase_rmsnorm(p, p.norm_ffn + 1024, bid, nb);
    asm volatile("; PHASE_END 13");
    XBAR();
    peer_query_phase8(p, 1, dyn_smem, (int)blockIdx.x, (int)gridDim.x);
    asm volatile("; PHASE_END 14");
    XBAR();
    peer_u_phase(p, 1, smem, bid, nb);
    XBAR();
    peer_v_phase<true>(p, 1, p.norm_final, smem, bid, nb);
}

extern "C" void kernel_launch(void* const* d_in, const int* in_sizes, int n_in, void* d_out, int out_size, void* d_ws, size_t ws_size, hipStream_t stream) {
    Params p{};
    p.x = (const float*)d_in[0]; p.pos = (const int*)d_in[1]; p.norm_mix = (const float*)d_in[2]; p.norm_ffn = (const float*)d_in[3]; p.norm_final = (const float*)d_in[4];
    p.gla_w_in = (const float*)d_in[5]; p.gla_wgu = (const float*)d_in[6]; p.gla_bg = (const float*)d_in[7]; p.gla_norm = (const float*)d_in[8]; p.gla_w_out = (const float*)d_in[9];
    p.diff_w_in = (const float*)d_in[10]; p.lq1 = (const float*)d_in[11]; p.lk1 = (const float*)d_in[12]; p.lq2 = (const float*)d_in[13]; p.lk2 = (const float*)d_in[14];
    p.diff_norm = (const float*)d_in[15]; p.diff_w_out = (const float*)d_in[16];
    p.peer_wq = (const float*)d_in[17]; p.peer_sk = (const float*)d_in[18]; p.peer_u = (const float*)d_in[19]; p.peer_v = (const float*)d_in[20];
    p.out = (float*)d_out; p.ws = (char*)d_ws;
    static int grid = 0;
    if (grid == 0) {
        int dev = 0, cus = 0, per_cu = 0;
        hipGetDevice(&dev);
        hipDeviceGetAttribute(&cus, hipDeviceAttributeMultiprocessorCount, dev);
        hipFuncSetAttribute((const void*)mega_fwd, hipFuncAttributeMaxDynamicSharedMemorySize, MEGA_LDS_BYTES);
        hipOccupancyMaxActiveBlocksPerMultiprocessor(&per_cu, (const void*)mega_fwd, 512, MEGA_LDS_BYTES);
        (void)hipGetLastError();
        if (per_cu < 1) per_cu = 1;
        if (cus < 1) cus = 256;
        grid = cus * (per_cu < 1 ? per_cu : 1);
    }
    hipMemsetAsync((char*)d_ws + WS_BAR, 0, XCD_BAR_WORDS * sizeof(unsigned), stream);
    mega_fwd<<<grid, 512, MEGA_LDS_BYTES, stream>>>(p);
}
```

```cpp
#include <hip/hip_runtime.h>
#include <stdint.h>

#define DI __device__ __forceinline__
typedef unsigned short u16;
typedef __attribute__((ext_vector_type(8))) short bf16x8;
typedef __attribute__((ext_vector_type(16))) float f32x16;
typedef __attribute__((ext_vector_type(2))) __bf16 bf2_t;
typedef __attribute__((ext_vector_type(4))) unsigned u32x4;
typedef __attribute__((ext_vector_type(2))) unsigned u32x2;
typedef __attribute__((ext_vector_type(4))) float f32x4;
#define MFMA32(a, b, c) __builtin_amdgcn_mfma_f32_32x32x16_bf16((a), (b), (c), 0, 0, 0)

constexpr int T_TOK = 32768, SEQ = 16384, DM = 1024;
constexpr int GLA_NPAD = 3328;
constexpr int NTHR = 256;

constexpr size_t MB = 1024ull * 1024ull;
constexpr size_t WS_BAR    = 0;
constexpr size_t WS_ROPE   = 64 * 1024;
constexpr size_t WS_WGIN   = WS_ROPE + 2 * MB;
constexpr size_t WS_WGOUT  = WS_WGIN + (size_t)GLA_NPAD * 1024 * 2;
constexpr size_t WS_WDIN   = WS_WGOUT + 2 * MB;
constexpr size_t WS_WDOUT  = WS_WDIN + 6 * MB;
constexpr size_t WS_WPQ    = WS_WDOUT + 2 * MB;
constexpr size_t WS_SK     = WS_WPQ + 8 * MB;
constexpr size_t WS_GLR    = WS_SK + 1 * MB;
constexpr size_t WS_DEC    = WS_GLR + 2 * MB;
constexpr size_t WS_TAB    = WS_DEC + 1 * MB;
constexpr size_t WS_HN     = WS_TAB + 64 * MB;
constexpr size_t WS_PROJ   = WS_HN + 64 * MB;
constexpr size_t WS_KV     = WS_PROJ + 192 * MB;
constexpr size_t WS_END    = WS_KV + 128 * MB;
static_assert(WS_END <= 512 * MB, "workspace overflow");
constexpr size_t WS_VT     = WS_PROJ + 128 * MB;
constexpr size_t WS_IDX    = WS_KV;
constexpr size_t WS_GATE   = WS_KV + 16 * MB;
constexpr size_t WS_DOT    = WS_KV + 32 * MB;

struct Params {
    const float* x; const int* pos; const float* norm_mix; const float* norm_ffn; const float* norm_final;
    const float* gla_w_in; const float* gla_wgu; const float* gla_bg; const float* gla_norm; const float* gla_w_out;
    const float* diff_w_in; const float* lq1; const float* lk1; const float* lq2; const float* lk2;
    const float* diff_norm; const float* diff_w_out;
    const float* peer_wq; const float* peer_sk; const float* peer_u; const float* peer_v;
    float* out; char* ws;
    int wv; int pad_;
};

DI int opaque_tid(const Params& p) { int l; asm volatile("v_mbcnt_lo_u32_b32 %0, -1, 0\n\tv_mbcnt_hi_u32_b32 %0, -1, %0" : "=v"(l)); return (p.wv << 6) | l; }
DI int opaque_tid8(const Params& p) { int l; asm volatile("v_mbcnt_lo_u32_b32 %0, -1, 0\n\tv_mbcnt_hi_u32_b32 %0, -1, %0" : "=v"(l)); return (p.pad_ << 6) | l; }
DI unsigned pk2(float a, float b) { bf2_t v = {(__bf16)a, (__bf16)b}; return __builtin_bit_cast(unsigned, v); }
DI u16 f2bf(float a) { return (u16)(pk2(a, 0.f) & 0xffffu); }
DI float bflo(unsigned w) { return __uint_as_float(w << 16); }
DI float bfhi(unsigned w) { return __uint_as_float(w & 0xffff0000u); }
DI float bf2f(u16 h) { return __uint_as_float(((unsigned)h) << 16); }
DI int xcd_unit(int j, int bid, int nb) { return ((nb & 7) == 0) ? j * nb + (bid & 7) * (nb >> 3) + (bid >> 3) : j * nb + bid; }
DI int crow(int i, int half) { return (i & 3) + 8 * (i >> 2) + 4 * half; }
template <int MASK> DI unsigned sxu(unsigned v, int half) {
    if constexpr (MASK < 32) return (unsigned)__builtin_amdgcn_ds_swizzle((int)v, (MASK << 10) | 0x1f);
    else { auto r = __builtin_amdgcn_permlane32_swap(v, v, false, false); return half ? r[0] : r[1]; }
}
template <int MASK> DI float sxf(float v, int half) { return __uint_as_float(sxu<MASK>(__float_as_uint(v), half)); }
template <int MASK> DI int sxi(int v, int half) { return (int)sxu<MASK>((unsigned)v, half); }
DI float wave_sum(float v, int half) { v += sxf<32>(v, half); v += sxf<16>(v, half); v += sxf<8>(v, half); v += sxf<4>(v, half); v += sxf<2>(v, half); v += sxf<1>(v, half); return v; }
DI f32x16 zero16() { f32x16 z; for (int i = 0; i < 16; ++i) z[i] = 0.f; return z; }
DI bf16x8 lds_frag(const char* p) { return *(const bf16x8*)p; }
DI bf16x8 lds_frag2(const char* p0, const char* p1) {
    u32x2 a = *(const u32x2*)p0, b = *(const u32x2*)p1; u32x4 r = {a.x, a.y, b.x, b.y}; return __builtin_bit_cast(bf16x8, r);
}
DI bf16x8 pack8(const f32x16& x, int s) {
    u32x4 r = {pk2(x[8 * s], x[8 * s + 1]), pk2(x[8 * s + 2], x[8 * s + 3]), pk2(x[8 * s + 4], x[8 * s + 5]), pk2(x[8 * s + 6], x[8 * s + 7])};
    return __builtin_bit_cast(bf16x8, r);
}
#define XB_TMO      128
#define XB_XCNT(j)  (256  + 64 * (j))
#define XB_XSUB(j)  (1280 + 64 * (j))
#define XB_XGEN(j)  (2304 + 64 * (j))
#define XB_TOP      3328
#define XB_TOPGEN   3392
#define XCD_BAR_WORDS 3456
#define XB_SPIN_CAP (1u << 18)
#define LAS __attribute__((address_space(3)))

__device__ __forceinline__ unsigned xb_ld(unsigned* p)              { return __hip_atomic_load(p, __ATOMIC_RELAXED, __HIP_MEMORY_SCOPE_AGENT); }
__device__ __forceinline__ unsigned xb_add(unsigned* p, unsigned v) { return __hip_atomic_fetch_add(p, v, __ATOMIC_RELAXED, __HIP_MEMORY_SCOPE_AGENT); }
__device__ __forceinline__ unsigned xb_xcc_id() { return (unsigned)__builtin_amdgcn_s_getreg((3 << 11) | 20) & 0xFu; }
#define XB_SPIN(cond, bar) do { unsigned _sp = 0; while (cond) { __builtin_amdgcn_s_sleep(1); \
    if ((++_sp & 255u) == 0u) { if (xb_ld(&(bar)[XB_TMO])) break; if (_sp > XB_SPIN_CAP) { atomicAdd(&(bar)[XB_TMO], 1u); break; } } } } while (0)

struct XcdBarrier {
    unsigned* bar; unsigned x;
    volatile LAS unsigned* st;
};

__device__ __forceinline__ XcdBarrier xcd_barrier_post(unsigned* bar, volatile LAS unsigned* st, bool t0) {
    XcdBarrier b; b.bar = bar; b.x = xb_xcc_id(); b.st = st;
    if (t0) (void)xb_add(&bar[XB_XCNT(b.x)], 1u);
    return b;
}
__device__ __forceinline__ void xcd_barrier_complete(unsigned* bar, unsigned x, unsigned& nloc, unsigned& nx) {
    const unsigned G = gridDim.x * gridDim.y * gridDim.z;
    unsigned sum, cnt, mine, sp = 0u;
    for (;;) {
        sum = 0u; cnt = 0u; mine = 0u;
#pragma unroll
        for (unsigned j = 0; j < 16; ++j) { const unsigned c = xb_ld(&bar[XB_XCNT(j)]); sum += c; cnt += (c > 0u) ? 1u : 0u; mine = (j == x) ? c : mine; }
        if (sum == G) break;
        __builtin_amdgcn_s_sleep(1);
        if ((++sp & 255u) == 0u) { if (xb_ld(&bar[XB_TMO])) break; if (sp > XB_SPIN_CAP) { atomicAdd(&bar[XB_TMO], 1u); break; } }
    }
    nloc = mine > 0u ? mine : 1u; nx = cnt > 0u ? cnt : 1u;
}

__device__ __forceinline__ void xcd_barrier(const XcdBarrier& b, bool t0) {
    asm volatile("s_waitcnt vmcnt(0)" ::: "memory");
    __syncthreads();
    if (t0) {
        unsigned* bar = b.bar;
        __builtin_amdgcn_s_waitcnt(0);
        unsigned nloc = b.st[0], nx = b.st[1];
        if (nloc == 0u) { xcd_barrier_complete(bar, b.x, nloc, nx); b.st[0] = nloc; b.st[1] = nx; }
        const unsigned old = xb_add(&bar[XB_XSUB(b.x)], 1u);
        const unsigned gen = old / nloc;
        if (old + 1u == (gen + 1u) * nloc) {
            __builtin_amdgcn_fence(__ATOMIC_RELEASE, "agent");
            asm volatile("s_waitcnt vmcnt(0)" ::: "memory");
            const unsigned og = xb_add(&bar[XB_TOP], 1u);
            const unsigned tg = og / nx;
            if (og + 1u == (tg + 1u) * nx) xb_add(&bar[XB_TOPGEN], 1u);
            else XB_SPIN(xb_ld(&bar[XB_TOPGEN]) == tg, bar);
            __builtin_amdgcn_fence(__ATOMIC_ACQUIRE, "agent");
            xb_add(&bar[XB_XGEN(b.x)], 1u);
            asm volatile("s_waitcnt vmcnt(0)" ::: "memory");
        } else {
            XB_SPIN(xb_ld(&bar[XB_XGEN(b.x)]) == gen, bar);
            __builtin_amdgcn_fence(__ATOMIC_ACQUIRE, "agent");
            asm volatile("s_waitcnt vmcnt(0)" ::: "memory");
        }
    }
    __syncthreads();
}
DI void rmsnorm_row_bf16(const float* __restrict__ src, const float* __restrict__ g, u16* __restrict__ dst, int lane) {
    const f32x4* xr = (const f32x4*)src;
    f32x4 a0 = xr[lane * 2], a1 = xr[lane * 2 + 1], b0 = xr[128 + lane * 2], b1 = xr[128 + lane * 2 + 1];
    float ss = a0.x * a0.x + a0.y * a0.y + a0.z * a0.z + a0.w * a0.w + a1.x * a1.x + a1.y * a1.y + a1.z * a1.z + a1.w * a1.w
             + b0.x * b0.x + b0.y * b0.y + b0.z * b0.z + b0.w * b0.w + b1.x * b1.x + b1.y * b1.y + b1.z * b1.z + b1.w * b1.w;
    ss = wave_sum(ss, lane >> 5);
    const float r = rsqrtf(ss * (1.f / 1024.f) + 1e-6f);
    const f32x4* gr = (const f32x4*)g;
    f32x4 g0 = gr[lane * 2], g1 = gr[lane * 2 + 1], g2 = gr[128 + lane * 2], g3 = gr[128 + lane * 2 + 1];
    u32x4 o0 = u32x4{pk2(a0.x * r * g0.x, a0.y * r * g0.y), pk2(a0.z * r * g0.z, a0.w * r * g0.w), pk2(a1.x * r * g1.x, a1.y * r * g1.y), pk2(a1.z * r * g1.z, a1.w * r * g1.w)};
    u32x4 o1 = u32x4{pk2(b0.x * r * g2.x, b0.y * r * g2.y), pk2(b0.z * r * g2.z, b0.w * r * g2.w), pk2(b1.x * r * g3.x, b1.y * r * g3.y), pk2(b1.z * r * g3.z, b1.w * r * g3.w)};
    ((u32x4*)dst)[lane] = o0;
    ((u32x4*)dst)[64 + lane] = o1;
}

DI void tconv_item(const float* __restrict__ src, u16* __restrict__ dst, int K, int N, int item, int lane) {
    const int kgroups = K >> 3;
    const int ng = item / kgroups, kg = item - ng * kgroups;
    const int n = ng * 64 + lane, k0 = kg * 8;
    float v[8];
#pragma unroll
    for (int i = 0; i < 8; ++i) v[i] = (n < N) ? src[(size_t)(k0 + i) * N + n] : 0.f;
    u32x4 o = u32x4{pk2(v[0], v[1]), pk2(v[2], v[3]), pk2(v[4], v[5]), pk2(v[6], v[7])};
    *(u32x4*)(dst + (size_t)n * K + k0) = o;
}

DI void conv8(const float* __restrict__ src, u16* __restrict__ dst, size_t i8) {
    const f32x4* s = (const f32x4*)(src + i8 * 8);
    f32x4 a = s[0], b = s[1];
    *(u32x4*)(dst + i8 * 8) = u32x4{pk2(a.x, a.y), pk2(a.z, a.w), pk2(b.x, b.y), pk2(b.z, b.w)};
}

DI void phase_prep_a(const Params& p, int bid, int nb) {
    const int wave = opaque_tid(p) >> 6, lane = opaque_tid(p) & 63;
    const int gw = bid * 4 + wave, nw = nb * 4;
    char* ws = p.ws;
    for (int t = gw; t < T_TOK; t += nw) rmsnorm_row_bf16(p.x + (size_t)t * DM, p.norm_mix, (u16*)(ws + WS_HN) + (size_t)t * DM, lane);
    const int n0 = (GLA_NPAD / 64) * 128, n1 = n0 + 16 * 128;
    for (int it = gw; it < n1; it += nw) {
        if (it < n0) tconv_item(p.gla_w_in, (u16*)(ws + WS_WGIN), 1024, 3088, it, lane);
        else         tconv_item(p.gla_w_out, (u16*)(ws + WS_WGOUT), 1024, 1024, it - n0, lane);
    }
}
DI void phase_prep_b(const Params& p, int bid, int nb) {
    const int wave = opaque_tid(p) >> 6, lane = opaque_tid(p) & 63;
    const int gw = bid * 4 + wave, nw = nb * 4;
    char* ws = p.ws;
    {
        const int n2 = 48 * 128, n3 = n2 + 16 * 128, n4 = n3 + 32 * 128, n5 = n4 + 32 * 128;
        for (int it = gw; it < n5; it += nw) {
            if (it < n2)      tconv_item(p.diff_w_in, (u16*)(ws + WS_WDIN), 1024, 3072, it, lane);
            else if (it < n3) tconv_item(p.diff_w_out, (u16*)(ws + WS_WDOUT), 1024, 1024, it - n2, lane);
            else if (it < n4) tconv_item(p.peer_wq, (u16*)(ws + WS_WPQ), 1024, 2048, it - n3, lane);
            else              tconv_item(p.peer_wq + (size_t)1024 * 2048, (u16*)(ws + WS_WPQ) + (size_t)2048 * 1024, 1024, 2048, it - n4, lane);
        }
    }
    for (int i = gw * 64 + lane; i < 65536; i += nw * 64) conv8(p.peer_sk, (u16*)(ws + WS_SK), (size_t)i);
    for (int i = gw * 64 + lane; i < T_TOK * 8; i += nw * 64) {
        const int t = i >> 3, f = i & 7;
        const float inv = exp2f(-(float)f * (18.931568569324174f / 8.f));
        const float ang = (float)p.pos[t] * inv;
        float sn, cs; sincosf(ang, &sn, &cs);
        ((float2*)(ws + WS_ROPE))[i] = make_float2(cs, sn);
    }
}

constexpr float TAB_SCALE_U = 64.f, TAB_SCALE_V = 6.f;
DI float clamp6(float a) { return fminf(fmaxf(a, -6.f), 6.f); }
DI unsigned pk8_fp4(f32x4 a, f32x4 b, float s) {
    unsigned w = 0;
    w = __builtin_amdgcn_cvt_scalef32_pk_fp4_f32(w, clamp6(a.x * s), clamp6(a.y * s), 1.0f, 0);
    w = __builtin_amdgcn_cvt_scalef32_pk_fp4_f32(w, clamp6(a.z * s), clamp6(a.w * s), 1.0f, 1);
    w = __builtin_amdgcn_cvt_scalef32_pk_fp4_f32(w, clamp6(b.x * s), clamp6(b.y * s), 1.0f, 2);
    w = __builtin_amdgcn_cvt_scalef32_pk_fp4_f32(w, clamp6(b.z * s), clamp6(b.w * s), 1.0f, 3);
    return w;
}
constexpr float TAB_SCALE_UI = 90.f;
DI unsigned pk8_i4(f32x4 a, f32x4 b, float s) {
    const float f[8] = {a.x, a.y, a.z, a.w, b.x, b.y, b.z, b.w};
    unsigned w = 0;
#pragma unroll
    for (int j = 0; j < 8; ++j) { const int q = (int)rintf(fminf(fmaxf(f[j] * s, -7.f), 7.f)); w |= ((unsigned)q & 15u) << (4 * j); }
    return w;
}
DI void phase_tabconv(const Params& p, int layer, int bid, int nb) {
    const size_t n16 = (size_t)16384 * 1024 / 16;
    const float* su = p.peer_u + (size_t)layer * 16384 * 1024;
    const float* sv = p.peer_v + (size_t)layer * 16384 * 1024;
    unsigned char* du = (unsigned char*)(p.ws + WS_TAB) + (size_t)layer * 16 * MB; unsigned char* dv = du + (size_t)16384 * 512;
    for (size_t i = (size_t)bid * NTHR + opaque_tid(p); i < n16; i += (size_t)nb * NTHR) {
        const f32x4* a = (const f32x4*)(su + i * 16); const f32x4* b = (const f32x4*)(sv + i * 16);
        const f32x4 a0 = __builtin_nontemporal_load(a), a1 = __builtin_nontemporal_load(a + 1), a2 = __builtin_nontemporal_load(a + 2), a3 = __builtin_nontemporal_load(a + 3);
        const f32x4 b0 = __builtin_nontemporal_load(b), b1 = __builtin_nontemporal_load(b + 1), b2 = __builtin_nontemporal_load(b + 2), b3 = __builtin_nontemporal_load(b + 3);
        *(u32x2*)(du + i * 8) = u32x2{pk8_i4(a0, a1, TAB_SCALE_UI), pk8_i4(a2, a3, TAB_SCALE_UI)};
        *(u32x2*)(dv + i * 8) = u32x2{pk8_fp4(b0, b1, TAB_SCALE_V), pk8_fp4(b2, b3, TAB_SCALE_V)};
    }
}

DI void phase_rmsnorm(const Params& p, const float* g, int bid, int nb) {
    const int wave = opaque_tid(p) >> 6, lane = opaque_tid(p) & 63;
    for (int t = bid * 4 + wave; t < T_TOK; t += nb * 4) rmsnorm_row_bf16(p.out + (size_t)t * DM, g, (u16*)(p.ws + WS_HN) + (size_t)t * DM, lane);
}
constexpr int G_ROW = 64;
constexpr int G_SLOT = 384 * G_ROW;
constexpr int G_LDS_BYTES = 3 * G_SLOT;
DI const char* uni_ptr(const char* p) {
    const unsigned long long v = (unsigned long long)p;
    const unsigned lo = __builtin_amdgcn_readfirstlane((unsigned)v), hi = __builtin_amdgcn_readfirstlane((unsigned)(v >> 32));
    return (const char*)(((unsigned long long)hi << 32) | lo);
}
DI void dma16(const char* ubase, unsigned voff, char* lds_wave_base) { __builtin_amdgcn_global_load_lds((const unsigned*)(uni_ptr(ubase) + voff), (unsigned*)lds_wave_base, 16, 0, 0); }

template <int WM, int WN, int BROWS = 128, int AROWS = 128, int NW = 4>
DI void gemm_mainloop(const Params& p, const u16* __restrict__ A, int ld, const u16* __restrict__ Bt, int  , int K, char* smem, int wm0, int wn0, f32x16 (&acc)[WM][WN], int wave_in = -1) {
    static_assert((AROWS % (16 * NW)) == 0 && (BROWS % (16 * NW)) == 0, "slot shape");
    constexpr int SLOT = (AROWS + BROWS) * G_ROW, NP = (AROWS + BROWS) / (16 * NW);
    static_assert(NP == 6 || NP == 3 || NP == 4, "counted waits below");
    const int tid = opaque_tid(p), lane = tid & 63, r = lane & 31, half = lane >> 5;
    const int wave = (wave_in < 0) ? p.wv : wave_in;
    const unsigned voff = (unsigned)(lane >> 2) * (unsigned)(ld * 2) + (unsigned)(((lane & 3) ^ ((lane >> 4) & 3)) << 4);
    const char* ab = (const char*)A + (size_t)(wave * 16) * ld * 2;
    const char* bb = (const char*)Bt + (size_t)(wave * 16) * ld * 2;
    const size_t pstep = (size_t)(16 * NW) * ld * 2;
    char* dbase = smem + wave * 1024;
    constexpr int NPA = AROWS / (16 * NW), NPB = BROWS / (16 * NW);
#define G_ISSUE(kt_, slot_) do { const size_t ko_ = (size_t)(kt_) * 64; char* d_ = dbase + (slot_) * SLOT; \
        _Pragma("unroll") for (int i_ = 0; i_ < NPA; ++i_) dma16(ab + i_ * pstep + ko_, voff, d_ + i_ * (NW * 1024)); \
        _Pragma("unroll") for (int i_ = 0; i_ < NPB; ++i_) dma16(bb + i_ * pstep + ko_, voff, d_ + AROWS * G_ROW + i_ * (NW * 1024)); } while (0)
    const int nk = K >> 5;
    asm volatile("s_waitcnt vmcnt(0)\n\ts_barrier" ::: "memory");
    G_ISSUE(0, 0); G_ISSUE(1, 1); G_ISSUE(2, 2);
    const int sw = (r >> 2) & 3;
    const int fo0 = r * G_ROW + ((half ^ sw) << 4), fo1 = r * G_ROW + (((2 + half) ^ sw) << 4);
    int slot = 0;
    for (int kt = 0; kt < nk; ++kt) {
        if constexpr (NP == 6) {
            if (kt + 2 < nk)      asm volatile("s_waitcnt vmcnt(12)\n\ts_barrier" ::: "memory");
            else if (kt + 1 < nk) asm volatile("s_waitcnt vmcnt(6)\n\ts_barrier" ::: "memory");
            else                  asm volatile("s_waitcnt vmcnt(0)\n\ts_barrier" ::: "memory");
        } else if constexpr (NP == 4) {
            if (kt + 2 < nk)      asm volatile("s_waitcnt vmcnt(8)\n\ts_barrier" ::: "memory");
            else if (kt + 1 < nk) asm volatile("s_waitcnt vmcnt(4)\n\ts_barrier" ::: "memory");
            else                  asm volatile("s_waitcnt vmcnt(0)\n\ts_barrier" ::: "memory");
        } else {
            if (kt + 2 < nk)      asm volatile("s_waitcnt vmcnt(6)\n\ts_barrier" ::: "memory");
            else if (kt + 1 < nk) asm volatile("s_waitcnt vmcnt(3)\n\ts_barrier" ::: "memory");
            else                  asm volatile("s_waitcnt vmcnt(0)\n\ts_barrier" ::: "memory");
        }
        const char* As = smem + slot * SLOT; const char* Bs = As + AROWS * G_ROW;
        bf16x8 af[2][WM], bfr[2][WN];
#pragma unroll
        for (int ks = 0; ks < 2; ++ks) {
            const int fo = ks ? fo1 : fo0;
#pragma unroll
            for (int i = 0; i < WM; ++i) af[ks][i] = lds_frag(As + (wm0 + 32 * i) * G_ROW + fo);
#pragma unroll
            for (int j = 0; j < WN; ++j) bfr[ks][j] = lds_frag(Bs + (wn0 + 32 * j) * G_ROW + fo);
        }
        asm volatile("s_waitcnt lgkmcnt(0)\n\ts_barrier" ::: "memory");
        if (kt + 3 < nk) G_ISSUE(kt + 3, slot);
#pragma unroll
        for (int ks = 0; ks < 2; ++ks)
#pragma unroll
            for (int i = 0; i < WM; ++i)
#pragma unroll
                for (int j = 0; j < WN; ++j) acc[i][j] = MFMA32(af[ks][i], bfr[ks][j], acc[i][j]);
        slot = (slot == 2) ? 0 : slot + 1;
    }
#undef G_ISSUE
}

enum { EPI_GLA_IN = 0, EPI_RESID = 1, EPI_DIFF_IN = 2 };

template <int EPI, int BN = 256>
DI void gemm_phase(const Params& p, const u16* A, const u16* Bt, int N, const float* resid, char* smem, int bid, int nb) {
    constexpr int TN = BN / 64;
    const int ntn = N / BN, ntm = T_TOK / 128;
    const int tid = opaque_tid(p), wave = tid >> 6, lane = tid & 63, r = lane & 31, half = lane >> 5;
    const int wm0 = (wave >> 1) * 64, wn0 = (wave & 1) * (BN / 2);
    for (int j = 0; j * nb < ntn * ntm; ++j) {
        const int u = xcd_unit(j, bid, nb);
        if (u >= ntn * ntm) continue;
        const int mt = u / ntn, nt = u - mt * ntn;
        const int m0 = mt * 128, n0 = nt * BN;
        f32x16 acc[2][TN];
#pragma unroll
        for (int i = 0; i < 2; ++i)
#pragma unroll
            for (int j = 0; j < TN; ++j) acc[i][j] = zero16();
        gemm_mainloop<2, TN, BN>(p, A + (size_t)m0 * 1024, 1024, Bt + (size_t)n0 * 1024, 1024, 1024, smem, wm0, wn0, acc);
        if constexpr (EPI == EPI_RESID) {
#pragma unroll
            for (int ti = 0; ti < 2; ++ti)
#pragma unroll
                for (int tj0 = 0; tj0 < TN; tj0 += 2) {
                    float rv[2][16];
#pragma unroll
                    for (int tt = 0; tt < 2; ++tt)
#pragma unroll
                        for (int i = 0; i < 16; ++i) rv[tt][i] = resid[(size_t)(m0 + wm0 + 32 * ti + crow(i, half)) * 1024 + n0 + wn0 + 32 * (tj0 + tt) + r];
#pragma unroll
                    for (int tt = 0; tt < 2; ++tt)
#pragma unroll
                        for (int i = 0; i < 16; ++i) p.out[(size_t)(m0 + wm0 + 32 * ti + crow(i, half)) * 1024 + n0 + wn0 + 32 * (tj0 + tt) + r] = rv[tt][i] + acc[ti][tj0 + tt][i];
                }
        } else
#pragma unroll
        for (int ti = 0; ti < 2; ++ti)
#pragma unroll
            for (int tj = 0; tj < TN; ++tj) {
                const int col = n0 + wn0 + 32 * tj + r;
                const int rowb = m0 + wm0 + 32 * ti;
                if constexpr (EPI == EPI_GLA_IN) {
                    u16* o = (u16*)(p.ws + WS_PROJ);
#pragma unroll
                    for (int i = 0; i < 16; ++i) o[(size_t)(rowb + crow(i, half)) * 3072 + col] = f2bf(acc[ti][tj][i]);
                } else if constexpr (EPI == EPI_RESID) {
#pragma unroll
                    for (int i = 0; i < 16; ++i) {
                        const size_t off = (size_t)(rowb + crow(i, half)) * 1024 + col;
                        p.out[off] = resid[off] + acc[ti][tj][i];
                    }
                } else if constexpr (EPI == EPI_DIFF_IN) {
                    if (col < 2048) {
                        const int c64 = col & 63;
                        const float qs = (col < 1024) ? 0.125f * 1.4426950408889634f : 1.0f;
                        const float2* cst = (const float2*)(p.ws + WS_ROPE);
                        u16* o = (u16*)(p.ws + WS_PROJ);
                        const bool rot = ((32 * tj) & 63) == 0;
                        float2 csr[16];
                        if (rot) {
#pragma unroll
                            for (int i = 0; i < 16; ++i) csr[i] = cst[(size_t)(rowb + crow(i, half)) * 8 + (c64 & 7)];
                        }
#pragma unroll
                        for (int i = 0; i < 16; ++i) {
                            const int row = rowb + crow(i, half);
                            float v = acc[ti][tj][i];
                            if (rot) {
                                const float pv = sxf<8>(v, half);
                                const float2 cs = csr[i];
                                if (c64 < 16) v = (c64 < 8) ? (v * cs.x - pv * cs.y) : (v * cs.x + pv * cs.y);
                            }
                            o[(size_t)row * 2048 + col] = f2bf(v * qs);
                        }
                    } else {
                        const int hv = (col - 2048) >> 7, dv = (col - 2048) & 127;
                        const int b = rowb >> 14, s0 = rowb & (SEQ - 1);
                        u16* o = (u16*)(p.ws + WS_VT) + ((size_t)(b * 8 + hv) * 128 + dv) * SEQ + s0;
#pragma unroll
                        for (int g = 0; g < 4; ++g) {
                            u32x2 w = {pk2(acc[ti][tj][4 * g], acc[ti][tj][4 * g + 1]), pk2(acc[ti][tj][4 * g + 2], acc[ti][tj][4 * g + 3])};
                            *(u32x2*)(o + 16 * (g >> 1) + 8 * half + 4 * (g & 1)) = w;
                        }
                    }
                }
            }
    }
}
namespace pg8 {
#define PG8_LAS __attribute__((address_space(3)))
typedef unsigned short bf16_t;
typedef short bf16x8 __attribute__((ext_vector_type(8)));
typedef float f32x4 __attribute__((ext_vector_type(4)));
typedef unsigned u32x4 __attribute__((ext_vector_type(4)));
constexpr int BM = 256, BK = 64, HALF = 128, HTB = HALF * BK * 2  , STAGE_BYTES = 8 * HTB, NXCD = 8, WGM = 8;

__host__ __device__ __forceinline__ int lds_byte(int r, int c) { const int st = (r >> 4) * 2 + (c >> 5), rr = r & 15, cc = c & 31, ob = rr * 64 + cc * 2; return st * 1024 + (ob ^ (((ob >> 9) & 1) << 5)); }
__host__ __device__ __forceinline__ void stage_rc(int b, int& R, int& C) { const int st = b / 1024, sb = b % 1024, swz = sb ^ (((sb >> 9) & 1) << 5); R = (st >> 1) * 16 + swz / 64; C = (st & 1) * 32 + (swz % 64) / 2; }
__host__ __device__ __forceinline__ int perm32(int rho) { const int n = rho >> 4, i = rho & 15; return 8 * (i >> 2) + 4 * n + (i & 3); }

struct Unit { int pm, pn; };
struct Gemm { const bf16_t* A; const bf16_t* Bt; int M, N, K; };

struct StaticOrder {
    int nM, nN, nwg, G, c;
    __host__ __device__ void init(int M, int N, int G_, int c_) { nM = M / BM; nN = N / BM; nwg = nM * nN; G = G_; c = c_; }
    __host__ __device__ bool next(int i, Unit& u) const {
        const long L = (long)i * G + c; if (L >= nwg) return false;
        int wgid = (int)L; { const int q = nwg / NXCD, r = nwg % NXCD, xcd = wgid % NXCD, off = wgid / NXCD; wgid = (xcd < r ? xcd * (q + 1) : r * (q + 1) + (xcd - r) * q) + off; }
        const int nig = WGM * nN, gid = wgid / nig, fm = gid * WGM, gsz = (nM - fm) < WGM ? (nM - fm) : WGM;
        u.pm = fm + ((wgid % nig) % gsz); u.pn = (wgid % nig) / gsz; return true;
    }
    __device__ __forceinline__ void a_ready(const Unit&) const {}
    __device__ __forceinline__ void done(const Unit&) const {}
};
template <class Epi, class Sched>
__device__ __forceinline__ void gemm_phase(PG8_LAS unsigned char* lds, const Gemm g, const Sched& S, const Epi& E, const int tid) {
    const int wid = __builtin_amdgcn_readfirstlane(tid >> 6), lane = tid & 63, wr = wid >> 2, wc = wid & 3, fr = lane & 15, fq = lane >> 4;
    const int K = g.K, nt = K / BK;
    unsigned voffA[2], voffB[2];
#pragma unroll
    for (int i = 0; i < 2; ++i) { int R, C; stage_rc(tid * 16 + i * 8192, R, C); const int Rb = Epi::PERM ? ((R & ~31) + perm32(R & 31)) : R;
        voffA[i] = (unsigned)(R * K + C) * 2u; voffB[i] = (unsigned)(Rb * K + C) * 2u; }
    const size_t kstep = (size_t)(BK * 2);
    const size_t hstep = (size_t)HALF * K * 2;
    const size_t tstep = 2 * hstep;
    const unsigned ldsw = (unsigned)wid * 1024u;
    const int aoff = lds_byte(wr * 64 + fr, fq * 8), boff = lds_byte(wc * 32 + fr, fq * 8);
#define PG8_SA(b, h) (((b) * 2 + (h)) * HTB)
#define PG8_SB(b, h) ((4 + (b) * 2 + (h)) * HTB)
#define PG8_STAGE(bufoff, gbase, voff) do { _Pragma("unroll") for (int _i = 0; _i < 2; ++_i) \
        __builtin_amdgcn_global_load_lds((const unsigned*)((const char*)(gbase) + (voff)[_i]), (PG8_LAS unsigned*)(lds + (bufoff) + ldsw + _i * 8192), 16, 0, 0); } while (0)
#define PG8_LDA(dst, b, h) do { _Pragma("unroll") for (int m = 0; m < 4; ++m) _Pragma("unroll") for (int k = 0; k < 2; ++k) dst[m][k] = *(const PG8_LAS bf16x8*)(lds + PG8_SA(b, h) + aoff + m * 2048 + k * 1024); } while (0)
#define PG8_LDB(dst, b, h) do { _Pragma("unroll") for (int n = 0; n < 2; ++n) _Pragma("unroll") for (int k = 0; k < 2; ++k) dst[n][k] = *(const PG8_LAS bf16x8*)(lds + PG8_SB(b, h) + boff + n * 2048 + k * 1024); } while (0)
#define PG8_MMA(ai, bj, At, Bt) do { __builtin_amdgcn_s_setprio(1); _Pragma("unroll") for (int m = 0; m < 4; ++m) _Pragma("unroll") for (int n = 0; n < 2; ++n) _Pragma("unroll") for (int k = 0; k < 2; ++k) \
        acc[ai][bj][m][n] = __builtin_amdgcn_mfma_f32_16x16x32_bf16(Bt[n][k], At[m][k], acc[ai][bj][m][n], 0, 0, 0); __builtin_amdgcn_s_setprio(0); } while (0)
#define PG8_WAIT_V(n) asm volatile("s_waitcnt vmcnt(" #n ")" ::: "memory")
#define PG8_WAIT_L(n) asm volatile("s_waitcnt lgkmcnt(" #n ")" ::: "memory")
#define PG8_BAR __builtin_amdgcn_s_barrier()
#define PG8_SCHED __builtin_amdgcn_sched_barrier(0)
    Unit cur, nxt; int ui = 0;
    if (!S.next(0, cur)) return;
    f32x4 acc[2][2][4][2];
#pragma unroll
    for (int a = 0; a < 2; ++a)
#pragma unroll
        for (int b = 0; b < 2; ++b)
#pragma unroll
            for (int m = 0; m < 4; ++m)
#pragma unroll
                for (int n = 0; n < 2; ++n) acc[a][b][m][n] = (f32x4){0.f, 0.f, 0.f, 0.f};
    bf16x8 At[4][2], B0[2][2], B1[2][2];
    const char* cA = (const char*)g.A + (size_t)cur.pm * tstep; const char* cB = (const char*)g.Bt + (size_t)cur.pn * tstep;
    S.a_ready(cur);
    PG8_STAGE(PG8_SB(0, 0), cB, voffB); PG8_STAGE(PG8_SA(0, 0), cA, voffA); PG8_STAGE(PG8_SB(0, 1), cB + hstep, voffB); PG8_STAGE(PG8_SA(0, 1), cA + hstep, voffA);
    if (wr == 1) PG8_BAR;
    PG8_WAIT_V(4); PG8_BAR;
    PG8_STAGE(PG8_SB(1, 0), cB + kstep, voffB); PG8_STAGE(PG8_SA(1, 0), cA + kstep, voffA); PG8_STAGE(PG8_SB(1, 1), cB + hstep + kstep, voffB);
    PG8_WAIT_V(6); PG8_BAR;
    for (;;) {
        const bool has_next = S.next(ui + 1, nxt);
        const char* nA = has_next ? (const char*)g.A + (size_t)nxt.pm * tstep : cA; const char* nB = has_next ? (const char*)g.Bt + (size_t)nxt.pn * tstep : cB;
        for (int t = 0; t < nt; t += 2) {
            const bool last = (t == nt - 2);
            const char* a1 = cA + (size_t)(t + 1) * kstep;
            const char* a2 = last ? nA : cA + (size_t)(t + 2) * kstep; const char* b2 = last ? nB : cB + (size_t)(t + 2) * kstep;
            const char* a3 = a2 + kstep; const char* b3 = b2 + kstep;
            if (last && has_next) S.a_ready(nxt);
            PG8_LDB(B0, 0, 0); PG8_SCHED; PG8_LDA(At, 0, 0); PG8_STAGE(PG8_SA(1, 1), a1 + hstep, voffA);
            PG8_WAIT_L(8); PG8_BAR; PG8_WAIT_L(0); PG8_MMA(0, 0, At, B0); PG8_BAR; PG8_SCHED;
            PG8_LDB(B1, 0, 1); PG8_STAGE(PG8_SB(0, 0), b2, voffB);
            PG8_BAR; PG8_WAIT_L(0); PG8_MMA(0, 1, At, B1); PG8_BAR;
            PG8_LDA(At, 0, 1); PG8_STAGE(PG8_SA(0, 0), a2, voffA);
            PG8_BAR; PG8_WAIT_L(0); PG8_MMA(1, 0, At, B0); PG8_BAR; PG8_SCHED;
            PG8_STAGE(PG8_SB(0, 1), b2 + hstep, voffB);
            PG8_WAIT_V(6); PG8_BAR; PG8_MMA(1, 1, At, B1); PG8_BAR;
            PG8_LDB(B0, 1, 0); PG8_SCHED; PG8_LDA(At, 1, 0); PG8_STAGE(PG8_SA(0, 1), a2 + hstep, voffA);
            PG8_WAIT_L(8); PG8_BAR; PG8_WAIT_L(0); PG8_MMA(0, 0, At, B0); PG8_BAR; PG8_SCHED;
            PG8_LDB(B1, 1, 1); PG8_STAGE(PG8_SB(1, 0), b3, voffB);
            PG8_BAR; PG8_WAIT_L(0); PG8_MMA(0, 1, At, B1); PG8_BAR;
            PG8_LDA(At, 1, 1); PG8_STAGE(PG8_SA(1, 0), a3, voffA);
            PG8_BAR; PG8_WAIT_L(0); PG8_MMA(1, 0, At, B0); PG8_BAR; PG8_SCHED;
            PG8_STAGE(PG8_SB(1, 1), b3 + hstep, voffB);
            PG8_WAIT_V(6); PG8_BAR; PG8_MMA(1, 1, At, B1); PG8_BAR;
        }
        if constexpr (!Epi::AFTER_DRAIN) { E(acc, cur, wr, wc, fr, fq); S.done(cur); }
        if (!has_next) break;
#pragma unroll
        for (int a = 0; a < 2; ++a)
#pragma unroll
            for (int b = 0; b < 2; ++b)
#pragma unroll
                for (int m = 0; m < 4; ++m)
#pragma unroll
                    for (int n = 0; n < 2; ++n) acc[a][b][m][n] = (f32x4){0.f, 0.f, 0.f, 0.f};
        cur = nxt; cA = nA; cB = nB; ++ui;
    }
    PG8_WAIT_V(0);
    if (wr == 0) PG8_BAR;
    PG8_BAR;
    if constexpr (Epi::AFTER_DRAIN) { E.fused(acc, cur, wr, wc, fr, fq, lds, wid, lane); S.done(cur); }
#undef PG8_SA
#undef PG8_SB
#undef PG8_STAGE
#undef PG8_LDA
#undef PG8_LDB
#undef PG8_MMA
#undef PG8_WAIT_V
#undef PG8_WAIT_L
#undef PG8_BAR
#undef PG8_SCHED
}
}

struct EpiProjBf16 {
    static constexpr bool PERM = true, AFTER_DRAIN = false;
    u16* O; int ldc;
    DI void operator()(const pg8::f32x4 (&acc)[2][2][4][2], const pg8::Unit& u, int wr, int wc, int fr, int fq) const {
        const int row0 = u.pm * 256 + wr * 64 + fr, col0 = u.pn * 256 + wc * 32 + 8 * fq;
#pragma unroll
        for (int ai = 0; ai < 2; ++ai)
#pragma unroll
            for (int m = 0; m < 4; ++m) {
                u16* rowp = O + (size_t)(row0 + ai * 128 + m * 16) * ldc + col0;
#pragma unroll
                for (int bj = 0; bj < 2; ++bj) {
                    const pg8::f32x4 v0 = acc[ai][bj][m][0], v1 = acc[ai][bj][m][1];
                    *(u32x4*)(rowp + bj * 128) = u32x4{pk2(v0[0], v0[1]), pk2(v0[2], v0[3]), pk2(v1[0], v1[1]), pk2(v1[2], v1[3])};
                }
            }
    }
};
struct EpiResid8 {
    static constexpr bool PERM = false, AFTER_DRAIN = false;
    const float* resid; float* out;
    DI void operator()(const pg8::f32x4 (&acc)[2][2][4][2], const pg8::Unit& u, int wr, int wc, int fr, int fq) const {
        const int row0 = u.pm * 256 + wr * 64 + fr, col0 = u.pn * 256 + wc * 32 + 4 * fq;
#pragma unroll
        for (int ai = 0; ai < 2; ++ai)
#pragma unroll
            for (int mp = 0; mp < 2; ++mp) {
                pg8::f32x4 rv[2][2][2];
#pragma unroll
                for (int mm = 0; mm < 2; ++mm)
#pragma unroll
                    for (int bj = 0; bj < 2; ++bj)
#pragma unroll
                        for (int n = 0; n < 2; ++n) rv[mm][bj][n] = *(const pg8::f32x4*)(resid + (size_t)(row0 + ai * 128 + (2 * mp + mm) * 16) * 1024 + col0 + bj * 128 + n * 16);
#pragma unroll
                for (int mm = 0; mm < 2; ++mm)
#pragma unroll
                    for (int bj = 0; bj < 2; ++bj)
#pragma unroll
                        for (int n = 0; n < 2; ++n) *(pg8::f32x4*)(out + (size_t)(row0 + ai * 128 + (2 * mp + mm) * 16) * 1024 + col0 + bj * 128 + n * 16) = rv[mm][bj][n] + acc[ai][bj][2 * mp + mm][n];
            }
    }
};
struct EpiDiffIn8 {
    static constexpr bool PERM = true, AFTER_DRAIN = false;
    char* ws;
    DI void operator()(const pg8::f32x4 (&acc)[2][2][4][2], const pg8::Unit& u, int wr, int wc, int fr, int fq) const {
        const int row0 = u.pm * 256 + wr * 64 + fr;
        if (u.pn < 8) {
            const float qs = (u.pn < 4) ? 0.125f * 1.4426950408889634f : 1.0f;
            u16* o = (u16*)(ws + WS_PROJ);
            const int col0 = u.pn * 256 + wc * 32 + 8 * fq;
            const bool ropew = (wc & 1) == 0;
            const float sg = (fq == 0) ? -1.f : 1.f; const bool act = fq < 2;
#pragma unroll
            for (int ai = 0; ai < 2; ++ai) {
                pg8::f32x4 cs[4][4];
                if (ropew) {
#pragma unroll
                    for (int m = 0; m < 4; ++m) { const pg8::f32x4* cp = (const pg8::f32x4*)(ws + WS_ROPE) + (size_t)(row0 + ai * 128 + m * 16) * 4;
#pragma unroll
                        for (int k = 0; k < 4; ++k) cs[m][k] = cp[k]; }
                }
#pragma unroll
                for (int m = 0; m < 4; ++m)
#pragma unroll
                    for (int bj = 0; bj < 2; ++bj) {
                        pg8::f32x4 v0 = acc[ai][bj][m][0], v1 = acc[ai][bj][m][1];
                        if (ropew) {
#pragma unroll
                            for (int j = 0; j < 4; ++j) {
                                const float p0 = sxf<16>(v0[j], 0), p1 = sxf<16>(v1[j], 0);
                                const float c0 = cs[m][j >> 1][2 * (j & 1)], s0 = cs[m][j >> 1][2 * (j & 1) + 1];
                                const float c1 = cs[m][2 + (j >> 1)][2 * (j & 1)], s1 = cs[m][2 + (j >> 1)][2 * (j & 1) + 1];
                                const float r0 = v0[j] * c0 + sg * p0 * s0, r1 = v1[j] * c1 + sg * p1 * s1;
                                v0[j] = act ? r0 : v0[j]; v1[j] = act ? r1 : v1[j];
                            }
                        }
                        *(u32x4*)(o + (size_t)(row0 + ai * 128 + m * 16) * 2048 + col0 + bj * 128) =
                            u32x4{pk2(v0[0] * qs, v0[1] * qs), pk2(v0[2] * qs, v0[3] * qs), pk2(v1[0] * qs, v1[1] * qs), pk2(v1[2] * qs, v1[3] * qs)};
                    }
            }
        } else {
            u16* vt = (u16*)(ws + WS_VT);
#pragma unroll
            for (int ai = 0; ai < 2; ++ai)
#pragma unroll
                for (int m = 0; m < 4; ++m) {
                    const int row = row0 + ai * 128 + m * 16, b = row >> 14, sq = row & (SEQ - 1);
                    const int sp = (sq & ~12) | ((sq & 4) << 1) | ((sq & 8) >> 1);
#pragma unroll
                    for (int bj = 0; bj < 2; ++bj) {
                        const int hv = 2 * (u.pn - 8) + bj, dv0 = wc * 32 + 8 * fq;
                        u16* vp = vt + ((size_t)((b * 8 + hv) * 128 + dv0)) * SEQ + sp;
                        const pg8::f32x4 v0 = acc[ai][bj][m][0], v1 = acc[ai][bj][m][1];
#pragma unroll
                        for (int j = 0; j < 4; ++j) { vp[(size_t)j * SEQ] = f2bf(v0[j]); vp[(size_t)(4 + j) * SEQ] = f2bf(v1[j]); }
                    }
                }
        }
    }
};
template <class Epi>
DI void gemm8(const Params& p, const u16* A, const u16* Bt, int N, const Epi& E) {
    extern __shared__ __attribute__((aligned(16))) char dyn_smem_g[];
    pg8::StaticOrder so; so.init(T_TOK, N, (int)gridDim.x, (int)blockIdx.x);
    pg8::Gemm g; g.A = A; g.Bt = Bt; g.M = T_TOK; g.N = N; g.K = 1024;
    pg8::gemm_phase((PG8_LAS unsigned char*)dyn_smem_g, g, so, E, opaque_tid8(p));
}
DI void gla_glr_phase(const Params& p, char* smem, int bid, int nb) {
    const int tid = opaque_tid(p), wave = tid >> 6, lane = tid & 63, r = lane & 31, half = lane >> 5;
    const u16* hn = (const u16*)(p.ws + WS_HN);
    const u16* wg = (const u16*)(p.ws + WS_WGIN) + (size_t)3072 * 1024;
    for (int u = bid; u < T_TOK / 128; u += nb) {
        const int m0 = u * 128;
        f32x16 acc[1][2];
        acc[0][0] = zero16(); acc[0][1] = zero16();
        gemm_mainloop<1, 2, 64, 128>(p, hn + (size_t)m0 * 1024, 1024, wg, 1024, 1024, smem, 32 * wave, 0, acc);
        if (r < 16) {
            float* o = (float*)(p.ws + WS_GLR);
#pragma unroll
            for (int i = 0; i < 16; ++i) o[(size_t)(m0 + 32 * wave + crow(i, half)) * 16 + r] = acc[0][0][i];
        }
    }
}
constexpr int CUM_LD = 129;

DI float log_sigmoid(float z) {
    const float e = __builtin_amdgcn_exp2f(-fabsf(z) * 1.4426950408889634f);
    return fminf(z, 0.f) - __builtin_amdgcn_logf(1.f + e) * 0.6931471805599453f;
}

DI void gla_cum(const Params& p, int tok0, int h, float* cumL, float* glrL) {
    const int tid = opaque_tid(p), d = tid & 127, part = tid >> 7;
    const float* glr = (const float*)(p.ws + WS_GLR) + (size_t)tok0 * 16;
    ((f32x4*)glrL)[tid] = ((const f32x4*)glr)[tid];
    float w[16];
#pragma unroll
    for (int q = 0; q < 16; ++q) w[q] = p.gla_wgu[q * 512 + h * 128 + d];
    const float bias = p.gla_bg[h * 128 + d];
    __syncthreads();
    float run = 0.f;
#pragma unroll 1
    for (int c0 = part * 32; c0 < part * 32 + 32; c0 += 8) {
        float gl[8];
#pragma unroll
        for (int j = 0; j < 8; ++j) {
            const f32x4* gr = (const f32x4*)(glrL + (c0 + j) * 16);
            const f32x4 g0 = gr[0], g1 = gr[1], g2 = gr[2], g3 = gr[3];
            const float p0 = g0.x * w[0] + g0.y * w[1] + g0.z * w[2] + g0.w * w[3];
            const float p1 = g1.x * w[4] + g1.y * w[5] + g1.z * w[6] + g1.w * w[7];
            const float p2 = g2.x * w[8] + g2.y * w[9] + g2.z * w[10] + g2.w * w[11];
            const float p3 = g3.x * w[12] + g3.y * w[13] + g3.z * w[14] + g3.w * w[15];
            gl[j] = log_sigmoid(bias + ((p0 + p1) + (p2 + p3))) * (1.f / 16.f);
        }
#pragma unroll
        for (int j = 0; j < 8; ++j) { run += gl[j]; cumL[(c0 + j) * CUM_LD + d] = run; }
    }
    __syncthreads();
    if (part == 1) {
        const float add = cumL[31 * CUM_LD + d];
#pragma unroll 8
        for (int c = 32; c < 64; ++c) cumL[c * CUM_LD + d] += add;
    }
    __syncthreads();
}

DI void gla_pass1(const Params& p, char* smem, int bid, int nb) {
    const int tid = opaque_tid(p), wave = tid >> 6, lane = tid & 63, r = lane & 31, half = lane >> 5;
    float* cumL = (float*)smem; char* vT = smem; char* kdT = smem + 36864; float* glrL = (float*)(smem + 36864);
    const u16* proj = (const u16*)(p.ws + WS_PROJ);
    for (int u = bid; u < 2048; u += nb) {
        const int bh = u >> 8, n = u & 255, b = bh >> 2, h = bh & 3;
        const int tok0 = b * SEQ + n * 64;
        __syncthreads();
        gla_cum(p, tok0, h, cumL, glrL);
        if (tid < 128) ((float*)(p.ws + WS_DEC))[(size_t)u * 128 + tid] = __expf(cumL[63 * CUM_LD + tid]);
#pragma unroll 1
        for (int it = 0; it < 4; ++it) {
            const int d0 = (wave + 4 * it) * 8;
            const u32x4 kreg = *(const u32x4*)(proj + (size_t)(tok0 + lane) * 3072 + 512 + h * 128 + d0);
            const unsigned wv[4] = {kreg.x, kreg.y, kreg.z, kreg.w};
            const float* cl = cumL + 63 * CUM_LD + d0; const float* cc = cumL + lane * CUM_LD + d0;
            char* dst = kdT + (d0 * 72 + lane) * 2;
#pragma unroll
            for (int i = 0; i < 8; ++i) {
                const float kv = (i & 1) ? bfhi(wv[i >> 1]) : bflo(wv[i >> 1]);
                const float e = __expf(cl[i] - cc[i]);
                *(u16*)(dst + i * 144) = f2bf(kv * e);
            }
        }
        __syncthreads();
#pragma unroll 1
        for (int it = 0; it < 8; ++it) {
            const int v0 = (wave + 4 * it) * 8;
            const u32x4 vr = *(const u32x4*)(proj + (size_t)(tok0 + lane) * 3072 + 1024 + h * 256 + v0);
            const unsigned wv[4] = {vr.x, vr.y, vr.z, vr.w};
            char* dst = vT + (v0 * 72 + lane) * 2;
#pragma unroll
            for (int i = 0; i < 8; ++i) *(u16*)(dst + i * 144) = (u16)((i & 1) ? (wv[i >> 1] >> 16) : (wv[i >> 1] & 0xffffu));
        }
        __syncthreads();
        u16* kvo = (u16*)(p.ws + WS_KV) + (size_t)u * 32768;
#pragma unroll 1
        for (int jh = 0; jh < 2; ++jh) {
            f32x16 acc[2][2];
#pragma unroll
            for (int i = 0; i < 2; ++i)
#pragma unroll
                for (int j = 0; j < 2; ++j) acc[i][j] = zero16();
#pragma unroll
            for (int ks = 0; ks < 4; ++ks) {
                bf16x8 af[2], bfr[2];
#pragma unroll
                for (int i = 0; i < 2; ++i) af[i] = lds_frag(vT + (64 * wave + 32 * i + r) * 144 + ks * 32 + half * 16);
#pragma unroll
                for (int j = 0; j < 2; ++j) bfr[j] = lds_frag(kdT + (64 * jh + 32 * j + r) * 144 + ks * 32 + half * 16);
#pragma unroll
                for (int i = 0; i < 2; ++i)
#pragma unroll
                    for (int j = 0; j < 2; ++j) acc[i][j] = MFMA32(af[i], bfr[j], acc[i][j]);
            }
#pragma unroll
            for (int i = 0; i < 2; ++i)
#pragma unroll
                for (int j = 0; j < 2; ++j)
#pragma unroll
                    for (int q = 0; q < 16; ++q) kvo[(64 * wave + 32 * i + crow(q, half)) * 128 + 64 * jh + 32 * j + r] = f2bf(acc[i][j][q]);
        }
    }
}

DI void gla_scan(const Params& p, int bid, int nb) {
    u16* kv = (u16*)(p.ws + WS_KV);
    const float* dec = (const float*)(p.ws + WS_DEC);
    for (int g = bid * NTHR + opaque_tid(p); g < 32768; g += nb * NTHR) {
        const int bh = g >> 12, rem = g & 4095;
        const int dch = rem & 15;
        float st[8];
#pragma unroll
        for (int i = 0; i < 8; ++i) st[i] = 0.f;
        const size_t base = (size_t)bh * 256 * 32768 + (size_t)rem * 8;
        const float* dbase = dec + (size_t)bh * 256 * 128 + dch * 8;
        for (int n0 = 0; n0 < 256; n0 += 8) {
            u32x4 kk[8]; f32x4 d0[8], d1[8];
#pragma unroll
            for (int j = 0; j < 8; ++j) {
                kk[j] = *(const u32x4*)(kv + base + (size_t)(n0 + j) * 32768);
                d0[j] = *(const f32x4*)(dbase + (size_t)(n0 + j) * 128);
                d1[j] = *(const f32x4*)(dbase + (size_t)(n0 + j) * 128 + 4);
            }
#pragma unroll
            for (int j = 0; j < 8; ++j) {
                const u32x4 o = u32x4{pk2(st[0], st[1]), pk2(st[2], st[3]), pk2(st[4], st[5]), pk2(st[6], st[7])};
                *(u32x4*)(kv + base + (size_t)(n0 + j) * 32768) = o;
                const float dd[8] = {d0[j].x, d0[j].y, d0[j].z, d0[j].w, d1[j].x, d1[j].y, d1[j].z, d1[j].w};
                const unsigned wv[4] = {kk[j].x, kk[j].y, kk[j].z, kk[j].w};
#pragma unroll
                for (int i = 0; i < 8; ++i) st[i] = dd[i] * st[i] + ((i & 1) ? bfhi(wv[i >> 1]) : bflo(wv[i >> 1]));
            }
        }
    }
}

DI void gla_pass3(const Params& p, char* smem, int bid, int nb) {
    const int tid = opaque_tid(p), wave = tid >> 6, lane = tid & 63, r = lane & 31, half = lane >> 5;
    float* cumL = (float*)smem; char* vT = smem; char* aM = smem + 18432; char* qd = smem + 36864; char* kq = smem + 54272; float* glrL = (float*)(smem + 36864);
    float* oL = (float*)smem;
    const u16* proj = (const u16*)(p.ws + WS_PROJ);
    const float scale = 0.08838834764831845f;
    for (int u = bid; u < 2048; u += nb) {
        const int bh = u >> 8, n = u & 255, b = bh >> 2, h = bh & 3;
        const int tok0 = b * SEQ + n * 64;
        const u16* st = (const u16*)(p.ws + WS_KV) + (size_t)u * 32768;
        __syncthreads();
        u32x4 qreg[4], kreg[4];
#pragma unroll
        for (int it = 0; it < 4; ++it) {
            const int id = tid + 256 * it, c = id >> 4, dch = id & 15;
            qreg[it] = *(const u32x4*)(proj + (size_t)(tok0 + c) * 3072 + h * 128 + dch * 8);
            kreg[it] = *(const u32x4*)(proj + (size_t)(tok0 + c) * 3072 + 512 + h * 128 + dch * 8);
        }
        gla_cum(p, tok0, h, cumL, glrL);
        u32x4 vreg[4], sreg[8];
#pragma unroll
        for (int it = 0; it < 4; ++it) {
            const int q = wave + 4 * it, wq = q >> 2, vv0 = (q & 3) * 8;
            vreg[it] = *(const u32x4*)(proj + (size_t)(tok0 + lane) * 3072 + 1024 + h * 256 + 64 * wq + vv0);
        }
#pragma unroll
        for (int ks = 0; ks < 8; ++ks) sreg[ks] = *(const u32x4*)(st + (size_t)(64 * wave + r) * 128 + ks * 16 + half * 8);
#pragma unroll
        for (int it = 0; it < 4; ++it) {
            const int id = tid + 256 * it, c = id >> 4, dch = id & 15;
            const unsigned qw[4] = {qreg[it].x, qreg[it].y, qreg[it].z, qreg[it].w}, kw[4] = {kreg[it].x, kreg[it].y, kreg[it].z, kreg[it].w};
            unsigned qo[4], ko[4];
#pragma unroll
            for (int i = 0; i < 4; ++i) {
                const int d = dch * 8 + 2 * i;
                const float e0 = cumL[c * CUM_LD + d] - cumL[31 * CUM_LD + d], e1 = cumL[c * CUM_LD + d + 1] - cumL[31 * CUM_LD + d + 1];
                qo[i] = pk2(bflo(qw[i]) * scale * __expf(e0), bfhi(qw[i]) * scale * __expf(e1));
                ko[i] = pk2(bflo(kw[i]) * __expf(-e0), bfhi(kw[i]) * __expf(-e1));
            }
            *(u32x4*)(qd + c * 272 + dch * 16) = u32x4{qo[0], qo[1], qo[2], qo[3]};
            *(u32x4*)(kq + c * 272 + dch * 16) = u32x4{ko[0], ko[1], ko[2], ko[3]};
        }
        __syncthreads();
        const int rb = wave >> 1, cb = wave & 1;
        f32x16 aacc = zero16();
        if (cb <= rb) {
#pragma unroll
            for (int ks = 0; ks < 8; ++ks) {
                const bf16x8 af = lds_frag(qd + (32 * rb + r) * 272 + ks * 32 + half * 16);
                const bf16x8 bf = lds_frag(kq + (32 * cb + r) * 272 + ks * 32 + half * 16);
                aacc = MFMA32(af, bf, aacc);
            }
        }
        __syncthreads();
#pragma unroll
        for (int it = 0; it < 4; ++it) {
            const int id = tid + 256 * it, c = id >> 4, dch = id & 15;
            const unsigned qw[4] = {qreg[it].x, qreg[it].y, qreg[it].z, qreg[it].w};
            unsigned qo[4];
#pragma unroll
            for (int i = 0; i < 4; ++i) {
                const int d = dch * 8 + 2 * i;
                qo[i] = pk2(bflo(qw[i]) * scale * __expf(cumL[c * CUM_LD + d]), bfhi(qw[i]) * scale * __expf(cumL[c * CUM_LD + d + 1]));
            }
            *(u32x4*)(kq + c * 272 + dch * 16) = u32x4{qo[0], qo[1], qo[2], qo[3]};
        }
        __syncthreads();
#pragma unroll
        for (int q = 0; q < 16; ++q) {
            const int c = 32 * rb + crow(q, half), j = 32 * cb + r;
            *(u16*)(aM + (c * 72 + j) * 2) = f2bf((j <= c) ? aacc[q] : 0.f);
        }
        f32x16 o[2][2];
#pragma unroll
        for (int i = 0; i < 2; ++i)
#pragma unroll
            for (int j = 0; j < 2; ++j) o[i][j] = zero16();
        u32x2 rreg[16];
#pragma unroll
        for (int ps = 0; ps < 2; ++ps) {
            if (ps == 1) __syncthreads();
#pragma unroll
            for (int it = 0; it < 4; ++it) {
                const int q = wave + 4 * it, wq = q >> 2, vv0 = (q & 3) * 8;
                const unsigned wv[4] = {vreg[it].x, vreg[it].y, vreg[it].z, vreg[it].w};
                char* dst = vT + ((wq * 32 + vv0) * 72 + lane) * 2;
#pragma unroll
                for (int i = 0; i < 8; ++i) *(u16*)(dst + i * 144) = (u16)((i & 1) ? (wv[i >> 1] >> 16) : (wv[i >> 1] & 0xffffu));
            }
            if (ps == 0) {
#pragma unroll
                for (int it = 0; it < 4; ++it) {
                    const int q = wave + 4 * it, wq = q >> 2, vv0 = (q & 3) * 8;
                    vreg[it] = *(const u32x4*)(proj + (size_t)(tok0 + lane) * 3072 + 1024 + h * 256 + 64 * wq + 32 + vv0);
                }
            } else {
                const u16* rrow = proj + (size_t)(tok0 + (tid >> 2)) * 3072 + 2048 + h * 256 + 4 * (tid & 3);
#pragma unroll
                for (int j = 0; j < 16; ++j) rreg[j] = *(const u32x2*)(rrow + 16 * j);
            }
            __syncthreads();
#pragma unroll
            for (int ks = 0; ks < 4; ++ks) {
                const bf16x8 bf = lds_frag(vT + (wave * 32 + r) * 144 + ks * 32 + half * 16);
#pragma unroll
                for (int i = 0; i < 2; ++i) {
                    const bf16x8 af = lds_frag(aM + (32 * i + r) * 144 + ks * 32 + half * 16);
                    o[ps][i] = MFMA32(af, bf, o[ps][i]);
                }
            }
#pragma unroll
            for (int ks = 0; ks < 8; ++ks) {
                const bf16x8 bf = __builtin_bit_cast(bf16x8, sreg[ks]);
#pragma unroll
                for (int i = 0; i < 2; ++i) {
                    const bf16x8 af = lds_frag(kq + (32 * i + r) * 272 + ks * 32 + half * 16);
                    o[ps][i] = MFMA32(af, bf, o[ps][i]);
                }
            }
            if (ps == 0) {
#pragma unroll
                for (int ks = 0; ks < 8; ++ks) sreg[ks] = *(const u32x4*)(st + (size_t)(64 * wave + 32 + r) * 128 + ks * 16 + half * 8);
            }
        }
        __syncthreads();
#pragma unroll
        for (int ps = 0; ps < 2; ++ps)
#pragma unroll
            for (int i = 0; i < 2; ++i)
#pragma unroll
                for (int q = 0; q < 16; ++q) oL[(32 * i + crow(q, half)) * 260 + 64 * wave + 32 * ps + r] = o[ps][i][q];
        __syncthreads();
        {
            const int c = tid >> 2, qq = tid & 3;
            f32x4 vals[16]; float ss = 0.f;
#pragma unroll
            for (int j = 0; j < 16; ++j) {
                vals[j] = *(const f32x4*)(oL + c * 260 + 16 * j + 4 * qq);
                ss += vals[j].x * vals[j].x + vals[j].y * vals[j].y + vals[j].z * vals[j].z + vals[j].w * vals[j].w;
            }
            ss += sxf<1>(ss, 0); ss += sxf<2>(ss, 0);
            const float rinv = rsqrtf(ss * (1.f / 256.f) + 1e-6f);
            const float* gn = p.gla_norm + h * 256;
            u16* orow = (u16*)(p.ws + WS_HN) + (size_t)(tok0 + c) * 1024 + h * 256;
#pragma unroll
            for (int j = 0; j < 16; ++j) {
                const int v0 = 16 * j + 4 * qq;
                const u32x2 rr = rreg[j];
                const f32x4 g4 = *(const f32x4*)(gn + v0);
                const float r0 = bflo(rr.x), r1 = bfhi(rr.x), r2 = bflo(rr.y), r3 = bfhi(rr.y);
                const float o0 = vals[j].x * rinv * g4.x * (r0 / (1.f + __expf(-r0)));
                const float o1 = vals[j].y * rinv * g4.y * (r1 / (1.f + __expf(-r1)));
                const float o2 = vals[j].z * rinv * g4.z * (r2 / (1.f + __expf(-r2)));
                const float o3 = vals[j].w * rinv * g4.w * (r3 / (1.f + __expf(-r3)));
                *(u32x2*)(orow + v0) = u32x2{pk2(o0, o1), pk2(o2, o3)};
            }
        }
    }
}
DI unsigned sortable(float v) { const unsigned u = __float_as_uint(v); return (u & 0x80000000u) ? ~u : (u | 0x80000000u); }
DI float unsortable(unsigned k) { const unsigned u = (k & 0x80000000u) ? (k & 0x7fffffffu) : ~k; return __uint_as_float(u); }
DI void ins16(unsigned (&L)[16], unsigned x) {
#pragma unroll
    for (int i = 0; i < 16; ++i) { const unsigned hi = max(L[i], x); x = min(L[i], x); L[i] = hi; }
}

DI void ce(unsigned& a, unsigned& b) { const unsigned hi = max(a, b), lo = min(a, b); a = hi; b = lo; }
template <int N> DI void bitonic_sort_desc(unsigned (&v)[N]) {
#pragma unroll
    for (int k = 2; k <= N; k <<= 1)
#pragma unroll
        for (int j = k >> 1; j > 0; j >>= 1)
#pragma unroll
            for (int i = 0; i < N; ++i) {
                const int l = i ^ j;
                if (l > i) { if ((i & k) == 0) ce(v[i], v[l]); else ce(v[l], v[i]); }
            }
}
DI void top16_merge(unsigned (&a)[16], const unsigned (&b)[16]) {
#pragma unroll
    for (int i = 0; i < 16; ++i) a[i] = max(a[i], b[15 - i]);
#pragma unroll
    for (int j = 8; j > 0; j >>= 1)
#pragma unroll
        for (int i = 0; i < 16; ++i) { const int l = i ^ j; if (l > i) ce(a[i], a[l]); }
}
constexpr int PQ_LDS_BYTES = G_LDS_BYTES;
DI void peer_query_phase(const Params& p, int layer, char* smem, int bid, int nb) {
    const int tid = opaque_tid(p), wave = tid >> 6, lane = tid & 63, r = lane & 31, half = lane >> 5;
    const u16* hn = (const u16*)(p.ws + WS_HN);
    const u16* wq = (const u16*)(p.ws + WS_WPQ) + (size_t)layer * 2048 * 1024;
    const u16* sk = (const u16*)(p.ws + WS_SK) + (size_t)layer * 8 * 2 * 128 * 128;
    char* Bk = smem;
    for (int j = 0; j * nb < 2048; ++j) {
        const int u = xcd_unit(j, bid, nb);
        if (u >= 2048) continue;
        const int tb = u >> 3, h = u & 7;
        unsigned Lp[2][16];
        __syncthreads();
        f32x16 acc[8][1];
#pragma unroll
        for (int i = 0; i < 8; ++i) acc[i][0] = zero16();
        gemm_mainloop<8, 1, 128, 256>(p, wq + (size_t)(h * 256) * 1024, 1024, hn + (size_t)(tb * 128) * 1024, 1024, 1024, smem, 0, 32 * wave, acc);
        bf16x8 bqa[2][8];
#pragma unroll
        for (int pp = 0; pp < 2; ++pp)
#pragma unroll
            for (int di = 0; di < 4; ++di) { bqa[pp][2 * di] = pack8(acc[4 * pp + di][0], 0); bqa[pp][2 * di + 1] = pack8(acc[4 * pp + di][0], 1); }
#pragma unroll
        for (int pp = 0; pp < 2; ++pp) {
            __syncthreads();
            const u16* skt = sk + (size_t)(h * 2 + pp) * 128 * 128;
            int tidl = tid; asm volatile("" : "+v"(tidl));
            {
                const int n0 = tidl >> 4, ch = tidl & 15;
                u32x4 tmp[8];
#pragma unroll
                for (int it = 0; it < 8; ++it) tmp[it] = *(const u32x4*)(skt + (n0 + 16 * it) * 128 + ch * 8);
#pragma unroll
                for (int it = 0; it < 8; ++it) *(u32x4*)(Bk + (n0 + 16 * it) * 272 + ch * 16) = tmp[it];
            }
            __syncthreads();
            f32x16 sc[4];
#pragma unroll
            for (int i = 0; i < 4; ++i) sc[i] = zero16();
#pragma unroll
            for (int di = 0; di < 4; ++di)
#pragma unroll
                for (int s = 0; s < 2; ++s) {
                    const bf16x8 bq = bqa[pp][2 * di + s];
#pragma unroll
                    for (int kb = 0; kb < 4; ++kb) {
                        const char* rowp = Bk + (32 * kb + r) * 272 + (32 * di + 16 * s + 4 * half) * 2;
                        const bf16x8 ak = lds_frag2(rowp, rowp + 16);
                        sc[kb] = MFMA32(ak, bq, sc[kb]);
                    }
                }
            unsigned L[16];
            {
                unsigned G[4][16];
                int hq4 = 4 * half; asm volatile("" : "+v"(hq4));
#pragma unroll
                for (int kb = 0; kb < 4; ++kb) {
#pragma unroll
                    for (int q = 0; q < 16; ++q) G[kb][q] = (sortable(sc[kb][q]) & 0xffffff80u) | (unsigned)(127 - 32 * kb - crow(q, 0) - hq4);
                    bitonic_sort_desc<16>(G[kb]);
                }
                top16_merge(G[0], G[1]); top16_merge(G[2], G[3]); top16_merge(G[0], G[2]);
#pragma unroll
                for (int i = 0; i < 16; ++i) L[i] = G[0][i];
            }
            {
                unsigned O[16];
#pragma unroll
                for (int i = 0; i < 16; ++i) O[i] = sxu<32>(L[i], half);
                top16_merge(L, O);
            }
#pragma unroll
            for (int i = 0; i < 16; ++i) Lp[pp][i] = L[i];
        }
        float s1[16], s2[16]; int i1[16], i2[16];
#pragma unroll
        for (int i = 0; i < 16; ++i) {
            s1[i] = unsortable(Lp[0][i] & 0xffffff80u); i1[i] = 127 - (int)(Lp[0][i] & 127u);
            s2[i] = unsortable(Lp[1][i] & 0xffffff80u); i2[i] = 127 - (int)(Lp[1][i] & 127u);
        }
        __syncthreads();
        int* tabL = (int*)(smem + wave * 8192);
        if (half == 0) {
#pragma unroll
            for (int i = 0; i < 16; ++i) { tabL[i * 32 + r] = i1[i]; tabL[(16 + i) * 32 + r] = i2[i]; tabL[(32 + i) * 32 + r] = __float_as_int(s1[i]); tabL[(48 + i) * 32 + r] = __float_as_int(s2[i]); }
        }
        unsigned C[16], D[16];
#pragma unroll
        for (int i = 0; i < 16; ++i) { C[i] = 0u; D[i] = 0u; }
#define CANDK(a0, b0, a1, b1) ((sortable(half ? (s1[a1] + s2[b1]) : (s1[a0] + s2[b0])) & 0xffffff00u) | (unsigned)(255 - (half ? (16 * a1 + b1) : (16 * a0 + b0))))
        C[0] = CANDK(0, 0, 0, 1);
        C[1] = CANDK(0, 2, 0, 3);
        C[2] = CANDK(0, 4, 0, 5);
        C[3] = CANDK(0, 6, 0, 7);
        C[4] = CANDK(0, 8, 0, 9);
        C[5] = CANDK(0, 10, 0, 11);
        C[6] = CANDK(0, 12, 0, 13);
        C[7] = CANDK(0, 14, 0, 15);
        C[8] = CANDK(1, 0, 1, 1);
        C[9] = CANDK(1, 2, 1, 3);
        C[10] = CANDK(1, 4, 1, 5);
        C[11] = CANDK(1, 6, 1, 7);
        C[12] = CANDK(2, 0, 2, 1);
        C[13] = CANDK(2, 2, 2, 3);
        C[14] = CANDK(2, 4, 3, 0);
        C[15] = CANDK(3, 1, 3, 2);
        D[0] = CANDK(3, 3, 4, 0);
        D[1] = CANDK(4, 1, 4, 2);
        D[2] = CANDK(5, 0, 5, 1);
        D[3] = CANDK(6, 0, 6, 1);
        D[4] = CANDK(7, 0, 7, 1);
        D[5] = CANDK(8, 0, 9, 0);
        D[6] = CANDK(10, 0, 11, 0);
        D[7] = CANDK(12, 0, 13, 0);
        D[8] = CANDK(14, 0, 15, 0);
#undef CANDK
        bitonic_sort_desc<16>(C); bitonic_sort_desc<16>(D);
        top16_merge(C, D);
        {
            unsigned O[16];
#pragma unroll
            for (int i = 0; i < 16; ++i) O[i] = sxu<32>(C[i], half);
            top16_merge(C, O);
        }
        float bs[16]; int bi[16];
#pragma unroll
        for (int i = 0; i < 16; ++i) {
            const int id = 255 - (int)(C[i] & 255u), a = id >> 4, b = id & 15;
            bi[i] = tabL[a * 32 + r] * 128 + tabL[(16 + b) * 32 + r];
            bs[i] = __int_as_float(tabL[(32 + a) * 32 + r]) + __int_as_float(tabL[(48 + b) * 32 + r]);
        }
        float den = 0.f, ex[16];
#pragma unroll
        for (int i = 0; i < 16; ++i) { ex[i] = __expf(bs[i] - bs[0]); den += ex[i]; }
        const float rden = 1.f / den;
        int rl = r; asm volatile("" : "+v"(rl));
        const int tok = tb * 128 + 32 * wave + rl;
        int* io = (int*)(p.ws + WS_IDX) + (size_t)tok * 128 + h * 16 + 8 * half;
        float* go = (float*)(p.ws + WS_GATE) + (size_t)tok * 128 + h * 16 + 8 * half;
        if (half == 0) {
            *(u32x4*)(io) = u32x4{(unsigned)bi[0], (unsigned)bi[1], (unsigned)bi[2], (unsigned)bi[3]};
            *(u32x4*)(io + 4) = u32x4{(unsigned)bi[4], (unsigned)bi[5], (unsigned)bi[6], (unsigned)bi[7]};
            *(f32x4*)(go) = f32x4{ex[0] * rden, ex[1] * rden, ex[2] * rden, ex[3] * rden};
            *(f32x4*)(go + 4) = f32x4{ex[4] * rden, ex[5] * rden, ex[6] * rden, ex[7] * rden};
        } else {
            *(u32x4*)(io) = u32x4{(unsigned)bi[8], (unsigned)bi[9], (unsigned)bi[10], (unsigned)bi[11]};
            *(u32x4*)(io + 4) = u32x4{(unsigned)bi[12], (unsigned)bi[13], (unsigned)bi[14], (unsigned)bi[15]};
            *(f32x4*)(go) = f32x4{ex[8] * rden, ex[9] * rden, ex[10] * rden, ex[11] * rden};
            *(f32x4*)(go + 4) = f32x4{ex[12] * rden, ex[13] * rden, ex[14] * rden, ex[15] * rden};
        }
    }
}

DI void peer_query_phase8(const Params& p, int layer, char* smem, int bid, int nb) {
    const int tid = opaque_tid8(p), wave = tid >> 6, lane = tid & 63, r = lane & 31, half = lane >> 5;
    const u16* hn = (const u16*)(p.ws + WS_HN);
    const u16* wq = (const u16*)(p.ws + WS_WPQ) + (size_t)layer * 2048 * 1024;
    const u16* sk = (const u16*)(p.ws + WS_SK) + (size_t)layer * 8 * 2 * 128 * 128;
    char* Bk = smem;
    for (int j = 0; j * nb < 1024; ++j) {
        const int u = xcd_unit(j, bid, nb);
        if (u >= 1024) continue;
        const int tb = u >> 3, h = u & 7;
        unsigned Lp[2][16];
        __syncthreads();
        f32x16 acc[8][1];
#pragma unroll
        for (int i = 0; i < 8; ++i) acc[i][0] = zero16();
        gemm_mainloop<8, 1, 256, 256, 8>(p, wq + (size_t)(h * 256) * 1024, 1024, hn + (size_t)(tb * 256) * 1024, 1024, 1024, smem, 0, 32 * wave, acc, p.pad_);
        bf16x8 bqa[2][8];
#pragma unroll
        for (int pp = 0; pp < 2; ++pp)
#pragma unroll
            for (int di = 0; di < 4; ++di) { bqa[pp][2 * di] = pack8(acc[4 * pp + di][0], 0); bqa[pp][2 * di + 1] = pack8(acc[4 * pp + di][0], 1); }
#pragma unroll
        for (int pp = 0; pp < 2; ++pp) {
            __syncthreads();
            const u16* skt = sk + (size_t)(h * 2 + pp) * 128 * 128;
            int tidl = tid; asm volatile("" : "+v"(tidl));
            {
                const int n0 = tidl >> 4, ch = tidl & 15;
                u32x4 tmp[4];
#pragma unroll
                for (int it = 0; it < 4; ++it) tmp[it] = *(const u32x4*)(skt + (n0 + 32 * it) * 128 + ch * 8);
#pragma unroll
                for (int it = 0; it < 4; ++it) *(u32x4*)(Bk + (n0 + 32 * it) * 272 + ch * 16) = tmp[it];
            }
            __syncthreads();
            f32x16 sc[4];
#pragma unroll
            for (int i = 0; i < 4; ++i) sc[i] = zero16();
#pragma unroll
            for (int di = 0; di < 4; ++di)
#pragma unroll
                for (int s = 0; s < 2; ++s) {
                    const bf16x8 bq = bqa[pp][2 * di + s];
#pragma unroll
                    for (int kb = 0; kb < 4; ++kb) {
                        const char* rowp = Bk + (32 * kb + r) * 272 + (32 * di + 16 * s + 4 * half) * 2;
                        const bf16x8 ak = lds_frag2(rowp, rowp + 16);
                        sc[kb] = MFMA32(ak, bq, sc[kb]);
                    }
                }
            unsigned L[16];
            {
                unsigned G[4][16];
                int hq4 = 4 * half; asm volatile("" : "+v"(hq4));
#pragma unroll
                for (int kb = 0; kb < 4; ++kb) {
#pragma unroll
                    for (int q = 0; q < 16; ++q) G[kb][q] = (sortable(sc[kb][q]) & 0xffffff80u) | (unsigned)(127 - 32 * kb - crow(q, 0) - hq4);
                    bitonic_sort_desc<16>(G[kb]);
                }
                top16_merge(G[0], G[1]); top16_merge(G[2], G[3]); top16_merge(G[0], G[2]);
#pragma unroll
                for (int i = 0; i < 16; ++i) L[i] = G[0][i];
            }
            {
                unsigned O[16];
#pragma unroll
                for (int i = 0; i < 16; ++i) O[i] = sxu<32>(L[i], half);
                top16_merge(L, O);
            }
#pragma unroll
            for (int i = 0; i < 16; ++i) Lp[pp][i] = L[i];
        }
        float s1[16], s2[16]; int i1[16], i2[16];
#pragma unroll
        for (int i = 0; i < 16; ++i) {
            s1[i] = unsortable(Lp[0][i] & 0xffffff80u); i1[i] = 127 - (int)(Lp[0][i] & 127u);
            s2[i] = unsortable(Lp[1][i] & 0xffffff80u); i2[i] = 127 - (int)(Lp[1][i] & 127u);
        }
        __syncthreads();
        int* tabL = (int*)(smem + wave * 8192);
        if (half == 0) {
#pragma unroll
            for (int i = 0; i < 16; ++i) { tabL[i * 32 + r] = i1[i]; tabL[(16 + i) * 32 + r] = i2[i]; tabL[(32 + i) * 32 + r] = __float_as_int(s1[i]); tabL[(48 + i) * 32 + r] = __float_as_int(s2[i]); }
        }
        unsigned C[16], D[16];
#pragma unroll
        for (int i = 0; i < 16; ++i) { C[i] = 0u; D[i] = 0u; }
#define CANDK(a0, b0, a1, b1) ((sortable(half ? (s1[a1] + s2[b1]) : (s1[a0] + s2[b0])) & 0xffffff00u) | (unsigned)(255 - (half ? (16 * a1 + b1) : (16 * a0 + b0))))
        C[0] = CANDK(0, 0, 0, 1);
        C[1] = CANDK(0, 2, 0, 3);
        C[2] = CANDK(0, 4, 0, 5);
        C[3] = CANDK(0, 6, 0, 7);
        C[4] = CANDK(0, 8, 0, 9);
        C[5] = CANDK(0, 10, 0, 11);
        C[6] = CANDK(0, 12, 0, 13);
        C[7] = CANDK(0, 14, 0, 15);
        C[8] = CANDK(1, 0, 1, 1);
        C[9] = CANDK(1, 2, 1, 3);
        C[10] = CANDK(1, 4, 1, 5);
        C[11] = CANDK(1, 6, 1, 7);
        C[12] = CANDK(2, 0, 2, 1);
        C[13] = CANDK(2, 2, 2, 3);
        C[14] = CANDK(2, 4, 3, 0);
        C[15] = CANDK(3, 1, 3, 2);
        D[0] = CANDK(3, 3, 4, 0);
        D[1] = CANDK(4, 1, 4, 2);
        D[2] = CANDK(5, 0, 5, 1);
        D[3] = CANDK(6, 0, 6, 1);
        D[4] = CANDK(7, 0, 7, 1);
        D[5] = CANDK(8, 0, 9, 0);
        D[6] = CANDK(10, 0, 11, 0);
        D[7] = CANDK(12, 0, 13, 0);
        D[8] = CANDK(14, 0, 15, 0);
#undef CANDK
        bitonic_sort_desc<16>(C); bitonic_sort_desc<16>(D);
        top16_merge(C, D);
        {
            unsigned O[16];
#pragma unroll
            for (int i = 0; i < 16; ++i) O[i] = sxu<32>(C[i], half);
            top16_merge(C, O);
        }
        float bs[16]; int bi[16];
#pragma unroll
        for (int i = 0; i < 16; ++i) {
            const int id = 255 - (int)(C[i] & 255u), a = id >> 4, b = id & 15;
            bi[i] = tabL[a * 32 + r] * 128 + tabL[(16 + b) * 32 + r];
            bs[i] = __int_as_float(tabL[(32 + a) * 32 + r]) + __int_as_float(tabL[(48 + b) * 32 + r]);
        }
        float den = 0.f, ex[16];
#pragma unroll
        for (int i = 0; i < 16; ++i) { ex[i] = __expf(bs[i] - bs[0]); den += ex[i]; }
        const float rden = 1.f / den;
        int rl = r; asm volatile("" : "+v"(rl));
        const int tok = tb * 256 + 32 * wave + rl;
        int* io = (int*)(p.ws + WS_IDX) + (size_t)tok * 128 + h * 16 + 8 * half;
        float* go = (float*)(p.ws + WS_GATE) + (size_t)tok * 128 + h * 16 + 8 * half;
        if (half == 0) {
            *(u32x4*)(io) = u32x4{(unsigned)bi[0], (unsigned)bi[1], (unsigned)bi[2], (unsigned)bi[3]};
            *(u32x4*)(io + 4) = u32x4{(unsigned)bi[4], (unsigned)bi[5], (unsigned)bi[6], (unsigned)bi[7]};
            *(f32x4*)(go) = f32x4{ex[0] * rden, ex[1] * rden, ex[2] * rden, ex[3] * rden};
            *(f32x4*)(go + 4) = f32x4{ex[4] * rden, ex[5] * rden, ex[6] * rden, ex[7] * rden};
        } else {
            *(u32x4*)(io) = u32x4{(unsigned)bi[8], (unsigned)bi[9], (unsigned)bi[10], (unsigned)bi[11]};
            *(u32x4*)(io + 4) = u32x4{(unsigned)bi[12], (unsigned)bi[13], (unsigned)bi[14], (unsigned)bi[15]};
            *(f32x4*)(go) = f32x4{ex[8] * rden, ex[9] * rden, ex[10] * rden, ex[11] * rden};
            *(f32x4*)(go + 4) = f32x4{ex[12] * rden, ex[13] * rden, ex[14] * rden, ex[15] * rden};
        }
    }
}

typedef __attribute__((ext_vector_type(2))) float f32x2;
DI float gelu_exact(float a) { return 0.5f * a * (1.f + erff(a * 0.7071067811865476f)); }
DI void unpack8_fp4(unsigned w, float (&f)[8]) {
    const f32x2 a = __builtin_amdgcn_cvt_scalef32_pk_f32_fp4(w, 1.0f, 0), b = __builtin_amdgcn_cvt_scalef32_pk_f32_fp4(w, 1.0f, 1);
    const f32x2 c = __builtin_amdgcn_cvt_scalef32_pk_f32_fp4(w, 1.0f, 2), d = __builtin_amdgcn_cvt_scalef32_pk_f32_fp4(w, 1.0f, 3);
    f[0] = a.x; f[1] = a.y; f[2] = b.x; f[3] = b.y; f[4] = c.x; f[5] = c.y; f[6] = d.x; f[7] = d.y;
}
constexpr float PG_SX = 21.6f;
constexpr int PG_RING_SLOTS = 16, PG_DEPTH = 14;
constexpr int PG_LDS_BYTES = 4 * PG_RING_SLOTS * 1024 + 4096;
DI void pg_dma(const unsigned char* tab, unsigned e, unsigned lane_off, char* slot) {
    __builtin_amdgcn_global_load_lds((const unsigned*)(tab + (e * 512u + lane_off)), (unsigned*)slot, 16, 0, 0);
}
DI void pg_dma4(const unsigned char* tab, const u32x4 e4, unsigned lane_off, char* ring, int g) {
    pg_dma(tab, e4.x, lane_off, ring + ((4 * g + 0) & 15) * 1024); pg_dma(tab, e4.y, lane_off, ring + ((4 * g + 1) & 15) * 1024);
    pg_dma(tab, e4.z, lane_off, ring + ((4 * g + 2) & 15) * 1024); pg_dma(tab, e4.w, lane_off, ring + ((4 * g + 3) & 15) * 1024);
}
#define PG_WAIT_GROUP(g) do { if ((g) + 3 < 16) asm volatile("s_waitcnt vmcnt(12)" ::: "memory"); else if ((g) == 13) asm volatile("s_waitcnt vmcnt(8)" ::: "memory"); \
                              else if ((g) == 14) asm volatile("s_waitcnt vmcnt(4)" ::: "memory"); else asm volatile("s_waitcnt vmcnt(0)" ::: "memory"); } while (0)
DI void peer_u_phase(const Params& p, int layer, char* smem, int bid, int nb) {
    const int tid = opaque_tid(p), wave = __builtin_amdgcn_readfirstlane(tid >> 6), lane = tid & 63, hh = lane >> 5, li = lane & 31;
    char* ring = smem + wave * (PG_RING_SLOTS * 1024);
    int* idxL = (int*)(smem + 4 * PG_RING_SLOTS * 1024 + wave * 1024); float* cL = (float*)(idxL + 128);
    const unsigned char* tu = (const unsigned char*)(p.ws + WS_TAB) + (size_t)layer * 16 * MB;
    const u16* hn = (const u16*)(p.ws + WS_HN);
    const char* myslot = ring + lane * 16;
    const unsigned lane_off = (unsigned)li * 16u;
    const int* idxH = idxL + hh * 64;
    for (int t = bid * 4 + wave; t < T_TOK; t += nb * 4) {
        const int* ig = (const int*)(p.ws + WS_IDX) + (size_t)t * 128;
        idxL[(lane & 1) * 64 + (lane >> 1)] = ig[lane]; idxL[(lane & 1) * 64 + 32 + (lane >> 1)] = ig[lane + 64];
        unsigned xh[4], xl[4];
        {
            const u16* xr = hn + (size_t)t * 1024 + 32 * li;
            const u32x4 xa = *(const u32x4*)(xr), xb = *(const u32x4*)(xr + 8), xc = *(const u32x4*)(xr + 16), xd = *(const u32x4*)(xr + 24);
            const unsigned xw[16] = {xa.x, xa.y, xa.z, xa.w, xb.x, xb.y, xb.z, xb.w, xc.x, xc.y, xc.z, xc.w, xd.x, xd.y, xd.z, xd.w};
#pragma unroll
            for (int d = 0; d < 4; ++d) {
                unsigned hw = 0, lw = 0;
#pragma unroll
                for (int j = 0; j < 8; ++j) {
                    const unsigned w = xw[4 * d + (j >> 1)];
                    const float xv = (j & 1) ? bfhi(w) : bflo(w);
                    const int q = (int)rintf(fminf(fmaxf(xv * PG_SX, -119.f), 119.f));
                    const int lo = ((q + 8) & 15) - 8, hi = (q - lo) >> 4;
                    hw |= ((unsigned)hi & 15u) << (4 * j); lw |= ((unsigned)lo & 15u) << (4 * j);
                }
                xh[d] = hw; xl[d] = lw;
            }
        }
        asm volatile("s_waitcnt vmcnt(0) lgkmcnt(0)" ::: "memory");
#pragma unroll
        for (int g = 0; g < 3; ++g) pg_dma4(tu, *(const u32x4*)(idxH + 4 * g), lane_off, ring, g);
#pragma unroll 1
        for (int bt = 0; bt < 4; ++bt) {
            float pr[16];
#pragma unroll
            for (int gg = 0; gg < 4; ++gg) {
                const int g = bt * 4 + gg;
                if (g + 3 < 16) pg_dma4(tu, *(const u32x4*)(idxH + 4 * (g + 3)), lane_off, ring, g + 3);
                PG_WAIT_GROUP(g);
                u32x4 w[4];
#pragma unroll
                for (int i = 0; i < 4; ++i) w[i] = *(const u32x4*)(myslot + ((4 * gg + i) & 15) * 1024);
#pragma unroll
                for (int i = 0; i < 4; ++i) {
                    const unsigned ww[4] = {w[i].x, w[i].y, w[i].z, w[i].w};
                    int ah = 0, al = 0;
#pragma unroll
                    for (int c = 0; c < 4; ++c) { ah = __builtin_amdgcn_sdot8((int)ww[c], (int)xh[c], ah, false); al = __builtin_amdgcn_sdot8((int)ww[c], (int)xl[c], al, false); }
                    pr[4 * gg + i] = (float)(16 * ah + al);
                }
            }
            float q8[8], q4[4], q2[2], q1;
            { const bool up = (lane & 1) != 0;
#pragma unroll
              for (int i = 0; i < 8; ++i) { const float send = up ? pr[i] : pr[i + 8]; const float keep = up ? pr[i + 8] : pr[i]; q8[i] = keep + sxf<1>(send, hh); } }
            { const bool up = (lane & 2) != 0;
#pragma unroll
              for (int i = 0; i < 4; ++i) { const float send = up ? q8[i] : q8[i + 4]; const float keep = up ? q8[i + 4] : q8[i]; q4[i] = keep + sxf<2>(send, hh); } }
            { const bool up = (lane & 4) != 0;
#pragma unroll
              for (int i = 0; i < 2; ++i) { const float send = up ? q4[i] : q4[i + 2]; const float keep = up ? q4[i + 2] : q4[i]; q2[i] = keep + sxf<4>(send, hh); } }
            { const bool up = (lane & 8) != 0; const float send = up ? q2[0] : q2[1]; const float keep = up ? q2[1] : q2[0]; q1 = keep + sxf<8>(send, hh); }
            q1 += sxf<16>(q1, hh);
            const int jj = 8 * (lane & 1) + 4 * ((lane >> 1) & 1) + 2 * ((lane >> 2) & 1) + ((lane >> 3) & 1);
            if ((lane & 16) == 0) cL[2 * (bt * 16 + jj) + hh] = q1;
        }
        float* dg = (float*)(p.ws + WS_DOT) + (size_t)t * 128;
        dg[lane] = cL[lane]; dg[lane + 64] = cL[lane + 64];
    }
}
typedef __attribute__((ext_vector_type(2))) _Float16 h2_t;
DI void pg_axpy(h2_t (&o2)[16], const u32x4 w, float cfs) {
    const _Float16 ch = (_Float16)cfs; const h2_t cf2 = {ch, ch};
    const unsigned ww[4] = {w.x, w.y, w.z, w.w};
#pragma unroll
    for (int c = 0; c < 4; ++c) {
        o2[4 * c + 0] = __builtin_amdgcn_cvt_scalef32_pk_f16_fp4(ww[c], 1.0f, 0) * cf2 + o2[4 * c + 0];
        o2[4 * c + 1] = __builtin_amdgcn_cvt_scalef32_pk_f16_fp4(ww[c], 1.0f, 1) * cf2 + o2[4 * c + 1];
        o2[4 * c + 2] = __builtin_amdgcn_cvt_scalef32_pk_f16_fp4(ww[c], 1.0f, 2) * cf2 + o2[4 * c + 2];
        o2[4 * c + 3] = __builtin_amdgcn_cvt_scalef32_pk_f16_fp4(ww[c], 1.0f, 3) * cf2 + o2[4 * c + 3];
    }
}
template <bool FINAL>
DI void peer_v_phase(const Params& p, int layer, const float* gnext, char* smem, int bid, int nb) {
    const int tid = opaque_tid(p), wave = __builtin_amdgcn_readfirstlane(tid >> 6), lane = tid & 63, hh = lane >> 5, li = lane & 31;
    char* ring = smem + wave * (PG_RING_SLOTS * 1024);
    int* idxL = (int*)(smem + 4 * PG_RING_SLOTS * 1024 + wave * 1024); float* cL = (float*)(idxL + 128);
    const unsigned char* tv = (const unsigned char*)(p.ws + WS_TAB) + (size_t)layer * 16 * MB + (size_t)16384 * 512;
    const char* myslot = ring + lane * 16;
    const unsigned lane_off = (unsigned)li * 16u;
    const int* idxH = idxL + hh * 64; const float* cH = cL + hh * 64;
    for (int t = bid * 4 + wave; t < T_TOK; t += nb * 4) {
        const int* ig = (const int*)(p.ws + WS_IDX) + (size_t)t * 128;
        const float* gg = (const float*)(p.ws + WS_GATE) + (size_t)t * 128;
        const float* dg = (const float*)(p.ws + WS_DOT) + (size_t)t * 128;
        const int s0 = (lane & 1) * 64 + (lane >> 1), s1 = s0 + 32;
        idxL[s0] = ig[lane]; idxL[s1] = ig[lane + 64];
        {
            const float d0 = dg[lane] * (1.f / (TAB_SCALE_UI * PG_SX)), d1 = dg[lane + 64] * (1.f / (TAB_SCALE_UI * PG_SX));
            cL[s0] = gg[lane] * gelu_exact(d0) * (1.f / TAB_SCALE_V); cL[s1] = gg[lane + 64] * gelu_exact(d1) * (1.f / TAB_SCALE_V);
        }
        asm volatile("s_waitcnt vmcnt(0) lgkmcnt(0)" ::: "memory");
#pragma unroll
        for (int g = 0; g < 3; ++g) pg_dma4(tv, *(const u32x4*)(idxH + 4 * g), lane_off, ring, g);
        h2_t o2[16];
#pragma unroll
        for (int i = 0; i < 16; ++i) o2[i] = h2_t{(_Float16)0.f, (_Float16)0.f};
#pragma unroll 1
        for (int bt = 0; bt < 4; ++bt) {
#pragma unroll
            for (int gg = 0; gg < 4; ++gg) {
                const int g = bt * 4 + gg;
                if (g + 3 < 16) pg_dma4(tv, *(const u32x4*)(idxH + 4 * (g + 3)), lane_off, ring, g + 3);
                const f32x4 c4 = *(const f32x4*)(cH + 4 * g);
                PG_WAIT_GROUP(g);
                u32x4 w[4];
#pragma unroll
                for (int i = 0; i < 4; ++i) w[i] = *(const u32x4*)(myslot + ((4 * gg + i) & 15) * 1024);
                pg_axpy(o2, w[0], c4.x); pg_axpy(o2, w[1], c4.y); pg_axpy(o2, w[2], c4.z); pg_axpy(o2, w[3], c4.w);
            }
        }
        float r[16];
#pragma unroll
        for (int i = 0; i < 8; ++i) {
            const h2_t send = hh ? o2[i] : o2[i + 8]; const h2_t keep = hh ? o2[i + 8] : o2[i];
            const h2_t got = __builtin_bit_cast(h2_t, sxu<32>(__builtin_bit_cast(unsigned, send), hh));
            r[2 * i] = (float)keep.x + (float)got.x; r[2 * i + 1] = (float)keep.y + (float)got.y;
        }
        float* hr = p.out + (size_t)t * 1024 + 32 * li + 16 * hh;
        f32x4 h0 = *(f32x4*)(hr), h1 = *(f32x4*)(hr + 4), h2 = *(f32x4*)(hr + 8), h3 = *(f32x4*)(hr + 12);
        h0 += f32x4{r[0], r[1], r[2], r[3]}; h1 += f32x4{r[4], r[5], r[6], r[7]};
        h2 += f32x4{r[8], r[9], r[10], r[11]}; h3 += f32x4{r[12], r[13], r[14], r[15]};
        float ss = h0.x * h0.x + h0.y * h0.y + h0.z * h0.z + h0.w * h0.w + h1.x * h1.x + h1.y * h1.y + h1.z * h1.z + h1.w * h1.w
                 + h2.x * h2.x + h2.y * h2.y + h2.z * h2.z + h2.w * h2.w + h3.x * h3.x + h3.y * h3.y + h3.z * h3.z + h3.w * h3.w;
        ss = wave_sum(ss, hh);
        const float rn = rsqrtf(ss * (1.f / 1024.f) + 1e-6f);
        const float* gp = gnext + 32 * li + 16 * hh;
        const f32x4 g0v = *(const f32x4*)(gp), g1v = *(const f32x4*)(gp + 4), g2v = *(const f32x4*)(gp + 8), g3v = *(const f32x4*)(gp + 12);
        if constexpr (FINAL) {
            *(f32x4*)(hr) = h0 * rn * g0v; *(f32x4*)(hr + 4) = h1 * rn * g1v; *(f32x4*)(hr + 8) = h2 * rn * g2v; *(f32x4*)(hr + 12) = h3 * rn * g3v;
        } else {
            *(f32x4*)(hr) = h0; *(f32x4*)(hr + 4) = h1; *(f32x4*)(hr + 8) = h2; *(f32x4*)(hr + 12) = h3;
            const f32x4 n0 = h0 * rn * g0v, n1 = h1 * rn * g1v, n2 = h2 * rn * g2v, n3 = h3 * rn * g3v;
            u16* hno = (u16*)(p.ws + WS_HN) + (size_t)t * 1024 + 32 * li + 16 * hh;
            *(u32x4*)(hno) = u32x4{pk2(n0.x, n0.y), pk2(n0.z, n0.w), pk2(n1.x, n1.y), pk2(n1.z, n1.w)};
            *(u32x4*)(hno + 8) = u32x4{pk2(n2.x, n2.y), pk2(n2.z, n2.w), pk2(n3.x, n3.y), pk2(n3.z, n3.w)};
        }
    }
}
constexpr int AT_LDS_BYTES = 65536;
constexpr float LAMBDA_INIT = 0.35550906759096927f;
constexpr float AT_THR = 8.f;


DI float max16(const f32x16& S) {
    float t0, t1, t2, t3, t4;
    asm volatile("s_nop 15\n\tv_max3_f32 %0, %5, %6, %7\n\tv_max3_f32 %1, %8, %9, %10\n\tv_max3_f32 %2, %11, %12, %13\n\tv_max3_f32 %3, %14, %15, %16\n\t"
                 "v_max3_f32 %4, %17, %18, %19\n\tv_max3_f32 %0, %0, %1, %20\n\tv_max3_f32 %2, %2, %3, %4\n\tv_max_f32 %0, %0, %2"
                 : "=&v"(t0), "=&v"(t1), "=&v"(t2), "=&v"(t3), "=&v"(t4)
                 : "v"(S[0]), "v"(S[1]), "v"(S[2]), "v"(S[3]), "v"(S[4]), "v"(S[5]), "v"(S[6]), "v"(S[7]), "v"(S[8]), "v"(S[9]), "v"(S[10]), "v"(S[11]),
                   "v"(S[12]), "v"(S[13]), "v"(S[14]), "v"(S[15]));
    return t0;
}
DI void attn_tile(const char* Kb, const char* Vb, const char* Qw, f32x16 (&O1)[4], f32x16 (&O2)[4], float& m1, float& l1, float& m2, float& l2,
                  bool diag, bool first, int k0, int qidx, int r, int half) {
    const int ksw = (r >> 1) & 7;
    const char* krow = Kb + r * 128;
    f32x16 S0, S1;
#pragma unroll
    for (int i = 0; i < 16; ++i) { S0[i] = -m1; S1[i] = -m2; }
    {
        bf16x8 kf[4], qf[4];
#pragma unroll
        for (int ks = 0; ks < 4; ++ks) { kf[ks] = lds_frag(krow + (((2 * ks + half) ^ ksw) << 4)); qf[ks] = lds_frag(Qw + ks * 1024); }
#pragma unroll
        for (int ks = 0; ks < 4; ++ks) S0 = MFMA32(kf[ks], qf[ks], S0);
    }
    {
        bf16x8 kf[4], qf[4];
#pragma unroll
        for (int ks = 0; ks < 4; ++ks) { kf[ks] = lds_frag(krow + 4096 + (((2 * ks + half) ^ ksw) << 4)); qf[ks] = lds_frag(Qw + (4 + ks) * 1024); }
#pragma unroll
        for (int ks = 0; ks < 4; ++ks) S1 = MFMA32(kf[ks], qf[ks], S1);
    }
    const int vsw = (r >> 2) & 3;
    const char* vrow = Vb + r * 64;
    const int vo0 = ((0 + half) ^ vsw) << 4, vo1 = ((2 + half) ^ vsw) << 4;
    __builtin_amdgcn_sched_barrier(0);
    if (diag) {
#pragma unroll
        for (int i = 0; i < 16; ++i) if (k0 + crow(i, half) > qidx) { S0[i] = -INFINITY; S1[i] = -INFINITY; }
    }
    float mx0 = max16(S0), mx1 = max16(S1);
    mx0 = fmaxf(mx0, sxf<32>(mx0, half)); mx1 = fmaxf(mx1, sxf<32>(mx1, half));
    if (first || !__all((mx0 <= AT_THR) && (mx1 <= AT_THR))) {
        const float d1 = fmaxf(mx0, 0.f), d2 = fmaxf(mx1, 0.f);
        const float e1 = first ? mx0 : d1, e2 = first ? mx1 : d2;
#pragma unroll
        for (int i = 0; i < 16; ++i) { S0[i] -= e1; S1[i] -= e2; }
        if (!first) {
            const float a1 = __builtin_amdgcn_exp2f(-d1), a2 = __builtin_amdgcn_exp2f(-d2);
#pragma unroll
            for (int d = 0; d < 4; ++d) { O1[d] *= a1; O2[d] *= a2; }
            l1 *= a1; l2 *= a2;
        }
        m1 += e1; m2 += e2;
    }
    __builtin_amdgcn_sched_barrier(0);
    bf16x8 vf[8];
#pragma unroll
    for (int d = 0; d < 4; ++d) { vf[2 * d] = lds_frag(vrow + d * 2048 + vo0); vf[2 * d + 1] = lds_frag(vrow + d * 2048 + vo1); }
    float ps0 = 0.f;
#pragma unroll
    for (int i = 0; i < 16; ++i) { const float pv = __builtin_amdgcn_exp2f(S0[i]); S0[i] = pv; ps0 += pv; }
    l1 += ps0;
    const bf16x8 P00 = pack8(S0, 0), P01 = pack8(S0, 1);
    __builtin_amdgcn_sched_barrier(0);
#pragma unroll
    for (int d = 0; d < 4; ++d) { O1[d] = MFMA32(vf[2 * d], P00, O1[d]); O1[d] = MFMA32(vf[2 * d + 1], P01, O1[d]); }
    float ps1 = 0.f;
#pragma unroll
    for (int i = 0; i < 16; ++i) { const float pv = __builtin_amdgcn_exp2f(S1[i]); S1[i] = pv; ps1 += pv; }
    l2 += ps1;
    const bf16x8 P10 = pack8(S1, 0), P11 = pack8(S1, 1);
#pragma unroll
    for (int g = 0; g < 8; ++g) { __builtin_amdgcn_sched_group_barrier(0x8, 1, 0); __builtin_amdgcn_sched_group_barrier(0x2, 8, 0); }
    __builtin_amdgcn_sched_barrier(0);
#pragma unroll
    for (int d = 0; d < 4; ++d) { O2[d] = MFMA32(vf[2 * d], P10, O2[d]); O2[d] = MFMA32(vf[2 * d + 1], P11, O2[d]); }
    __builtin_amdgcn_sched_barrier(0);
}

DI void attn_phase(const Params& p, char* smem, int bid, int nb) {
    const int tid = opaque_tid8(p), wave = p.pad_, lane = tid & 63, r = lane & 31, half = lane >> 5;
    char* Qs = smem; char* Kbuf = smem + 65536; char* Vbuf = smem + 81920;
    const u16* qk = (const u16*)(p.ws + WS_PROJ);
    const u16* vt = (const u16*)(p.ws + WS_VT);
    const float lam = __uint_as_float(__builtin_amdgcn_readfirstlane(__float_as_uint(
        __expf(wave_sum(p.lq1[lane] * p.lk1[lane], half)) - __expf(wave_sum(p.lq2[lane] * p.lk2[lane], half)) + LAMBDA_INIT)));
    const unsigned q_off = (unsigned)(lane & 31) * 4096u + (unsigned)(lane >> 5) * 16u;
    const unsigned kx = (unsigned)((lane & 7) ^ (lane >> 4));
    const unsigned k_off0 = (unsigned)(lane >> 3) * 4096u + (kx << 4), k_off1 = (unsigned)(lane >> 3) * 4096u + ((kx ^ 4u) << 4);
    const unsigned v_off = (unsigned)(lane >> 2) * (unsigned)(SEQ * 2) + (unsigned)(((lane & 3) ^ ((lane >> 4) & 3)) << 4);
    const int nrounds = (1024 + nb - 1) / nb;
    for (int j = 0; j < nrounds; ++j) {
        const int rank = j * nb + ((j & 1) ? (nb - 1 - bid) : bid);
        if (rank >= 1024) continue;
        const int qb = 63 - (rank >> 4), bh = rank & 15, b = bh >> 3, h = bh & 7;
        const int q0 = qb * 256, tokbase = b * SEQ, qlo = q0 + 32 * wave, qidx = qlo + r;
        const u16* kbase = qk + (size_t)tokbase * 2048 + 1024 + h * 128;
        const u16* vbase = vt + (size_t)(b * 8 + h) * 128 * SEQ;
        const int nkt = 8 * (qb + 1);
        __syncthreads();
        {
            const char* qsrc = (const char*)(qk + (size_t)(tokbase + q0 + wave * 32) * 2048 + h * 128);
#pragma unroll
            for (int i = 0; i < 8; ++i) dma16(qsrc + i * 32, q_off, Qs + (wave * 8 + i) * 1024);
        }
        const char* ksrc = (const char*)(kbase + (size_t)(8 * (wave & 3)) * 2048 + (wave >> 2) * 64);
        const char* vsrc = (const char*)(vbase + (size_t)(wave * 16) * SEQ);
        const unsigned k_off = (wave & 1) ? k_off1 : k_off0;
        dma16(ksrc, k_off, Kbuf + wave * 1024);
        dma16(vsrc, v_off, Vbuf + wave * 1024);
        f32x16 O1[4], O2[4];
#pragma unroll
        for (int d = 0; d < 4; ++d) { O1[d] = zero16(); O2[d] = zero16(); }
        float m1 = 0.f, m2 = 0.f, l1 = 0.f, l2 = 0.f;
        const char* Qw = Qs + wave * 8192 + lane * 16;
        for (int kt = 0; kt < nkt; ++kt) {
            const int k0 = kt * 32, buf = kt & 1;
            asm volatile("s_waitcnt vmcnt(0)" ::: "memory");
            __syncthreads();
            if (kt + 1 < nkt) {
                const char* kn = ksrc + (size_t)(k0 + 32) * 4096; const char* vn = vsrc + (k0 + 32) * 2;
                dma16(kn, k_off, Kbuf + (buf ^ 1) * 8192 + wave * 1024);
                dma16(vn, v_off, Vbuf + (buf ^ 1) * 8192 + wave * 1024);
            }
            if (k0 <= qlo + 31) {
                const bool diag = (k0 + 31 > qlo);
                const char* Kb = Kbuf + buf * 8192; const char* Vb = Vbuf + buf * 8192;
                attn_tile(Kb, Vb, Qw, O1, O2, m1, l1, m2, l2, diag, kt == 0, k0, qidx, r, half);
            }
        }
        l1 += sxf<32>(l1, half); l2 += sxf<32>(l2, half);
        const float i1 = __builtin_amdgcn_rcpf(l1), i2 = lam * __builtin_amdgcn_rcpf(l2);
        float ss = 0.f;
#pragma unroll
        for (int d = 0; d < 4; ++d)
#pragma unroll
            for (int i = 0; i < 16; ++i) { const float v = O1[d][i] * i1 - O2[d][i] * i2; O1[d][i] = v; ss += v * v; }
        ss += sxf<32>(ss, half);
        const float rn = rsqrtf(ss * (1.f / 128.f) + 1e-6f) * (1.f - LAMBDA_INIT);
        u16* orow = (u16*)(p.ws + WS_HN) + (size_t)(tokbase + qidx) * 1024 + h * 128;
        const float* gn = p.diff_norm + h * 128;
        int half_e = half; asm volatile("" : "+v"(half_e));
        f32x4 gv[16];
#pragma unroll
        for (int i = 0; i < 16; ++i) gv[i] = *(const f32x4*)(gn + 32 * (i >> 2) + 8 * (i & 3) + 4 * half_e);
#pragma unroll
        for (int d = 0; d < 4; ++d)
#pragma unroll
            for (int g = 0; g < 4; ++g) {
                const int c0 = 32 * d + 8 * g + 4 * half_e;
                const f32x4 gq = gv[4 * d + g];
                *(u32x2*)(orow + c0) = u32x2{pk2(O1[d][4 * g] * rn * gq.x, O1[d][4 * g + 1] * rn * gq.y), pk2(O1[d][4 * g + 2] * rn * gq.z, O1[d][4 * g + 3] * rn * gq.w)};
            }
    }
}
extern __shared__ __attribute__((aligned(16))) char dyn_smem[];
constexpr int SUB_LDS = 73728;
constexpr int MEGA_LDS_WORK = 2 * SUB_LDS;
constexpr int MEGA_LDS_BYTES = MEGA_LDS_WORK + 16;

__global__ void __launch_bounds__(512, 2) mega_fwd(Params pk) {
    Params p = pk; const int w8 = __builtin_amdgcn_readfirstlane((int)(threadIdx.x >> 6));
    p.wv = w8 & 3; p.pad_ = w8; const int sub = w8 >> 2;
    volatile LAS unsigned* st = (volatile LAS unsigned*)(dyn_smem + MEGA_LDS_WORK);
    if (threadIdx.x == 0) { st[0] = 0u; st[1] = 0u; st[2] = 0u; st[3] = 0u; }
    __syncthreads();
    XcdBarrier bar = xcd_barrier_post((unsigned*)(p.ws + WS_BAR), st, threadIdx.x == 0);
#define XBAR() xcd_barrier(bar, (opaque_tid(p) | sub) == 0)
    char* smem = dyn_smem + sub * SUB_LDS;
    const int nb = 2 * (int)gridDim.x, bid = (int)blockIdx.x + sub * (int)gridDim.x;
    const int bidp = 2 * (int)blockIdx.x + sub;
    const u16* hn = (const u16*)(p.ws + WS_HN);
    phase_prep_a(p, bid, nb);
    asm volatile("; PHASE_END 1");
    XBAR();
    gemm8(p, hn, (const u16*)(p.ws + WS_WGIN), 3072, EpiProjBf16{(u16*)(p.ws + WS_PROJ), 3072});
    gla_glr_phase(p, smem, (int)blockIdx.x, (int)gridDim.x);
    asm volatile("; PHASE_END 2");
    XBAR();
    gla_pass1(p, smem, bid, nb);
    asm volatile("; PHASE_END 3");
    XBAR();
    if (nb >= 256) { if (bid < 128) gla_scan(p, bid, 128); else { phase_prep_b(p, bid - 128, nb - 128); phase_tabconv(p, 0, bid - 128, nb - 128); phase_tabconv(p, 1, bid - 128, nb - 128); } }
    else { gla_scan(p, bid, nb); phase_prep_b(p, bid, nb); phase_tabconv(p, 0, bid, nb); phase_tabconv(p, 1, bid, nb); }
    asm volatile("; PHASE_END 4");
    XBAR();
    gla_pass3(p, smem, bid, nb);
    asm volatile("; PHASE_END 5");
    XBAR();
    gemm8(p, hn, (const u16*)(p.ws + WS_WGOUT), 1024, EpiResid8{p.x, p.out});
    asm volatile("; PHASE_END 6");
    XBAR();
    phase_rmsnorm(p, p.norm_ffn, bid, nb);
    asm volatile("; PHASE_END 7");
    XBAR();
    peer_query_phase8(p, 0, dyn_smem, (int)blockIdx.x, (int)gridDim.x);
    asm volatile("; PHASE_END 8");
    XBAR();
    peer_u_phase(p, 0, smem, bid, nb);
    XBAR();
    peer_v_phase<false>(p, 0, p.norm_mix + 1024, smem, bid, nb);
    asm volatile("; PHASE_END 9");
    XBAR();
    gemm8(p, hn, (const u16*)(p.ws + WS_WDIN), 3072, EpiDiffIn8{p.ws});
    asm volatile("; PHASE_END 10");
    XBAR();
    attn_phase(p, dyn_smem, (int)blockIdx.x, (int)gridDim.x);
    asm volatile("; PHASE_END 11");
    XBAR();
    gemm8(p, hn, (const u16*)(p.ws + WS_WDOUT), 1024, EpiResid8{p.out, p.out});
    asm volatile("; PHASE_END 12");
    XBAR();
    phase_rmsnorm(p, p.norm_ffn + 1024, bid, nb);
    asm volatile("; PHASE_END 13");
    XBAR();
    peer_query_phase8(p, 1, dyn_smem, (int)blockIdx.x, (int)gridDim.x);
    asm volatile("; PHASE_END 14");
    XBAR();
    peer_u_phase(p, 1, smem, bid, nb);
    XBAR();
    peer_v_phase<true>(p, 1, p.norm_final, smem, bid, nb);
}

extern "C" void kernel_launch(void* const* d_in, const int* in_sizes, int n_in, void* d_out, int out_size, void* d_ws, size_t ws_size, hipStream_t stream) {
    Params p{};
    p.x = (const float*)d_in[0]; p.pos = (const int*)d_in[1]; p.norm_mix = (const float*)d_in[2]; p.norm_ffn = (const float*)d_in[3]; p.norm_final = (const float*)d_in[4];
    p.gla_w_in = (const float*)d_in[5]; p.gla_wgu = (const float*)d_in[6]; p.gla_bg = (const float*)d_in[7]; p.gla_norm = (const float*)d_in[8]; p.gla_w_out = (const float*)d_in[9];
    p.diff_w_in = (const float*)d_in[10]; p.lq1 = (const float*)d_in[11]; p.lk1 = (const float*)d_in[12]; p.lq2 = (const float*)d_in[13]; p.lk2 = (const float*)d_in[14];
    p.diff_norm = (const float*)d_in[15]; p.diff_w_out = (const float*)d_in[16];
    p.peer_wq = (const float*)d_in[17]; p.peer_sk = (const float*)d_in[18]; p.peer_u = (const float*)d_in[19]; p.peer_v = (const float*)d_in[20];
    p.out = (float*)d_out; p.ws = (char*)d_ws;
    static int grid = 0;
    if (grid == 0) {
        int dev = 0, cus = 0, per_cu = 0;
        hipGetDevice(&dev);
        hipDeviceGetAttribute(&cus, hipDeviceAttributeMultiprocessorCount, dev);
        hipFuncSetAttribute((const void*)mega_fwd, hipFuncAttributeMaxDynamicSharedMemorySize, MEGA_LDS_BYTES);
        hipOccupancyMaxActiveBlocksPerMultiprocessor(&per_cu, (const void*)mega_fwd, 512, MEGA_LDS_BYTES);
        (void)hipGetLastError();
        if (per_cu < 1) per_cu = 1;
        if (cus < 1) cus = 256;
        grid = cus * (per_cu < 1 ? per_cu : 1);
    }
    hipMemsetAsync((char*)d_ws + WS_BAR, 0, XCD_BAR_WORDS * sizeof(unsigned), stream);
    mega_fwd<<<grid, 512, MEGA_LDS_BYTES, stream>>>(p);
}
```
